# Optimizing an MI355X kernel written in HIP

```python
import jax, jax.numpy as jnp
from jax import lax
import numpy as np

D_MODEL = 1024
BATCH = 4
SEQ = 8192
DEPTH = 1

GDN_H = 4
GDN_DK = 128
GDN_DV = 128
GDN_W = GDN_H * GDN_DV
CONV_W = 4
CHUNK = 64
SB_H = 4
SB_D = 128
SB_W = SB_H * SB_D
Q_BLOCK = 128
MEM_H = 4
MEM_D = 128
MEM_W = MEM_H * MEM_D
N_MEM = 256
N_BRANCH = 3
D_FF = 4 * D_MODEL
EPS = 1e-6
IN_SIZES = (3 * GDN_W, GDN_W, GDN_H, GDN_H, 3 * SB_W, MEM_W, N_BRANCH * D_MODEL)
D_IN = sum(IN_SIZES)

kernel_name = "hybrid_gdn_stickbreak_memxattn_gated_merge"


def rms_norm(x, g):
    xf = x.astype(jnp.float32)
    y = xf * lax.rsqrt(jnp.mean(xf * xf, axis=-1, keepdims=True) + EPS)
    return (y * g.astype(jnp.float32)).astype(x.dtype)


def l2norm(x):
    return x * lax.rsqrt(jnp.sum(x * x, axis=-1, keepdims=True) + EPS)


def causal_dwconv(x, w):
    c = x.shape[-1]
    return lax.conv_general_dilated(
        x, w[:, None, :].astype(x.dtype), window_strides=(1,),
        padding=[(w.shape[0] - 1, 0)], dimension_numbers=("NWC", "WIO", "NWC"),
        feature_group_count=c)


def gated_delta_rule_chunked(q, k, v, g, beta):
    b, s, h, dk = q.shape
    dv = v.shape[-1]
    n = s // CHUNK

    def to_chunks(t):
        return jnp.moveaxis(t.reshape(b, n, CHUNK, h, *t.shape[3:]), 3, 1)

    qc, kc, vc, gc, bc = (to_chunks(t) for t in (q, k, v, g, beta))
    gc = jnp.cumsum(gc, axis=-1)
    idx = jnp.arange(CHUNK)
    causal = idx[:, None] >= idx[None, :]
    strict = idx[:, None] > idx[None, :]
    decay = jnp.exp(jnp.where(causal, gc[..., :, None] - gc[..., None, :], -jnp.inf))
    kb = kc * bc[..., None]
    vb = vc * bc[..., None]
    lower = jnp.where(strict, jnp.einsum("bhncd,bhnsd->bhncs", kb, kc) * decay, 0.0)
    eye = jnp.eye(CHUNK, dtype=jnp.float32)
    t_inv = lax.linalg.triangular_solve(eye + lower, jnp.broadcast_to(eye, lower.shape),
                                        left_side=True, lower=True, unit_diagonal=True)
    u = jnp.einsum("bhncs,bhnsv->bhncv", t_inv, vb)
    w = jnp.einsum("bhncs,bhnsk->bhnck", t_inv, kb * jnp.exp(gc)[..., None])
    a_qk = jnp.where(causal, jnp.einsum("bhncd,bhnsd->bhncs", qc, kc) * decay, 0.0)
    q_dec = qc * jnp.exp(gc)[..., None]
    k_dec = kc * jnp.exp(gc[..., -1:] - gc)[..., None]
    g_last = jnp.exp(gc[..., -1])
    xs = tuple(jnp.moveaxis(t, 2, 0) for t in (u, w, a_qk, q_dec, k_dec, g_last))

    def step(state, inp):
        u_i, w_i, a_i, qd_i, kd_i, gl_i = inp
        v_new = u_i - jnp.einsum("bhck,bhkv->bhcv", w_i, state)
        o_i = (jnp.einsum("bhck,bhkv->bhcv", qd_i, state)
               + jnp.einsum("bhcs,bhsv->bhcv", a_i, v_new))
        state = state * gl_i[..., None, None] + jnp.einsum("bhck,bhcv->bhkv", kd_i, v_new)
        return state, o_i

    s0 = jnp.zeros((b, h, dk, dv), jnp.float32)
    _, o = lax.scan(step, s0, xs)
    o = jnp.moveaxis(jnp.moveaxis(o, 0, 2), 1, 3)
    return o.reshape(b, s, h, dv)


def stick_breaking_attention(q, k, v):
    s = q.shape[2]
    scale = q.shape[-1] ** -0.5
    outs = []
    for blk in range(s // Q_BLOCK):
        q0 = blk * Q_BLOCK
        kl = q0 + Q_BLOCK
        z = jnp.einsum("bhqd,bhkd->bhqk", q[:, :, q0:kl], k[:, :, :kl]) * scale
        mask = jnp.arange(kl)[None, :] < (q0 + jnp.arange(Q_BLOCK))[:, None]
        log_1mb = jnp.where(mask, jax.nn.log_sigmoid(-z), 0.0)
        between = lax.cumsum(log_1mb, axis=3, reverse=True) - log_1mb
        att = jnp.where(mask, jnp.exp(jax.nn.log_sigmoid(z) + between), 0.0)
        outs.append(jnp.einsum("bhqk,bhkd->bhqd", att, v[:, :, :kl]))
    return jnp.concatenate(outs, axis=2)


def setup_inputs(seed: int = 0) -> dict:
    key = jax.random.key(seed)
    ks = jax.random.split(key, 24)
    f32 = jnp.float32
    nrm = lambda k, shape, scale: jax.random.normal(k, shape, f32) * scale
    gain = lambda k, n: 1.0 + 0.02 * jax.random.normal(k, (DEPTH, n), f32)
    dt = jnp.exp(jax.random.uniform(ks[5], (DEPTH, GDN_H), f32, np.log(1e-3), np.log(1e-1)))
    return {
        "x": nrm(ks[0], (BATCH, SEQ, D_MODEL), 1.0),
        "mem": nrm(ks[1], (BATCH, N_MEM, D_MODEL), 1.0),
        "norm1_g": gain(ks[2], D_MODEL),
        "w_in": nrm(ks[3], (DEPTH, D_MODEL, D_IN), D_MODEL ** -0.5),
        "conv_w": nrm(ks[4], (DEPTH, CONV_W, 3 * GDN_W), CONV_W ** -0.5),
        "a_log": jnp.log(jax.random.uniform(ks[6], (DEPTH, GDN_H), f32, 1.0, 16.0)),
        "dt_bias": jnp.log(jnp.expm1(dt)),
        "gdn_norm_g": gain(ks[7], GDN_DV),
        "sb_q_norm_g": gain(ks[8], SB_D),
        "sb_k_norm_g": gain(ks[9], SB_D),
        "mem_norm_g": gain(ks[10], D_MODEL),
        "w_mem_kv": nrm(ks[11], (DEPTH, D_MODEL, 2 * MEM_W), D_MODEL ** -0.5),
        "mem_q_norm_g": gain(ks[12], MEM_D),
        "mem_k_norm_g": gain(ks[13], MEM_D),
        "w_br_gdn": nrm(ks[14], (DEPTH, GDN_W, D_MODEL), GDN_W ** -0.5),
        "w_br_sb": nrm(ks[15], (DEPTH, SB_W, D_MODEL), SB_W ** -0.5),
        "w_br_mem": nrm(ks[16], (DEPTH, MEM_W, D_MODEL), MEM_W ** -0.5),
        "w_o": nrm(ks[17], (DEPTH, D_MODEL, D_MODEL), D_MODEL ** -0.5),
        "norm2_g": gain(ks[18], D_MODEL),
        "w_up": nrm(ks[19], (DEPTH, D_MODEL, D_FF), D_MODEL ** -0.5),
        "w_down": nrm(ks[20], (DEPTH, D_FF, D_MODEL), D_FF ** -0.5),
    }


def reference(x, mem, norm1_g, w_in, conv_w, a_log, dt_bias, gdn_norm_g, sb_q_norm_g, sb_k_norm_g,
              mem_norm_g, w_mem_kv, mem_q_norm_g, mem_k_norm_g, w_br_gdn, w_br_sb, w_br_mem, w_o,
              norm2_g, w_up, w_down):
    b, s, _ = x.shape
    f32 = jnp.float32
    splits = np.cumsum(IN_SIZES)[:-1].tolist()
    for l in range(DEPTH):
        h = rms_norm(x, norm1_g[l])
        proj = h @ w_in[l]
        gdn_qkv, gdn_z, gdn_a, gdn_b, sb_qkv, mem_q, gate_logits = jnp.split(proj, splits, axis=-1)

        gdn_qkv = jax.nn.silu(causal_dwconv(gdn_qkv, conv_w[l])).astype(f32)
        gq, gk, gv = jnp.split(gdn_qkv, 3, axis=-1)
        gq = l2norm(gq.reshape(b, s, GDN_H, GDN_DK)) * (GDN_DK ** -0.5)
        gk = l2norm(gk.reshape(b, s, GDN_H, GDN_DK))
        gv = gv.reshape(b, s, GDN_H, GDN_DV)
        beta = jax.nn.sigmoid(gdn_b.astype(f32))
        g = -jnp.exp(a_log[l].astype(f32)) * jax.nn.softplus(gdn_a.astype(f32) + dt_bias[l].astype(f32))
        o_gdn = gated_delta_rule_chunked(gq, gk, gv, g, beta)
        o_gdn = rms_norm(o_gdn, gdn_norm_g[l]) * jax.nn.silu(gdn_z.astype(f32).reshape(b, s, GDN_H, GDN_DV))
        y_gdn = o_gdn.reshape(b, s, GDN_W).astype(x.dtype) @ w_br_gdn[l]

        sq, sk, sv = jnp.split(sb_qkv, 3, axis=-1)
        sq = rms_norm(sq.reshape(b, s, SB_H, SB_D), sb_q_norm_g[l])
        sk = rms_norm(sk.reshape(b, s, SB_H, SB_D), sb_k_norm_g[l])
        sv = sv.reshape(b, s, SB_H, SB_D)
        to_bhsd = lambda t: jnp.transpose(t, (0, 2, 1, 3)).astype(f32)
        o_sb = stick_breaking_attention(to_bhsd(sq), to_bhsd(sk), to_bhsd(sv))
        y_sb = jnp.transpose(o_sb, (0, 2, 1, 3)).reshape(b, s, SB_W).astype(x.dtype) @ w_br_sb[l]

        kv = rms_norm(mem, mem_norm_g[l]) @ w_mem_kv[l]
        km, vm = jnp.split(kv, 2, axis=-1)
        km = rms_norm(km.reshape(b, N_MEM, MEM_H, MEM_D), mem_k_norm_g[l]).astype(f32)
        vm = vm.reshape(b, N_MEM, MEM_H, MEM_D).astype(f32)
        qm = rms_norm(mem_q.reshape(b, s, MEM_H, MEM_D), mem_q_norm_g[l]).astype(f32)
        p = jax.nn.softmax(jnp.einsum("bshd,bmhd->bhsm", qm, km) * (MEM_D ** -0.5), axis=-1)
        o_mem = jnp.einsum("bhsm,bmhd->bshd", p, vm).reshape(b, s, MEM_W).astype(x.dtype)
        y_mem = o_mem @ w_br_mem[l]

        g_gdn, g_sb, g_mem = jnp.split(jax.nn.sigmoid(gate_logits), N_BRANCH, axis=-1)
        mix = g_gdn * y_gdn + g_sb * y_sb + g_mem * y_mem
        x = x + mix @ w_o[l]

        h2 = rms_norm(x, norm2_g[l])
        x = x + jnp.square(jax.nn.relu(h2 @ w_up[l])) @ w_down[l]
    return x
```

```cpp
#include <hip/hip_runtime.h>
#include <hip/hip_cooperative_groups.h>
#include <cstdio>
#include <cstdint>
namespace cg = cooperative_groups;

#define LAS __attribute__((address_space(3)))
typedef unsigned short bf16_t;
typedef short bf16x8 __attribute__((ext_vector_type(8)));
typedef float f32x4 __attribute__((ext_vector_type(4)));
typedef float f32x2 __attribute__((ext_vector_type(2)));
typedef unsigned u32x4 __attribute__((ext_vector_type(4)));
typedef unsigned u32x2 __attribute__((ext_vector_type(2)));

constexpr int DM = 1024, NB = 4, SEQ = 8192, TOK = NB * SEQ;
constexpr int NH = 4, HD = 128, BW = 512;
constexpr int CHUNK = 64, NCH = SEQ / CHUNK;
constexpr int NMEM = 256, DFF = 4096, DIN = 7176, NPROJ = 7168;
constexpr float EPS = 1e-6f;

constexpr size_t MiB = 1u << 20;
constexpr size_t WS_CTL = 0;
constexpr size_t WS_WIN = 1 * MiB;
constexpr size_t WS_WMKV = 15 * MiB;
constexpr size_t WS_WBR = 17 * MiB;
constexpr size_t WS_WO = 20 * MiB;
constexpr size_t WS_WUP = 22 * MiB;
constexpr size_t WS_WDN = 30 * MiB;
constexpr size_t WS_MEMN = 38 * MiB;
constexpr size_t WS_MEMKV = 40 * MiB;
constexpr size_t WS_AB = 42 * MiB;
constexpr size_t WS_SSQ = 43 * MiB;
constexpr size_t WS_GL = 45 * MiB;
constexpr size_t WS_H = 46 * MiB;
constexpr size_t WS_GDNI = 110 * MiB;
constexpr size_t GI_W = 0, GI_QD = 32 * MiB, GI_KDT = 64 * MiB, GI_UT = 96 * MiB, GI_A = 128 * MiB;
constexpr size_t WS_GZ = 254 * MiB;
constexpr size_t WS_GQKV = 286 * MiB;
constexpr size_t WS_OG = 318 * MiB;
constexpr size_t WS_OS = 350 * MiB;
constexpr size_t WS_SQKV = 382 * MiB;
constexpr size_t WS_MQ = 478 * MiB;
constexpr size_t WS_GATES = 110 * MiB;
constexpr size_t WS_MIXF = 382 * MiB;
constexpr size_t WS_MIX = 46 * MiB;
constexpr size_t WS_X1B = 110 * MiB;
constexpr size_t WS_ACT = 174 * MiB;
constexpr size_t WS_END = 510 * MiB;

constexpr int LDS_BYTES = 147456;

typedef __bf16 bf16x2_t __attribute__((ext_vector_type(2)));
__device__ __forceinline__ unsigned cvt_pk_bf16_mfma(float lo, float hi) { f32x2 v = {lo, hi}; bf16x2_t b = __builtin_convertvector(v, bf16x2_t); return __builtin_bit_cast(unsigned, b); }
__device__ __forceinline__ unsigned cvt_pk_bf16(float lo, float hi) { unsigned r; asm volatile("v_cvt_pk_bf16_f32 %0, %1, %2" : "=v"(r) : "v"(lo), "v"(hi)); return r; }
__device__ __forceinline__ float bflo(unsigned u) { return __uint_as_float(u << 16); }
__device__ __forceinline__ float bfhi(unsigned u) { return __uint_as_float(u & 0xffff0000u); }
__device__ __forceinline__ float wave_sum(float v) {
#pragma unroll
    for (int o = 1; o < 64; o <<= 1) v += __shfl_xor(v, o);
    return v;
}
__device__ __forceinline__ float sigmoidf_(float x) { return 1.0f / (1.0f + __expf(-x)); }
__device__ __forceinline__ float softplusf_(float x) { return fmaxf(x, 0.f) + __logf(1.0f + __expf(-fabsf(x))); }
__device__ __forceinline__ u32x2 ld8_agent(const void* p) { const unsigned long long v = __hip_atomic_load((const unsigned long long*)p, __ATOMIC_RELAXED, __HIP_MEMORY_SCOPE_AGENT); u32x2 r; r.x = (unsigned)v; r.y = (unsigned)(v >> 32); return r; }
#define MFMA16(x, y, c) __builtin_amdgcn_mfma_f32_16x16x32_bf16((x), (y), (c), 0, 0, 0)
#define LDS_WAIT() asm volatile("s_waitcnt lgkmcnt(0)" ::: "memory")

namespace pg8 {
constexpr int BM = 256, BK = 64, HALF = 128, HTB = HALF * BK * 2, STAGE_BYTES = 8 * HTB, NXCD = 8, WGM = 8;
__host__ __device__ __forceinline__ int lds_byte(int r, int c) { const int st = (r >> 4) * 2 + (c >> 5), rr = r & 15, cc = c & 31, ob = rr * 64 + cc * 2; return st * 1024 + (ob ^ (((ob >> 9) & 1) << 5)); }
__host__ __device__ __forceinline__ void stage_rc(int b, int& R, int& C) { const int st = b / 1024, sb = b % 1024, swz = sb ^ (((sb >> 9) & 1) << 5); R = (st >> 1) * 16 + swz / 64; C = (st & 1) * 32 + (swz % 64) / 2; }
__host__ __device__ __forceinline__ int perm32(int rho) { const int n = rho >> 4, i = rho & 15; return 8 * (i >> 2) + 4 * n + (i & 3); }

struct Unit { int pm, pn, kind; const char* A; const char* B; };

__device__ __forceinline__ bool tile_order(int nM, int nN, int G, int c, int i, int& pm, int& pn) {
    const int nwg = nM * nN; const long L = (long)i * G + c; if (L >= nwg) return false;
    int wgid = (int)L; { const int q = nwg / NXCD, r = nwg % NXCD, xcd = wgid % NXCD, off = wgid / NXCD; wgid = (xcd < r ? xcd * (q + 1) : r * (q + 1) + (xcd - r) * q) + off; }
    const int nig = WGM * nN, gid = wgid / nig, fm = gid * WGM, gsz = (nM - fm) < WGM ? (nM - fm) : WGM;
    pm = fm + ((wgid % nig) % gsz); pn = (wgid % nig) / gsz; return true;
}

template <class Epi, class Sched, bool ALIGN_EPI, bool SP2>
__device__ __forceinline__ void gemm_phase(LAS unsigned char* lds, const int K, const Sched& S, const Epi& E) {
    const int tid = threadIdx.x, wid = __builtin_amdgcn_readfirstlane(tid >> 6), lane = tid & 63, wr = wid >> 2, wc = wid & 3, fr = lane & 15, fq = lane >> 4;
    const int nt = K / BK;
    unsigned voffA[2], voffB[2];
#pragma unroll
    for (int i = 0; i < 2; ++i) { int R, C; stage_rc(tid * 16 + i * 8192, R, C); const int Rb = Epi::PERM ? ((R & ~31) + perm32(R & 31)) : R;
        voffA[i] = (unsigned)(R * K + C) * 2u; voffB[i] = (unsigned)(Rb * K + C) * 2u; }
    const size_t kstep = (size_t)(BK * 2);
    const size_t hstep = (size_t)HALF * K * 2;
    const unsigned ldsw = (unsigned)wid * 1024u;
    const int aoff = lds_byte(wr * 64 + fr, fq * 8), boff = lds_byte(wc * 32 + fr, fq * 8);
#define PG8_SA(b, h) (((b) * 2 + (h)) * HTB)
#define PG8_SB(b, h) ((4 + (b) * 2 + (h)) * HTB)
#define PG8_STAGE(bufoff, gbase, voff) do { _Pragma("unroll") for (int _i = 0; _i < 2; ++_i) \
        __builtin_amdgcn_global_load_lds((const unsigned*)((const char*)(gbase) + (voff)[_i]), (LAS unsigned*)(lds + (bufoff) + ldsw + _i * 8192), 16, 0, 16  ); } while (0)
#define PG8_LDA(dst, b, h) do { _Pragma("unroll") for (int m = 0; m < 4; ++m) _Pragma("unroll") for (int k = 0; k < 2; ++k) dst[m][k] = *(const LAS bf16x8*)(lds + PG8_SA(b, h) + aoff + m * 2048 + k * 1024); } while (0)
#define PG8_LDB(dst, b, h) do { _Pragma("unroll") for (int n = 0; n < 2; ++n) _Pragma("unroll") for (int k = 0; k < 2; ++k) dst[n][k] = *(const LAS bf16x8*)(lds + PG8_SB(b, h) + boff + n * 2048 + k * 1024); } while (0)
#define PG8_MMA(ai, bj, At, Bt) do { __builtin_amdgcn_s_setprio(1); _Pragma("unroll") for (int m = 0; m < 4; ++m) _Pragma("unroll") for (int n = 0; n < 2; ++n) _Pragma("unroll") for (int k = 0; k < 2; ++k) \
        acc[ai][bj][m][n] = __builtin_amdgcn_mfma_f32_16x16x32_bf16(Bt[n][k], At[m][k], acc[ai][bj][m][n], 0, 0, 0); __builtin_amdgcn_s_setprio(0); } while (0)
#define PG8_WAIT_V(n) asm volatile("s_waitcnt vmcnt(" #n ")" ::: "memory")
#define PG8_WAIT_L(n) asm volatile("s_waitcnt lgkmcnt(" #n ")" ::: "memory")
#define PG8_BAR __builtin_amdgcn_s_barrier()
#define PG8_SCHED __builtin_amdgcn_sched_barrier(0)
    Unit cur, nxt; int ui = 0;
    if (!S.next(0, cur)) return;
    f32x4 acc[2][2][4][2];
#pragma unroll
    for (int a = 0; a < 2; ++a)
#pragma unroll
        for (int b = 0; b < 2; ++b)
#pragma unroll
            for (int m = 0; m < 4; ++m)
#pragma unroll
                for (int n = 0; n < 2; ++n) acc[a][b][m][n] = (f32x4){0.f, 0.f, 0.f, 0.f};
    bf16x8 At[4][2], B0[2][2], B1[2][2];
    const char* cA = cur.A; const char* cB = cur.B;
    if constexpr (SP2) {
        PG8_STAGE(PG8_SB(0, 0), cB, voffB); PG8_STAGE(PG8_SB(0, 1), cB + hstep, voffB); PG8_STAGE(PG8_SA(0, 0), cA, voffA); PG8_STAGE(PG8_SA(0, 1), cA + hstep, voffA);
        if (wr == 1) PG8_BAR;
        PG8_WAIT_V(2); PG8_BAR;
        PG8_STAGE(PG8_SB(1, 0), cB + kstep, voffB); PG8_STAGE(PG8_SA(1, 0), cA + kstep, voffA); PG8_STAGE(PG8_SB(1, 1), cB + hstep + kstep, voffB);
        PG8_WAIT_V(6); PG8_BAR;
    } else {
        PG8_STAGE(PG8_SB(0, 0), cB, voffB); PG8_STAGE(PG8_SA(0, 0), cA, voffA); PG8_STAGE(PG8_SB(0, 1), cB + hstep, voffB); PG8_STAGE(PG8_SA(0, 1), cA + hstep, voffA);
        if (wr == 1) PG8_BAR;
        PG8_WAIT_V(4); PG8_BAR;
        PG8_STAGE(PG8_SB(1, 0), cB + kstep, voffB); PG8_STAGE(PG8_SA(1, 0), cA + kstep, voffA); PG8_STAGE(PG8_SB(1, 1), cB + hstep + kstep, voffB);
        PG8_WAIT_V(6); PG8_BAR;
    }
    for (;;) {
        const bool has_next = S.next(ui + 1, nxt);
        const char* nA = has_next ? nxt.A : cA; const char* nB = has_next ? nxt.B : cB;
        for (int t = 0; t < nt; t += 2) {
            const bool last = (t == nt - 2);
            const char* a1 = cA + (size_t)(t + 1) * kstep;
            const char* a2 = last ? nA : cA + (size_t)(t + 2) * kstep; const char* b2 = last ? nB : cB + (size_t)(t + 2) * kstep;
            const char* a3 = a2 + kstep; const char* b3 = b2 + kstep;
            if constexpr (SP2) {
            PG8_LDB(B0, 0, 0); PG8_LDB(B1, 0, 1); PG8_SCHED; PG8_LDA(At, 0, 0); PG8_STAGE(PG8_SA(1, 1), a1 + hstep, voffA);
            PG8_WAIT_V(8); PG8_WAIT_L(0); PG8_BAR; PG8_MMA(0, 0, At, B0); PG8_MMA(0, 1, At, B1); PG8_BAR; PG8_SCHED;
            PG8_LDA(At, 0, 1); PG8_STAGE(PG8_SB(0, 0), b2, voffB); PG8_STAGE(PG8_SB(0, 1), b2 + hstep, voffB); PG8_STAGE(PG8_SA(0, 0), a2, voffA);
            PG8_WAIT_V(8); PG8_WAIT_L(0); PG8_BAR; PG8_MMA(1, 0, At, B0); PG8_MMA(1, 1, At, B1); PG8_BAR; PG8_SCHED;
            PG8_LDB(B0, 1, 0); PG8_LDB(B1, 1, 1); PG8_SCHED; PG8_LDA(At, 1, 0); PG8_STAGE(PG8_SA(0, 1), a2 + hstep, voffA);
            PG8_WAIT_V(8); PG8_WAIT_L(0); PG8_BAR; PG8_MMA(0, 0, At, B0); PG8_MMA(0, 1, At, B1); PG8_BAR; PG8_SCHED;
            PG8_LDA(At, 1, 1); PG8_STAGE(PG8_SB(1, 0), b3, voffB); PG8_STAGE(PG8_SB(1, 1), b3 + hstep, voffB); PG8_STAGE(PG8_SA(1, 0), a3, voffA);
            PG8_WAIT_V(8); PG8_WAIT_L(0); PG8_BAR; PG8_MMA(1, 0, At, B0); PG8_MMA(1, 1, At, B1); PG8_BAR; PG8_SCHED;
            } else {
            PG8_LDB(B0, 0, 0); PG8_SCHED; PG8_LDA(At, 0, 0); PG8_STAGE(PG8_SA(1, 1), a1 + hstep, voffA);
            PG8_WAIT_L(8); PG8_BAR; PG8_WAIT_L(0); PG8_MMA(0, 0, At, B0); PG8_BAR; PG8_SCHED;
            PG8_LDB(B1, 0, 1); PG8_STAGE(PG8_SB(0, 0), b2, voffB);
            PG8_BAR; PG8_WAIT_L(0); PG8_MMA(0, 1, At, B1); PG8_BAR;
            PG8_LDA(At, 0, 1); PG8_STAGE(PG8_SA(0, 0), a2, voffA);
            PG8_BAR; PG8_WAIT_L(0); PG8_MMA(1, 0, At, B0); PG8_BAR; PG8_SCHED;
            PG8_STAGE(PG8_SB(0, 1), b2 + hstep, voffB);
            PG8_WAIT_V(6); PG8_BAR; PG8_MMA(1, 1, At, B1); PG8_BAR;
            PG8_LDB(B0, 1, 0); PG8_SCHED; PG8_LDA(At, 1, 0); PG8_STAGE(PG8_SA(0, 1), a2 + hstep, voffA);
            PG8_WAIT_L(8); PG8_BAR; PG8_WAIT_L(0); PG8_MMA(0, 0, At, B0); PG8_BAR; PG8_SCHED;
            PG8_LDB(B1, 1, 1); PG8_STAGE(PG8_SB(1, 0), b3, voffB);
            PG8_BAR; PG8_WAIT_L(0); PG8_MMA(0, 1, At, B1); PG8_BAR;
            PG8_LDA(At, 1, 1); PG8_STAGE(PG8_SA(1, 0), a3, voffA);
            PG8_BAR; PG8_WAIT_L(0); PG8_MMA(1, 0, At, B0); PG8_BAR; PG8_SCHED;
            PG8_STAGE(PG8_SB(1, 1), b3 + hstep, voffB);
            PG8_WAIT_V(6); PG8_BAR; PG8_MMA(1, 1, At, B1); PG8_BAR;
            }
        }
        if constexpr (ALIGN_EPI) { if (wr == 0) PG8_BAR; }
        E(acc, cur, wr, wc, fr, fq);
        if (!has_next) break;
#pragma unroll
        for (int a = 0; a < 2; ++a)
#pragma unroll
            for (int b = 0; b < 2; ++b)
#pragma unroll
                for (int m = 0; m < 4; ++m)
#pragma unroll
                    for (int n = 0; n < 2; ++n) acc[a][b][m][n] = (f32x4){0.f, 0.f, 0.f, 0.f};
        cur = nxt; cA = nA; cB = nB; ++ui;
        if constexpr (ALIGN_EPI) { if (wr == 1) PG8_BAR; }
    }
    PG8_WAIT_V(0);
    if constexpr (!ALIGN_EPI) { if (wr == 0) PG8_BAR; }
    PG8_BAR;
#undef PG8_SA
#undef PG8_SB
#undef PG8_STAGE
#undef PG8_LDA
#undef PG8_LDB
#undef PG8_MMA
#undef PG8_WAIT_V
#undef PG8_WAIT_L
#undef PG8_BAR
#undef PG8_SCHED
}
}

struct Args {
    const float* in[21];
    float* out; unsigned char* ws;
    int ph_lo, ph_hi;
};
enum { I_X = 0, I_MEM, I_N1G, I_WIN, I_CONVW, I_ALOG, I_DTB, I_GDNG, I_SBQG, I_SBKG, I_MEMNG, I_WMKV, I_MQG, I_MKG, I_WBRG, I_WBRS, I_WBRM, I_WO, I_N2G, I_WUP, I_WDN };

struct SchedGrid {
    const char* A; const char* B; int nM, nN, G, c; size_t tstep;
    __device__ __forceinline__ bool next(int i, pg8::Unit& u) const {
        if (!pg8::tile_order(nM, nN, G, c, i, u.pm, u.pn)) return false;
        u.kind = 0; u.A = A + (size_t)u.pm * tstep; u.B = B + (size_t)u.pn * tstep; return true;
    }
};
struct SchedBranch {
    const char* A0; const char* A1; const char* A2; const char* B; int G, c; size_t tstep;
    __device__ __forceinline__ bool next(int i, pg8::Unit& u) const {
        const int t = i / 3, br = i - 3 * t;
        if (!pg8::tile_order(TOK / 256, DM / 256, G, c, t, u.pm, u.pn)) return false;
        u.kind = br; u.A = (br == 0 ? A0 : (br == 1 ? A1 : A2)) + (size_t)u.pm * tstep; u.B = B + (size_t)br * ((size_t)DM * BW * 2) + (size_t)u.pn * tstep; return true;
    }
};

struct EpiP1 {
    static constexpr bool PERM = true;
    bf16_t* gqkv; bf16_t* gz; bf16_t* sqkv; bf16_t* mq; bf16_t* gates; bf16_t* memkv; int is_mem;
    __device__ __forceinline__ void operator()(const f32x4 (&acc)[2][2][4][2], const pg8::Unit& u, int wr, int wc, int fr, int fq) const {
        bf16_t* base; int ldc, c0; bool sig = false; const int pn = u.pn;
        if (is_mem == 1) { base = memkv; ldc = 1024; c0 = pn * 256; }
        else if (is_mem == 2) { base = gates; ldc = 3072; c0 = pn * 256; sig = true; }
        else if (pn < 6) { base = gqkv; ldc = 1536; c0 = pn * 256; }
        else if (pn < 8) { base = gz; ldc = 512; c0 = (pn - 6) * 256; }
        else if (pn < 14) { base = sqkv; ldc = 1536; c0 = (pn - 8) * 256; }
        else { base = mq; ldc = 512; c0 = (pn - 14) * 256; }
        const int row0 = u.pm * 256 + wr * 64 + fr, col0 = c0 + wc * 32 + 8 * fq;
#pragma unroll
        for (int ai = 0; ai < 2; ++ai)
#pragma unroll
            for (int m = 0; m < 4; ++m) { bf16_t* rowp = base + (size_t)(row0 + ai * 128 + m * 16) * ldc + col0;
#pragma unroll
                for (int bj = 0; bj < 2; ++bj) { f32x4 v0 = acc[ai][bj][m][0], v1 = acc[ai][bj][m][1];
                    if (sig) {
#pragma unroll
                        for (int e = 0; e < 4; ++e) { v0[e] = sigmoidf_(v0[e]); v1[e] = sigmoidf_(v1[e]); } }
                    u32x4 w; w.x = cvt_pk_bf16(v0[0], v0[1]); w.y = cvt_pk_bf16(v0[2], v0[3]); w.z = cvt_pk_bf16(v1[0], v1[1]); w.w = cvt_pk_bf16(v1[2], v1[3]);
                    *(u32x4*)(rowp + bj * 128) = w; } }
    }
};
struct EpiP3 {
    static constexpr bool PERM = true;
    const bf16_t* gates; float* priv; bf16_t* mix;
    __device__ __forceinline__ void operator()(const f32x4 (&acc)[2][2][4][2], const pg8::Unit& u, int wr, int wc, int fr, int fq) const {
        const int br = u.kind; int opq; asm volatile("v_mov_b32 %0, 0" : "=v"(opq));
        const unsigned row0 = (unsigned)(u.pm * 256 + wr * 64 + fr + opq), col0 = (unsigned)(u.pn * 256 + wc * 32 + 8 * fq);
        const unsigned goff0 = row0 * 3072u + (unsigned)br * 1024u + col0, moff0 = row0 * 1024u + col0;
        f32x4* pv = (f32x4*)priv + threadIdx.x + opq;
        if (br > 0) asm volatile("s_waitcnt vmcnt(0)" ::: "memory");
#pragma unroll
        for (int ai = 0; ai < 2; ++ai)
#pragma unroll
            for (int m = 0; m < 4; ++m) {
#pragma unroll
                for (int bj = 0; bj < 2; ++bj) {
                    const bf16_t* gp_ = gates + (goff0 + (unsigned)((ai * 128 + m * 16) * 3072 + bj * 128)); const u32x2 g0_ = ld8_agent(gp_), g1_ = ld8_agent(gp_ + 4); u32x4 g; g.x = g0_.x; g.y = g0_.y; g.z = g1_.x; g.w = g1_.y;
                    f32x4 v0 = acc[ai][bj][m][0], v1 = acc[ai][bj][m][1];
                    v0[0] *= bflo(g.x); v0[1] *= bfhi(g.x); v0[2] *= bflo(g.y); v0[3] *= bfhi(g.y);
                    v1[0] *= bflo(g.z); v1[1] *= bfhi(g.z); v1[2] *= bflo(g.w); v1[3] *= bfhi(g.w);
                    const int ri = ((ai * 2 + bj) * 4 + m) * 2;
#ifndef P3_NORMW
                    if (br > 0) {
                        const u32x2 a0 = ld8_agent(&pv[ri * 512]), a1 = ld8_agent((const char*)&pv[ri * 512] + 8), b0 = ld8_agent(&pv[(ri + 1) * 512]), b1 = ld8_agent((const char*)&pv[(ri + 1) * 512] + 8);
                        v0[0] += __uint_as_float(a0.x); v0[1] += __uint_as_float(a0.y); v0[2] += __uint_as_float(a1.x); v0[3] += __uint_as_float(a1.y);
                        v1[0] += __uint_as_float(b0.x); v1[1] += __uint_as_float(b0.y); v1[2] += __uint_as_float(b1.x); v1[3] += __uint_as_float(b1.y); }
                    if (br < 2) { pv[ri * 512] = v0; pv[(ri + 1) * 512] = v1; }
#else
                    if (br < 2) { }
#endif
                    else { u32x4 w; w.x = cvt_pk_bf16(v0[0], v0[1]); w.y = cvt_pk_bf16(v0[2], v0[3]); w.z = cvt_pk_bf16(v1[0], v1[1]); w.w = cvt_pk_bf16(v1[2], v1[3]);
                        *(u32x4*)(mix + (moff0 + (unsigned)((ai * 128 + m * 16) * 1024 + bj * 128))) = w; } }
                asm volatile("s_waitcnt vmcnt(24)" ::: "memory"); }
    }
};
struct EpiP4 {
    static constexpr bool PERM = true;
    const float* x; float* out; bf16_t* x1b; float* ssq;
    __device__ __forceinline__ void operator()(const f32x4 (&acc)[2][2][4][2], const pg8::Unit& u, int wr, int wc, int fr, int fq) const {
        int opq; asm volatile("v_mov_b32 %0, 0" : "=v"(opq));
        const unsigned row0 = (unsigned)(u.pm * 256 + wr * 64 + fr + opq), col0 = (unsigned)(u.pn * 256 + wc * 32 + 8 * fq);
#pragma unroll
        for (int ai = 0; ai < 2; ++ai)
#pragma unroll
            for (int m = 0; m < 4; ++m) { const unsigned row = row0 + ai * 128 + m * 16; float s = 0.f;
#pragma unroll
                for (int bj = 0; bj < 2; ++bj) { const unsigned off = row * 1024u + col0 + bj * 128;
#ifdef P4_MINIMAL
                    const f32x4 o0 = acc[ai][bj][m][0], o1 = acc[ai][bj][m][1];
#else
                    const f32x4 o0 = *(const f32x4*)(x + off) + acc[ai][bj][m][0], o1 = *(const f32x4*)(x + off + 4) + acc[ai][bj][m][1];
#endif
                    s += (o0[0] * o0[0] + o0[1] * o0[1]) + (o0[2] * o0[2] + o0[3] * o0[3]) + (o1[0] * o1[0] + o1[1] * o1[1]) + (o1[2] * o1[2] + o1[3] * o1[3]);
                    u32x4 w; w.x = cvt_pk_bf16(o0[0], o0[1]); w.y = cvt_pk_bf16(o0[2], o0[3]); w.z = cvt_pk_bf16(o1[0], o1[1]); w.w = cvt_pk_bf16(o1[2], o1[3]);
                    *(u32x4*)(x1b + off) = w; }
#ifndef NO_SSQ
                s += __shfl_xor(s, 16); s += __shfl_xor(s, 32);
                if (fq == 0) ssq[(size_t)u.pn * (TOK * 4) + row * 4 + wc] = s;
#endif
                asm volatile("s_waitcnt vmcnt(24)" ::: "memory"); }
    }
};
struct EpiP6 {
    static constexpr bool PERM = true;
    const float* ssq; bf16_t* act;
    __device__ __forceinline__ void operator()(const f32x4 (&acc)[2][2][4][2], const pg8::Unit& u, int wr, int wc, int fr, int fq) const {
        const int row0 = u.pm * 256 + wr * 64 + fr, col0 = u.pn * 256 + wc * 32 + 8 * fq;
#pragma unroll
        for (int ai = 0; ai < 2; ++ai)
#pragma unroll
            for (int m = 0; m < 4; ++m) { const size_t row = (size_t)(row0 + ai * 128 + m * 16);
                const f32x4 p = *(const f32x4*)(ssq + (size_t)fq * (TOK * 4) + row * 4); float s = (p[0] + p[1]) + (p[2] + p[3]);
                s += __shfl_xor(s, 16); s += __shfl_xor(s, 32);
                const float rstd = rsqrtf(s * (1.0f / DM) + EPS);
#pragma unroll
                for (int bj = 0; bj < 2; ++bj) { f32x4 v0 = acc[ai][bj][m][0] * rstd, v1 = acc[ai][bj][m][1] * rstd;
#pragma unroll
                    for (int e = 0; e < 4; ++e) { const float a = fmaxf(v0[e], 0.f), b = fmaxf(v1[e], 0.f); v0[e] = a * a; v1[e] = b * b; }
                    u32x4 w; w.x = cvt_pk_bf16(v0[0], v0[1]); w.y = cvt_pk_bf16(v0[2], v0[3]); w.z = cvt_pk_bf16(v1[0], v1[1]); w.w = cvt_pk_bf16(v1[2], v1[3]);
                    *(u32x4*)(act + row * 4096 + col0 + bj * 128) = w; } }
    }
};
struct EpiP7 {
    static constexpr bool PERM = false;
    const bf16_t* x1b; float* out;
    __device__ __forceinline__ void operator()(const f32x4 (&acc)[2][2][4][2], const pg8::Unit& u, int wr, int wc, int fr, int fq) const {
        int opq; asm volatile("v_mov_b32 %0, 0" : "=v"(opq));
        const unsigned row0 = (unsigned)(u.pm * 256 + wr * 64 + fr + opq), col0 = (unsigned)(u.pn * 256 + wc * 32 + 4 * fq);
#pragma unroll
        for (int ai = 0; ai < 2; ++ai)
#pragma unroll
            for (int m = 0; m < 4; ++m) { const unsigned row = row0 + ai * 128 + m * 16;
#pragma unroll
                for (int bj = 0; bj < 2; ++bj)
#pragma unroll
                    for (int n = 0; n < 2; ++n) { const unsigned off = row * 1024u + col0 + bj * 128 + n * 16;
                        const u32x2 xb = ld8_agent(x1b + off);
                        f32x4 o = acc[ai][bj][m][n];
#ifndef P7_NOX
                        o[0] += bflo(xb.x); o[1] += bfhi(xb.x); o[2] += bflo(xb.y); o[3] += bfhi(xb.y);
#endif
                        *(f32x4*)(out + off) = o; }
                asm volatile("s_waitcnt vmcnt(24)" ::: "memory"); }
    }
};

__device__ __forceinline__ void p0_transpose_item(const float* W, int K, int ldw, int N, bf16_t* WT, const float* kscale, int skip_at, LAS float* scr, int item, int lane) {
    const int nblk = N / 32, kb = item / nblk, nb = item % nblk, k0 = 64 * kb, n0 = 32 * nb;
    const int src0 = n0 + (n0 >= skip_at ? 8 : 0);
#pragma unroll 8
    for (int i = 0; i < 32; ++i) { const int kk = 2 * i + (lane >> 5); float v = W[(size_t)(k0 + kk) * ldw + src0 + (lane & 31)]; if (kscale) v *= kscale[k0 + kk]; scr[kk * 33 + (lane & 31)] = v; }
    LDS_WAIT(); asm volatile("" ::: "memory");
    const int c = lane & 7;
#pragma unroll
    for (int j = 0; j < 4; ++j) { const int n = (lane >> 3) + 8 * j; const LAS float* s = scr + (8 * c) * 33 + n;
        u32x4 o; o.x = cvt_pk_bf16(s[0 * 33], s[1 * 33]); o.y = cvt_pk_bf16(s[2 * 33], s[3 * 33]); o.z = cvt_pk_bf16(s[4 * 33], s[5 * 33]); o.w = cvt_pk_bf16(s[6 * 33], s[7 * 33]);
        *(u32x4*)(WT + (size_t)(n0 + n) * K + k0 + 8 * c) = o; }
    LDS_WAIT(); asm volatile("" ::: "memory");
}

__device__ __forceinline__ void phase0(const Args& a, LAS unsigned char* lds, int vcu, int G) {
    const int tid = threadIdx.x, lane = tid & 63, wave = __builtin_amdgcn_readfirstlane(tid >> 6);
    unsigned char* ws = a.ws;
    LAS float* wab = (LAS float*)(lds + 8 * 8448);
    for (int e = tid; e < 8192; e += 512) wab[e] = a.in[I_WIN][(size_t)(e >> 3) * DIN + 2048 + (e & 7)];
    LAS float* scr = (LAS float*)(lds + wave * 8448);
    const int gw = vcu * 8 + wave, NGW = G * 8;
    constexpr int I_IN = 16 * 224, I_MKV = 16 * 32, I_BR = 8 * 32, I_O = 16 * 32, I_UP = 16 * 128, I_DN = 64 * 32;
    constexpr int NITEMS = I_IN + I_MKV + 3 * I_BR + I_O + I_UP + I_DN;
    for (int it = gw; it < NITEMS; it += NGW) {
        int r = it;
        if (r < I_IN) { p0_transpose_item(a.in[I_WIN], 1024, DIN, NPROJ, (bf16_t*)(ws + WS_WIN), nullptr, 2048, scr, r, lane); continue; } r -= I_IN;
        if (r < I_MKV) { p0_transpose_item(a.in[I_WMKV], 1024, 1024, 1024, (bf16_t*)(ws + WS_WMKV), nullptr, 1 << 30, scr, r, lane); continue; } r -= I_MKV;
        if (r < I_BR) { p0_transpose_item(a.in[I_WBRG], 512, 1024, 1024, (bf16_t*)(ws + WS_WBR), nullptr, 1 << 30, scr, r, lane); continue; } r -= I_BR;
        if (r < I_BR) { p0_transpose_item(a.in[I_WBRS], 512, 1024, 1024, (bf16_t*)(ws + WS_WBR) + (size_t)DM * BW, nullptr, 1 << 30, scr, r, lane); continue; } r -= I_BR;
        if (r < I_BR) { p0_transpose_item(a.in[I_WBRM], 512, 1024, 1024, (bf16_t*)(ws + WS_WBR) + (size_t)2 * DM * BW, nullptr, 1 << 30, scr, r, lane); continue; } r -= I_BR;
        if (r < I_O) { p0_transpose_item(a.in[I_WO], 1024, 1024, 1024, (bf16_t*)(ws + WS_WO), nullptr, 1 << 30, scr, r, lane); continue; } r -= I_O;
        if (r < I_UP) { p0_transpose_item(a.in[I_WUP], 1024, 4096, 4096, (bf16_t*)(ws + WS_WUP), a.in[I_N2G], 1 << 30, scr, r, lane); continue; } r -= I_UP;
        p0_transpose_item(a.in[I_WDN], 4096, 1024, 1024, (bf16_t*)(ws + WS_WDN), nullptr, 1 << 30, scr, r, lane);
    }
    __syncthreads();
    const float* g1 = a.in[I_N1G]; bf16_t* H = (bf16_t*)(ws + WS_H); float* AB = (float*)(ws + WS_AB);
    f32x4 gv[4];
#pragma unroll
    for (int j = 0; j < 4; ++j) gv[j] = *(const f32x4*)(g1 + 256 * j + 4 * lane);
    for (int m = gw; m < TOK; m += NGW) {
        const f32x4* xr = (const f32x4*)(a.in[I_X] + (size_t)m * DM) + lane;
        f32x4 v[4]; float s = 0.f;
#pragma unroll
        for (int j = 0; j < 4; ++j) { v[j] = xr[64 * j]; s += (v[j].x * v[j].x + v[j].y * v[j].y) + (v[j].z * v[j].z + v[j].w * v[j].w); }
        const float rstd = rsqrtf(wave_sum(s) * (1.f / DM) + EPS);
        float p[8];
#pragma unroll
        for (int c = 0; c < 8; ++c) p[c] = 0.f;
        u32x2* o8 = (u32x2*)(H + (size_t)m * DM) + lane;
#pragma unroll
        for (int j = 0; j < 4; ++j) { v[j] = v[j] * rstd * gv[j];
            u32x2 w; w.x = cvt_pk_bf16(v[j].x, v[j].y); w.y = cvt_pk_bf16(v[j].z, v[j].w); o8[64 * j] = w;
#pragma unroll
            for (int e = 0; e < 4; ++e) { const LAS f32x4* wp = (const LAS f32x4*)(wab + (256 * j + 4 * lane + e) * 8); const f32x4 w0 = wp[0], w1 = wp[1]; const float hv = v[j][e];
                p[0] += hv * w0.x; p[1] += hv * w0.y; p[2] += hv * w0.z; p[3] += hv * w0.w; p[4] += hv * w1.x; p[5] += hv * w1.y; p[6] += hv * w1.z; p[7] += hv * w1.w; } }
#pragma unroll
        for (int c = 0; c < 8; ++c) p[c] = wave_sum(p[c]);
        if (lane == 0) { f32x4* ab = (f32x4*)(AB + (size_t)m * 8); ab[0] = (f32x4){p[0], p[1], p[2], p[3]}; ab[1] = (f32x4){p[4], p[5], p[6], p[7]}; }
    }
    const float* gm = a.in[I_MEMNG]; bf16_t* MN = (bf16_t*)(ws + WS_MEMN);
#pragma unroll
    for (int j = 0; j < 4; ++j) gv[j] = *(const f32x4*)(gm + 256 * j + 4 * lane);
    for (int m = gw; m < NB * NMEM; m += NGW) {
        const f32x4* xr = (const f32x4*)(a.in[I_MEM] + (size_t)m * DM) + lane;
        f32x4 v[4]; float s = 0.f;
#pragma unroll
        for (int j = 0; j < 4; ++j) { v[j] = xr[64 * j]; s += (v[j].x * v[j].x + v[j].y * v[j].y) + (v[j].z * v[j].z + v[j].w * v[j].w); }
        const float rstd = rsqrtf(wave_sum(s) * (1.f / DM) + EPS);
        u32x2* o8 = (u32x2*)(MN + (size_t)m * DM) + lane;
#pragma unroll
        for (int j = 0; j < 4; ++j) { v[j] = v[j] * rstd * gv[j]; u32x2 w; w.x = cvt_pk_bf16(v[j].x, v[j].y); w.y = cvt_pk_bf16(v[j].z, v[j].w); o8[64 * j] = w; }
    }
}

constexpr int PQ_LD = 136;
__device__ __forceinline__ void gdn_prep_unit(const Args& a, LAS unsigned char* lds, int cid) {
    const int tid = threadIdx.x, lane = tid & 63, wave = __builtin_amdgcn_readfirstlane(tid >> 6), fr = lane & 15, fq = lane >> 4;
    unsigned char* ws = a.ws;
    const int n = cid & (NCH - 1), bh = cid >> 7, h = bh & 3, b = bh >> 2;
    const size_t row0 = (size_t)b * SEQ + (size_t)n * CHUNK;
    LAS bf16_t* Qb = (LAS bf16_t*)lds;
    LAS bf16_t* Kb = (LAS bf16_t*)(lds + 17408);
    LAS float* Kf = (LAS float*)(lds + 34816);
    LAS float* Vf = (LAS float*)(lds + 34816 + 32768);
    LAS float* Lm = (LAS float*)(lds + 34816 + 65536);
    LAS float* gcs = (LAS float*)(lds + 34816 + 65536 + 16384);
    LAS float* bet = gcs + 64;
    LAS float* bge = gcs + 128;
    const bf16_t* GQ = (const bf16_t*)(ws + WS_GQKV);
    if (wave == 0) {
        const float* AB = (const float*)(ws + WS_AB) + (row0 + lane) * 8;
        const float al = AB[h], bl = AB[4 + h];
        float g = -__expf(a.in[I_ALOG][h]) * softplusf_(al + a.in[I_DTB][h]);
#pragma unroll
        for (int o = 1; o < 64; o <<= 1) { const float t = __shfl_up(g, o); if (lane >= o) g += t; }
        const float be = sigmoidf_(bl);
        gcs[lane] = g; bet[lane] = be; bge[lane] = be * __expf(g);
        { const float gle = __expf(__shfl(g, 63)); if (lane < 32) ((float*)(ws + WS_GL))[cid * 32 + lane] = gle; }
    }
    {
        const float* cw = a.in[I_CONVW];
        float wq[4][2], wk[4][2], wv[4][2];
#pragma unroll
        for (int j = 0; j < 4; ++j) { const float* p = cw + j * 1536 + h * 128 + 2 * lane; wq[j][0] = p[0]; wq[j][1] = p[1]; wk[j][0] = p[512]; wk[j][1] = p[513]; wv[j][0] = p[1024]; wv[j][1] = p[1025]; }
        unsigned rq[11], rk[11], rv[11];
#pragma unroll
        for (int i = 0; i < 11; ++i) { const int rr = wave * 8 + i - 3; const bool ok = (n > 0) || (rr >= 0);
            const bf16_t* p = GQ + (row0 + rr) * 1536 + h * 128 + 2 * lane;
            rq[i] = ok ? *(const unsigned*)p : 0u; rk[i] = ok ? *(const unsigned*)(p + 512) : 0u; rv[i] = ok ? *(const unsigned*)(p + 1024) : 0u; }
#pragma unroll
        for (int i = 0; i < 8; ++i) { const int r = wave * 8 + i;
            float q0 = 0.f, q1 = 0.f, k0 = 0.f, k1 = 0.f, v0 = 0.f, v1 = 0.f;
#pragma unroll
            for (int j = 0; j < 4; ++j) { q0 += wq[j][0] * bflo(rq[i + j]); q1 += wq[j][1] * bfhi(rq[i + j]); k0 += wk[j][0] * bflo(rk[i + j]); k1 += wk[j][1] * bfhi(rk[i + j]);
                v0 += wv[j][0] * bflo(rv[i + j]); v1 += wv[j][1] * bfhi(rv[i + j]); }
            q0 *= sigmoidf_(q0); q1 *= sigmoidf_(q1); k0 *= sigmoidf_(k0); k1 *= sigmoidf_(k1); v0 *= sigmoidf_(v0); v1 *= sigmoidf_(v1);
            const float qn = rsqrtf(wave_sum(q0 * q0 + q1 * q1) + EPS) * 0.08838834764831845f, kn = rsqrtf(wave_sum(k0 * k0 + k1 * k1) + EPS);
            q0 *= qn; q1 *= qn; k0 *= kn; k1 *= kn;
            *(LAS unsigned*)(Qb + r * PQ_LD + 2 * lane) = cvt_pk_bf16(q0, q1);
            *(LAS unsigned*)(Kb + r * PQ_LD + 2 * lane) = cvt_pk_bf16(k0, k1);
            *(LAS f32x2*)(Kf + r * 128 + 2 * lane) = (f32x2){k0, k1};
            *(LAS f32x2*)(Vf + r * 128 + 2 * lane) = (f32x2){v0, v1}; }
    }
    __syncthreads();
    {
        const int mat = wave >> 2, ct = wave & 3;
        const LAS bf16_t* Xb = mat ? Qb : Kb;
        bf16x8 xf[4];
#pragma unroll
        for (int ks = 0; ks < 4; ++ks) xf[ks] = *(const LAS bf16x8*)(Xb + (ct * 16 + fr) * PQ_LD + ks * 32 + 8 * fq);
        bf16_t* Ag = (bf16_t*)(ws + WS_GDNI + GI_A) + (size_t)cid * 4096;
#pragma unroll
        for (int st = 0; st < 4; ++st) {
            f32x4 d = (f32x4){0.f, 0.f, 0.f, 0.f};
#pragma unroll
            for (int ks = 0; ks < 4; ++ks) { const bf16x8 yf = *(const LAS bf16x8*)(Kb + (st * 16 + fr) * PQ_LD + ks * 32 + 8 * fq); d = MFMA16(xf[ks], yf, d); }
            const int s = st * 16 + fr; const float gs = gcs[s];
#pragma unroll
            for (int i = 0; i < 4; ++i) { const int c = ct * 16 + 4 * fq + i; const float dec = __expf(fminf(gcs[c] - gs, 0.f));
                if (mat == 0) Lm[c * 64 + s] = (c > s) ? bet[c] * d[i] * dec : 0.f;
                else Ag[c * 64 + s] = (bf16_t)(cvt_pk_bf16((c >= s) ? d[i] * dec : 0.f, 0.f) & 0xffffu); }
        }
    }
    __syncthreads();
    const size_t gbase = (size_t)cid * 8192;
    if (wave < 4) {
        const int col = (wave & 1) * 64 + lane; const bool isw = wave >= 2;
        const LAS float* src = isw ? Kf : Vf; const LAS float* scl = isw ? bge : bet;
        float xv[64]; int opq; asm volatile("v_mov_b32 %0, 0" : "=v"(opq));
        const LAS float* Lmv = Lm + opq;
#pragma unroll
        for (int i = 0; i < 64; ++i) xv[i] = 0.f;
#pragma unroll
        for (int i = 0; i < 64; ++i) {
            float r = src[i * 128 + col] * scl[i];
#pragma unroll
            for (int j4 = 0; j4 < (i + 3) / 4; ++j4) { const f32x4 lv = *(const LAS f32x4*)(Lmv + i * 64 + 4 * j4);
                r -= lv.x * xv[4 * j4]; r -= lv.y * xv[4 * j4 + 1]; r -= lv.z * xv[4 * j4 + 2]; r -= lv.w * xv[4 * j4 + 3]; }
            xv[i] = r;
        }
        if (!isw) {
            u32x4* up = (u32x4*)((bf16_t*)(ws + WS_GDNI + GI_UT) + gbase + (size_t)col * 64);
#pragma unroll
            for (int j = 0; j < 8; ++j) { u32x4 w; w.x = cvt_pk_bf16(xv[8 * j], xv[8 * j + 1]); w.y = cvt_pk_bf16(xv[8 * j + 2], xv[8 * j + 3]); w.z = cvt_pk_bf16(xv[8 * j + 4], xv[8 * j + 5]); w.w = cvt_pk_bf16(xv[8 * j + 6], xv[8 * j + 7]); up[j] = w; }
        } else {
            bf16_t* wp = (bf16_t*)(ws + WS_GDNI + GI_W) + gbase + col;
#pragma unroll
            for (int i = 0; i < 64; ++i) wp[i * 128] = (bf16_t)(cvt_pk_bf16(xv[i], 0.f) & 0xffffu);
        }
    } else {
        const int t = tid - 256; const float gl = gcs[63];
        bf16_t* qd = (bf16_t*)(ws + WS_GDNI + GI_QD) + gbase; bf16_t* kdt = (bf16_t*)(ws + WS_GDNI + GI_KDT) + gbase;
#pragma unroll
        for (int j = 0; j < 4; ++j) { const int task = t + 256 * j, c = task >> 4, seg = task & 15; const float e = __expf(gcs[c]);
            const u32x4 qv = *(const LAS u32x4*)(Qb + c * PQ_LD + seg * 8);
            u32x4 w; w.x = cvt_pk_bf16(bflo(qv.x) * e, bfhi(qv.x) * e); w.y = cvt_pk_bf16(bflo(qv.y) * e, bfhi(qv.y) * e); w.z = cvt_pk_bf16(bflo(qv.z) * e, bfhi(qv.z) * e); w.w = cvt_pk_bf16(bflo(qv.w) * e, bfhi(qv.w) * e);
            *(u32x4*)(qd + c * 128 + seg * 8) = w; }
#pragma unroll
        for (int j = 0; j < 4; ++j) { const int task = t + 256 * j, dk = task & 127, c8 = task >> 7; float v[8];
#pragma unroll
            for (int e = 0; e < 8; ++e) { const int c = c8 * 8 + e; v[e] = Kf[c * 128 + dk] * __expf(gl - gcs[c]); }
            u32x4 w; w.x = cvt_pk_bf16(v[0], v[1]); w.y = cvt_pk_bf16(v[2], v[3]); w.z = cvt_pk_bf16(v[4], v[5]); w.w = cvt_pk_bf16(v[6], v[7]);
            *(u32x4*)(kdt + dk * 64 + c8 * 8) = w; }
    }
    __syncthreads();
}

constexpr int ST_LD = 136, VN_LD = 72;
__device__ __forceinline__ void gdn_scan_unit(const Args& a, LAS unsigned char* lds, int bh) {
    const int tid = threadIdx.x, lane = tid & 63, wave = __builtin_amdgcn_readfirstlane(tid >> 6), fr = lane & 15, fq = lane >> 4;
    unsigned char* ws = a.ws;
    const int h = bh & 3, b = bh >> 2;
    LAS bf16_t* St = (LAS bf16_t*)lds;
    LAS bf16_t* VNt = (LAS bf16_t*)(lds + 2 * 128 * ST_LD * 2);
    LAS float* red = (LAS float*)(lds + 2 * 128 * ST_LD * 2 + 128 * VN_LD * 2);
    for (int e = tid; e < 128 * ST_LD / 2; e += 512) ((LAS unsigned*)St)[e] = 0u;
    f32x4 sacc[8];
#pragma unroll
    for (int j = 0; j < 8; ++j) sacc[j] = (f32x4){0.f, 0.f, 0.f, 0.f};
    const int ct = wave >> 1, dvh = wave & 1;
    const bf16_t* Wg = (const bf16_t*)(ws + WS_GDNI + GI_W); const bf16_t* QDg = (const bf16_t*)(ws + WS_GDNI + GI_QD);
    const bf16_t* KDTg = (const bf16_t*)(ws + WS_GDNI + GI_KDT); const bf16_t* UTg = (const bf16_t*)(ws + WS_GDNI + GI_UT); const bf16_t* Ag = (const bf16_t*)(ws + WS_GDNI + GI_A);
    const float* GL = (const float*)(ws + WS_GL);
    const bf16_t* GZ = (const bf16_t*)(ws + WS_GZ); bf16_t* OG = (bf16_t*)(ws + WS_OG);
    f32x4 gng[4];
#pragma unroll
    for (int j = 0; j < 4; ++j) gng[j] = *(const f32x4*)(a.in[I_GDNG] + (dvh * 4 + j) * 16 + 4 * fq);
    __syncthreads();
    for (int n = 0; n < NCH; ++n) {
        const int cid = bh * NCH + n; const size_t gb = (size_t)cid * 8192;
        const LAS bf16_t* Sc = St + (n & 1) * 128 * ST_LD; LAS bf16_t* Sn = St + ((n + 1) & 1) * 128 * ST_LD;
        bf16x8 wf[4], qf[4], af[2], kf[2];
#pragma unroll
        for (int ks = 0; ks < 4; ++ks) { wf[ks] = *(const bf16x8*)(Wg + gb + (ct * 16 + fr) * 128 + ks * 32 + 8 * fq); qf[ks] = *(const bf16x8*)(QDg + gb + (ct * 16 + fr) * 128 + ks * 32 + 8 * fq); }
#pragma unroll
        for (int ks = 0; ks < 2; ++ks) { af[ks] = *(const bf16x8*)(Ag + (size_t)cid * 4096 + (ct * 16 + fr) * 64 + ks * 32 + 8 * fq); kf[ks] = *(const bf16x8*)(KDTg + gb + (wave * 16 + fr) * 64 + ks * 32 + 8 * fq); }
        u32x2 uv[4], zv[4];
        const size_t trow = (size_t)b * SEQ + (size_t)n * CHUNK + ct * 16 + fr;
#pragma unroll
        for (int j = 0; j < 4; ++j) { const int dvt = dvh * 4 + j; uv[j] = *(const u32x2*)(UTg + gb + (dvt * 16 + fr) * 64 + ct * 16 + 4 * fq);
            zv[j] = *(const u32x2*)(GZ + trow * 512 + h * 128 + dvt * 16 + 4 * fq); }
        float gl; (void)GL;
        { const float* abp = (const float*)(ws + WS_AB) + ((size_t)b * SEQ + (size_t)n * CHUNK + lane) * 8;
          gl = __expf(wave_sum(-__expf(a.in[I_ALOG][h]) * softplusf_(abp[h] + a.in[I_DTB][h]))); }
#pragma unroll
        for (int j = 0; j < 4; ++j) { const int dvt = dvh * 4 + j; f32x4 d = (f32x4){0.f, 0.f, 0.f, 0.f};
#pragma unroll
            for (int ks = 0; ks < 4; ++ks) { const bf16x8 yf = *(const LAS bf16x8*)(Sc + (dvt * 16 + fr) * ST_LD + ks * 32 + 8 * fq); d = MFMA16(wf[ks], yf, d); }
            const float v0 = bflo(uv[j].x) - d[0], v1 = bfhi(uv[j].x) - d[1], v2 = bflo(uv[j].y) - d[2], v3 = bfhi(uv[j].y) - d[3];
            u32x2 w; w.x = cvt_pk_bf16(v0, v1); w.y = cvt_pk_bf16(v2, v3);
            *(LAS u32x2*)(VNt + (dvt * 16 + fr) * VN_LD + ct * 16 + 4 * fq) = w; }
        __syncthreads();
        f32x4 oacc[4]; float ss = 0.f;
#pragma unroll
        for (int j = 0; j < 4; ++j) { const int dvt = dvh * 4 + j; f32x4 d = (f32x4){0.f, 0.f, 0.f, 0.f};
#pragma unroll
            for (int ks = 0; ks < 4; ++ks) { const bf16x8 xf = *(const LAS bf16x8*)(Sc + (dvt * 16 + fr) * ST_LD + ks * 32 + 8 * fq); d = MFMA16(xf, qf[ks], d); }
#pragma unroll
            for (int ks = 0; ks < 2; ++ks) { const bf16x8 xf = *(const LAS bf16x8*)(VNt + (dvt * 16 + fr) * VN_LD + ks * 32 + 8 * fq); d = MFMA16(xf, af[ks], d); }
            oacc[j] = d; ss += (d[0] * d[0] + d[1] * d[1]) + (d[2] * d[2] + d[3] * d[3]); }
        ss += __shfl_xor(ss, 16); ss += __shfl_xor(ss, 32);
        if (fq == 0) red[(ct * 2 + dvh) * 16 + fr] = ss;
#pragma unroll
        for (int j = 0; j < 8; ++j) { f32x4 d = sacc[j] * gl;
#pragma unroll
            for (int ks = 0; ks < 2; ++ks) { const bf16x8 yf = *(const LAS bf16x8*)(VNt + (j * 16 + fr) * VN_LD + ks * 32 + 8 * fq); d = MFMA16(kf[ks], yf, d); }
            sacc[j] = d;
            u32x2 w; w.x = cvt_pk_bf16_mfma(d[0], d[1]); w.y = cvt_pk_bf16_mfma(d[2], d[3]);
            *(LAS u32x2*)(Sn + (j * 16 + fr) * ST_LD + wave * 16 + 4 * fq) = w; }
        __syncthreads();
        const float tot = red[(ct * 2) * 16 + fr] + red[(ct * 2 + 1) * 16 + fr];
        const float rstd = rsqrtf(tot * (1.f / HD) + EPS);
#pragma unroll
        for (int j = 0; j < 4; ++j) { const int dvt = dvh * 4 + j;
            const float z0 = bflo(zv[j].x), z1 = bfhi(zv[j].x), z2 = bflo(zv[j].y), z3 = bfhi(zv[j].y);
            const float o0 = oacc[j][0] * rstd * gng[j][0] * (z0 * sigmoidf_(z0)), o1 = oacc[j][1] * rstd * gng[j][1] * (z1 * sigmoidf_(z1));
            const float o2 = oacc[j][2] * rstd * gng[j][2] * (z2 * sigmoidf_(z2)), o3 = oacc[j][3] * rstd * gng[j][3] * (z3 * sigmoidf_(z3));
            u32x2 w; w.x = cvt_pk_bf16(o0, o1); w.y = cvt_pk_bf16(o2, o3);
            *(u32x2*)(OG + trow * 512 + h * 128 + dvt * 16 + 4 * fq) = w; }
    }
    __syncthreads();
}

constexpr int KS_LD = 136, VT_LD = 72;
__device__ __forceinline__ void sb_unit(const Args& a, LAS unsigned char* lds, int uid) {
    const int tid = threadIdx.x, lane = tid & 63, wave = __builtin_amdgcn_readfirstlane(tid >> 6), fr = lane & 15, fq = lane >> 4;
    const int qb = uid & 63, bh = uid >> 6, h = bh & 3, b = bh >> 2;
    const bf16_t* SQ = (const bf16_t*)(a.ws + WS_SQKV); bf16_t* OS = (bf16_t*)(a.ws + WS_OS);
    LAS bf16_t* Ks = (LAS bf16_t*)lds;
    LAS bf16_t* Vt = (LAS bf16_t*)(lds + 64 * KS_LD * 2);
    LAS int* flags = (LAS int*)(lds + 64 * KS_LD * 2 + 128 * VT_LD * 2);
    const int q0 = qb * 128, tq = q0 + wave * 16 + fr;
    const size_t brow = (size_t)b * SEQ;
    bf16x8 qf[4];
    {
        u32x4 raw[4]; float s = 0.f;
#pragma unroll
        for (int ks = 0; ks < 4; ++ks) { raw[ks] = *(const u32x4*)(SQ + (brow + tq) * 1536 + h * 128 + ks * 32 + 8 * fq);
#pragma unroll
            for (int e = 0; e < 4; ++e) { const float lo = bflo(raw[ks][e]), hi = bfhi(raw[ks][e]); s += lo * lo + hi * hi; } }
        s += __shfl_xor(s, 16); s += __shfl_xor(s, 32);
        const float rs = rsqrtf(s * (1.f / HD) + EPS) * 0.08838834764831845f;
#pragma unroll
        for (int ks = 0; ks < 4; ++ks) { const float* gp = a.in[I_SBQG] + ks * 32 + 8 * fq; u32x4 w;
#pragma unroll
            for (int e = 0; e < 4; ++e) w[e] = cvt_pk_bf16(bflo(raw[ks][e]) * rs * gp[2 * e], bfhi(raw[ks][e]) * rs * gp[2 * e + 1]);
            qf[ks] = __builtin_bit_cast(bf16x8, w); }
    }
    f32x4 oacc[8];
#pragma unroll
    for (int j = 0; j < 8; ++j) oacc[j] = (f32x4){0.f, 0.f, 0.f, 0.f};
    float carry = 0.f;
    for (int kt = qb * 2 + 1; kt >= 0; --kt) {
#pragma unroll
        for (int j = 0; j < 2; ++j) { const int task = tid + 512 * j, r = task >> 4, seg = task & 15;
            const bf16_t* kp = SQ + (brow + kt * 64 + r) * 1536 + 512 + h * 128 + seg * 8;
            const u32x4 kr = *(const u32x4*)kp; const u32x4 vr = *(const u32x4*)(kp + 512);
            float s = 0.f;
#pragma unroll
            for (int e = 0; e < 4; ++e) { const float lo = bflo(kr[e]), hi = bfhi(kr[e]); s += lo * lo + hi * hi; }
            s += __shfl_xor(s, 1); s += __shfl_xor(s, 2); s += __shfl_xor(s, 4); s += __shfl_xor(s, 8);
            const float rs = rsqrtf(s * (1.f / HD) + EPS); const float* gp = a.in[I_SBKG] + seg * 8; u32x4 w;
#pragma unroll
            for (int e = 0; e < 4; ++e) w[e] = cvt_pk_bf16(bflo(kr[e]) * rs * gp[2 * e], bfhi(kr[e]) * rs * gp[2 * e + 1]);
            *(LAS u32x4*)(Ks + r * KS_LD + seg * 8) = w;
            const int xt = r >> 4, kfq = (r & 15) >> 2, ii = r & 3, slot = (xt >> 1) * 32 + kfq * 8 + (xt & 1) * 4 + ii;
#pragma unroll
            for (int e = 0; e < 4; ++e) { Vt[(seg * 8 + 2 * e) * VT_LD + slot] = (bf16_t)(vr[e] & 0xffffu); Vt[(seg * 8 + 2 * e + 1) * VT_LD + slot] = (bf16_t)(vr[e] >> 16); } }
        __syncthreads();
        f32x4 z[4];
#pragma unroll
        for (int xt = 0; xt < 4; ++xt) { f32x4 d = (f32x4){0.f, 0.f, 0.f, 0.f};
#pragma unroll
            for (int ks = 0; ks < 4; ++ks) { const bf16x8 xf = *(const LAS bf16x8*)(Ks + (xt * 16 + fr) * KS_LD + ks * 32 + 8 * fq); d = MFMA16(xf, qf[ks], d); }
            z[xt] = d; }
        float s4[4], lsg[4][4]; bool val[4][4];
#pragma unroll
        for (int xt = 0; xt < 4; ++xt) { s4[xt] = 0.f;
#pragma unroll
            for (int i = 0; i < 4; ++i) { const int key = kt * 64 + xt * 16 + 4 * fq + i; val[xt][i] = key < tq;
                const float sp = softplusf_(z[xt][i]); const float l = val[xt][i] ? -sp : 0.f; lsg[xt][i] = z[xt][i] - sp; z[xt][i] = l; s4[xt] += l; } }
        float R[4], Hh[4];
#pragma unroll
        for (int xt = 0; xt < 4; ++xt) { const float v1 = __shfl_xor(s4[xt], 16), v2 = __shfl_xor(s4[xt], 32), v3 = __shfl_xor(s4[xt], 48);
            R[xt] = s4[xt] + v1 + v2 + v3;
            Hh[xt] = (((fq ^ 1) > fq) ? v1 : 0.f) + (((fq ^ 2) > fq) ? v2 : 0.f) + (((fq ^ 3) > fq) ? v3 : 0.f); }
        float above = carry;
        u32x4 pw[2];
#pragma unroll
        for (int xt = 3; xt >= 0; --xt) { const float base = above + Hh[xt];
            const float b3 = base, b2 = b3 + z[xt][3], b1 = b2 + z[xt][2], b0 = b1 + z[xt][1];
            const float p0 = val[xt][0] ? __expf(lsg[xt][0] + b0) : 0.f, p1 = val[xt][1] ? __expf(lsg[xt][1] + b1) : 0.f;
            const float p2 = val[xt][2] ? __expf(lsg[xt][2] + b2) : 0.f, p3 = val[xt][3] ? __expf(lsg[xt][3] + b3) : 0.f;
            pw[xt >> 1][(xt & 1) * 2] = cvt_pk_bf16(p0, p1); pw[xt >> 1][(xt & 1) * 2 + 1] = cvt_pk_bf16(p2, p3);
            above += R[xt]; }
        carry = above;
#pragma unroll
        for (int ks = 0; ks < 2; ++ks) { const bf16x8 pf = __builtin_bit_cast(bf16x8, pw[ks]);
#pragma unroll
            for (int dt = 0; dt < 8; ++dt) { const bf16x8 xf = *(const LAS bf16x8*)(Vt + (dt * 16 + fr) * VT_LD + ks * 32 + 8 * fq); oacc[dt] = MFMA16(xf, pf, oacc[dt]); } }
        const bool done = __all(carry < -110.0f);
        if (lane == 0) flags[wave] = done ? 1 : 0;
        __syncthreads();
        int alld = 1;
#pragma unroll
        for (int w = 0; w < 8; ++w) alld &= flags[w];
        if (alld) break;
        __syncthreads();
    }
#pragma unroll
    for (int dt = 0; dt < 8; ++dt) { u32x2 w; w.x = cvt_pk_bf16(oacc[dt][0], oacc[dt][1]); w.y = cvt_pk_bf16(oacc[dt][2], oacc[dt][3]);
        *(u32x2*)(OS + (brow + tq) * 512 + h * 128 + dt * 16 + 4 * fq) = w; }
    __syncthreads();
}

constexpr int MK_LD = 136, MV_LD = 264;
__device__ __forceinline__ void mem_unit(const Args& a, LAS unsigned char* lds, int uid) {
    const int tid = threadIdx.x, lane = tid & 63, wave = __builtin_amdgcn_readfirstlane(tid >> 6), fr = lane & 15, fq = lane >> 4;
    const int qb = uid & 31, bh = uid >> 5, h = bh & 3, b = bh >> 2;
    bf16_t* MQ = (bf16_t*)(a.ws + WS_MQ); const bf16_t* KV = (const bf16_t*)(a.ws + WS_MEMKV);
    LAS bf16_t* Km = (LAS bf16_t*)lds;
    LAS bf16_t* Vt = (LAS bf16_t*)(lds + 256 * MK_LD * 2);
#pragma unroll
    for (int j = 0; j < 8; ++j) { const int task = tid + 512 * j, r = task >> 4, seg = task & 15;
        const bf16_t* kp = KV + (size_t)(b * NMEM + r) * 1024 + h * 128 + seg * 8;
        const u32x4 kr = *(const u32x4*)kp; const u32x4 vr = *(const u32x4*)(kp + 512);
        float s = 0.f;
#pragma unroll
        for (int e = 0; e < 4; ++e) { const float lo = bflo(kr[e]), hi = bfhi(kr[e]); s += lo * lo + hi * hi; }
        s += __shfl_xor(s, 1); s += __shfl_xor(s, 2); s += __shfl_xor(s, 4); s += __shfl_xor(s, 8);
        const float rs = rsqrtf(s * (1.f / HD) + EPS); const float* gp = a.in[I_MKG] + seg * 8; u32x4 w;
#pragma unroll
        for (int e = 0; e < 4; ++e) w[e] = cvt_pk_bf16(bflo(kr[e]) * rs * gp[2 * e], bfhi(kr[e]) * rs * gp[2 * e + 1]);
        *(LAS u32x4*)(Km + r * MK_LD + seg * 8) = w;
        const int xt = r >> 4, kfq = (r & 15) >> 2, ii = r & 3, slot = (xt >> 1) * 32 + kfq * 8 + (xt & 1) * 4 + ii;
#pragma unroll
        for (int e = 0; e < 4; ++e) { Vt[(seg * 8 + 2 * e) * MV_LD + slot] = (bf16_t)(vr[e] & 0xffffu); Vt[(seg * 8 + 2 * e + 1) * MV_LD + slot] = (bf16_t)(vr[e] >> 16); } }
    __syncthreads();
    for (int pass = 0; pass < 2; ++pass) {
        const size_t trow = (size_t)b * SEQ + qb * 256 + pass * 128 + wave * 16 + fr;
        bf16x8 qf[4];
        {
            u32x4 raw[4]; float s = 0.f;
#pragma unroll
            for (int ks = 0; ks < 4; ++ks) { raw[ks] = *(const u32x4*)(MQ + trow * 512 + h * 128 + ks * 32 + 8 * fq);
#pragma unroll
                for (int e = 0; e < 4; ++e) { const float lo = bflo(raw[ks][e]), hi = bfhi(raw[ks][e]); s += lo * lo + hi * hi; } }
            s += __shfl_xor(s, 16); s += __shfl_xor(s, 32);
            const float rs = rsqrtf(s * (1.f / HD) + EPS) * 0.08838834764831845f;
#pragma unroll
            for (int ks = 0; ks < 4; ++ks) { const float* gp = a.in[I_MQG] + ks * 32 + 8 * fq; u32x4 w;
#pragma unroll
                for (int e = 0; e < 4; ++e) w[e] = cvt_pk_bf16(bflo(raw[ks][e]) * rs * gp[2 * e], bfhi(raw[ks][e]) * rs * gp[2 * e + 1]);
                qf[ks] = __builtin_bit_cast(bf16x8, w); }
        }
        f32x4 z[16]; float mx = -3.0e38f;
#pragma unroll
        for (int xt = 0; xt < 16; ++xt) { f32x4 d = (f32x4){0.f, 0.f, 0.f, 0.f};
#pragma unroll
            for (int ks = 0; ks < 4; ++ks) { const bf16x8 xf = *(const LAS bf16x8*)(Km + (xt * 16 + fr) * MK_LD + ks * 32 + 8 * fq); d = MFMA16(xf, qf[ks], d); }
            z[xt] = d; mx = fmaxf(mx, fmaxf(fmaxf(d[0], d[1]), fmaxf(d[2], d[3]))); }
        mx = fmaxf(mx, __shfl_xor(mx, 16)); mx = fmaxf(mx, __shfl_xor(mx, 32));
        float sum = 0.f;
#pragma unroll
        for (int xt = 0; xt < 16; ++xt) {
#pragma unroll
            for (int i = 0; i < 4; ++i) { const float p = __expf(z[xt][i] - mx); z[xt][i] = p; sum += p; } }
        sum += __shfl_xor(sum, 16); sum += __shfl_xor(sum, 32);
        const float inv = 1.0f / sum;
        f32x4 oacc[8];
#pragma unroll
        for (int j = 0; j < 8; ++j) oacc[j] = (f32x4){0.f, 0.f, 0.f, 0.f};
#pragma unroll
        for (int ks = 0; ks < 8; ++ks) { u32x4 pw; pw.x = cvt_pk_bf16(z[2 * ks][0], z[2 * ks][1]); pw.y = cvt_pk_bf16(z[2 * ks][2], z[2 * ks][3]); pw.z = cvt_pk_bf16(z[2 * ks + 1][0], z[2 * ks + 1][1]); pw.w = cvt_pk_bf16(z[2 * ks + 1][2], z[2 * ks + 1][3]);
            const bf16x8 pf = __builtin_bit_cast(bf16x8, pw);
#pragma unroll
            for (int dt = 0; dt < 8; ++dt) { const bf16x8 xf = *(const LAS bf16x8*)(Vt + (dt * 16 + fr) * MV_LD + ks * 32 + 8 * fq); oacc[dt] = MFMA16(xf, pf, oacc[dt]); } }
#pragma unroll
        for (int dt = 0; dt < 8; ++dt) { u32x2 w; w.x = cvt_pk_bf16(oacc[dt][0] * inv, oacc[dt][1] * inv); w.y = cvt_pk_bf16(oacc[dt][2] * inv, oacc[dt][3] * inv);
            *(u32x2*)(MQ + trow * 512 + h * 128 + dt * 16 + 4 * fq) = w; }
    }
    __syncthreads();
}

__device__ __forceinline__ void l2_flush(const float* x, int bx, int tid, float* sink) {
    const f32x4* p = (const f32x4*)x + (size_t)bx * 32768 + tid;
    f32x4 a = (f32x4){0.f, 0.f, 0.f, 0.f};
#pragma unroll 8
    for (int i = 0; i < 64; ++i) a += p[(size_t)i * 512];
    if (a[0] + a[1] + a[2] + a[3] == 1.2345e38f) *sink = a[0];
}

__global__ void __launch_bounds__(512) fwd_megakernel(Args args) {
    extern __shared__ __attribute__((aligned(16))) unsigned char lds_raw[];
    LAS unsigned char* lds = (LAS unsigned char*)lds_raw;
    cg::grid_group grid = cg::this_grid();
    const int G = gridDim.x, bx = blockIdx.x, tid = threadIdx.x;
    const int vcu = (G % 8 == 0) ? (bx % 8) * (G / 8) + bx / 8 : bx;
    unsigned char* ws = args.ws;
    unsigned* ctl = (unsigned*)(ws + WS_CTL);
    LAS int* qslot = (LAS int*)(lds + LDS_BYTES - 64);
    const int lo = args.ph_lo, hi = args.ph_hi;
#ifndef PH_MASK
#define PH_MASK 0x1ff
#endif
#define INR(k) (lo <= (k) && (k) < hi)
#define IN(k) (((PH_MASK >> (k)) & 1) && INR(k))
#define SEAM(k) do { if (INR(k) && INR((k) + 1)) { asm volatile("s_waitcnt vmcnt(0)" ::: "memory"); grid.sync(); \
        __builtin_amdgcn_fence(__ATOMIC_ACQUIRE, "agent"); asm volatile("s_waitcnt vmcnt(0)" ::: "memory"); } } while (0)

    if (IN(0)) phase0(args, lds, vcu, G);
    SEAM(0);
#ifdef TEST_GEMM
    if (IN(1)) {
        EpiP7 E{(const bf16_t*)(ws + WS_H), args.out};
        SchedGrid S{(const char*)(ws + WS_H), (const char*)(ws + WS_WO), TOK / 256, DM / 256, G, bx, (size_t)256 * 1024 * 2};
        pg8::gemm_phase<EpiP7, SchedGrid, true, true>(lds, 1024, S, E);
    }
#endif
#ifdef TEST_GEMM
    if (false) {
#else
    if (IN(1)) {
#endif
        EpiP1 E{(bf16_t*)(ws + WS_GQKV), (bf16_t*)(ws + WS_GZ), (bf16_t*)(ws + WS_SQKV), (bf16_t*)(ws + WS_MQ), (bf16_t*)(ws + WS_GATES), (bf16_t*)(ws + WS_MEMKV), 0};
        SchedGrid S{(const char*)(ws + WS_H), (const char*)(ws + WS_WIN), TOK / 256, 16, G, bx, (size_t)256 * 1024 * 2};
        pg8::gemm_phase<EpiP1, SchedGrid, true, true>(lds, 1024, S, E);
        EpiP1 E2 = E; E2.is_mem = 1;
        SchedGrid S2{(const char*)(ws + WS_MEMN), (const char*)(ws + WS_WMKV), 4, 4, G, bx, (size_t)256 * 1024 * 2};
        pg8::gemm_phase<EpiP1, SchedGrid, true, true>(lds, 1024, S2, E2);
    }
    SEAM(1);
    if (IN(2)) { for (int cid = bx; cid < NB * NH * NCH; cid += G) gdn_prep_unit(args, lds, cid); }
    SEAM(2);
    if (IN(3)) {
        if (bx < NB * NH) gdn_scan_unit(args, lds, bx);
        for (;;) {
            if (tid == 0) *qslot = (int)atomicAdd(ctl + 64, 1u);
            __syncthreads();
            const int it = *qslot;
            __syncthreads();
            if (it >= 1024 + 512) break;
            if (it < 1024) sb_unit(args, lds, it); else mem_unit(args, lds, it - 1024);
        }
    }
    SEAM(3);
    if (IN(4)) {
        EpiP1 E{(bf16_t*)(ws + WS_GQKV), (bf16_t*)(ws + WS_GZ), (bf16_t*)(ws + WS_SQKV), (bf16_t*)(ws + WS_MQ), (bf16_t*)(ws + WS_GATES), (bf16_t*)(ws + WS_MEMKV), 2};
        SchedGrid S{(const char*)(ws + WS_H), (const char*)(ws + WS_WIN) + (size_t)4096 * 1024 * 2, TOK / 256, 12, G, bx, (size_t)256 * 1024 * 2};
        pg8::gemm_phase<EpiP1, SchedGrid, true, true>(lds, 1024, S, E);
    }
    SEAM(4);
    if (IN(5)) {
        EpiP3 E{(const bf16_t*)(ws + WS_GATES), (float*)(ws + WS_MIXF + (size_t)bx * 262144), (bf16_t*)(ws + WS_MIX)};
        SchedBranch S{(const char*)(ws + WS_OG), (const char*)(ws + WS_OS), (const char*)(ws + WS_MQ), (const char*)(ws + WS_WBR), G, bx, (size_t)256 * 512 * 2};
        pg8::gemm_phase<EpiP3, SchedBranch, true, true>(lds, 512, S, E);
    }
    SEAM(5);
    if (IN(6)) {
        EpiP4 E{args.in[I_X], args.out, (bf16_t*)(ws + WS_X1B), (float*)(ws + WS_SSQ)};
        SchedGrid S{(const char*)(ws + WS_MIX), (const char*)(ws + WS_WO), TOK / 256, DM / 256, G, bx, (size_t)256 * 1024 * 2};
        pg8::gemm_phase<EpiP4, SchedGrid, true, true>(lds, 1024, S, E);
    }
    SEAM(6);
    if (IN(7)) {
        EpiP6 E{(const float*)(ws + WS_SSQ), (bf16_t*)(ws + WS_ACT)};
        SchedGrid S{(const char*)(ws + WS_X1B), (const char*)(ws + WS_WUP), TOK / 256, DFF / 256, G, bx, (size_t)256 * 1024 * 2};
        pg8::gemm_phase<EpiP6, SchedGrid, true, true>(lds, 1024, S, E);
    }
    SEAM(7);
    if (IN(8)) {
#ifdef P7_VIA_WS
        EpiP7 E{(const bf16_t*)(ws + WS_X1B), (float*)(ws + 46 * MiB)};
#else
        EpiP7 E{(const bf16_t*)(ws + WS_X1B), args.out};
#endif
#ifdef TEST_P7
        E.x1b = (const bf16_t*)(ws + TEST_A);
        SchedGrid S{(const char*)(ws + TEST_A), (const char*)(ws + WS_WO), TOK / 256, DM / 256, G, bx, (size_t)256 * 1024 * 2};
        pg8::gemm_phase<EpiP7, SchedGrid, true, true>(lds, 1024, S, E);
#else
        SchedGrid S{(const char*)(ws + WS_ACT), (const char*)(ws + WS_WDN), TOK / 256, DM / 256, G, bx, (size_t)256 * 4096 * 2};
        pg8::gemm_phase<EpiP7, SchedGrid, true, true>(lds, 4096, S, E);
#endif
    }
#ifdef P7_VIA_WS
    { asm volatile("s_waitcnt vmcnt(0)" ::: "memory"); grid.sync(); __builtin_amdgcn_fence(__ATOMIC_ACQUIRE, "agent"); asm volatile("s_waitcnt vmcnt(0)" ::: "memory");
      const f32x4* src = (const f32x4*)(ws + 46 * MiB); f32x4* dst = (f32x4*)args.out;
      for (size_t i = (size_t)bx * 512 + tid; i < (size_t)TOK * DM / 4; i += (size_t)G * 512) dst[i] = src[i]; }
#endif
    asm volatile("s_waitcnt vmcnt(0)" ::: "memory"); __syncthreads();
    if (tid == 0) { __builtin_amdgcn_fence(__ATOMIC_RELEASE, "agent"); asm volatile("s_waitcnt vmcnt(0)" ::: "memory"); }
#ifdef DUMP_OFF
    if (lo == 0) { asm volatile("s_waitcnt vmcnt(0)" ::: "memory"); grid.sync(); __builtin_amdgcn_fence(__ATOMIC_ACQUIRE, "agent"); asm volatile("s_waitcnt vmcnt(0)" ::: "memory"); }
    if (lo == 100 || lo == 0) {
        const unsigned* src = (const unsigned*)(ws + (size_t)DUMP_OFF);
        { const int xcd = bx & 7, k = bx >> 3, pmt = xcd * 16 + (k >> 1), half = k & 1;
          const size_t base = ((size_t)pmt * 256 + (size_t)half * 128) * 512;
          for (int j = tid; j < 128 * 512; j += 512) { const size_t i = base + j; const unsigned u = src[i]; args.out[2 * i] = bflo(u); args.out[2 * i + 1] = bfhi(u); } }
    }
    asm volatile("s_waitcnt vmcnt(0)" ::: "memory"); __syncthreads();
    if (tid == 0) { __builtin_amdgcn_fence(__ATOMIC_RELEASE, "agent"); asm volatile("s_waitcnt vmcnt(0)" ::: "memory"); }
#endif
#undef IN
#undef SEAM
}

#ifndef MK_N_LAUNCHES
#define MK_N_LAUNCHES 1
#endif
extern "C" void kernel_launch(void* const* d_in, const int* in_sizes, int n_in, void* d_out, int out_size, void* d_ws, size_t ws_size, hipStream_t stream) {
    static int grid = 0;
    if (grid == 0) {
        if (n_in != 21 || out_size != TOK * DM || ws_size < WS_END) { fprintf(stderr, "kernel_launch: unexpected shapes (n_in %d, out %d, ws %zu)\n", n_in, out_size, ws_size); grid = -1; return; }
        int dev = 0, cus = 0, per_cu = 0;
        hipGetDevice(&dev); hipDeviceGetAttribute(&cus, hipDeviceAttributeMultiprocessorCount, dev);
        hipFuncSetAttribute((const void*)fwd_megakernel, hipFuncAttributeMaxDynamicSharedMemorySize, LDS_BYTES);
        hipOccupancyMaxActiveBlocksPerMultiprocessor(&per_cu, (const void*)fwd_megakernel, 512, LDS_BYTES);
        (void)hipGetLastError();
        if (per_cu < 1) { fprintf(stderr, "kernel_launch: occupancy query says %d workgroups per CU\n", per_cu); per_cu = 1; }
        grid = cus;
    }
    if (grid < 0) return;
    hipMemsetAsync((char*)d_ws + WS_CTL, 0, 4096, stream);
    Args a{};
    for (int i = 0; i < 21; ++i) a.in[i] = (const float*)d_in[i];
    a.out = (float*)d_out; a.ws = (unsigned char*)d_ws;
#if MK_N_LAUNCHES == 1
#ifdef DUMP_OFF
    a.ph_lo = 0; a.ph_hi = DUMP_AFTER + 1;
#elif defined(TEST_GEMM)
    a.ph_lo = 0; a.ph_hi = 2;
#else
    a.ph_lo = 0; a.ph_hi = 9;
#endif
    void* kargs[] = {&a};
    hipError_t e = hipLaunchCooperativeKernel((const void*)fwd_megakernel, dim3(grid), dim3(512), kargs, LDS_BYTES, stream);
    if (e != hipSuccess) fprintf(stderr, "cooperative launch failed: %s (grid %d)\n", hipGetErrorString(e), grid);
#else
#ifdef DUMP_OFF
    for (int p = 0; p <= DUMP_AFTER; ++p) { a.ph_lo = p; a.ph_hi = p + 1; hipLaunchKernelGGL(fwd_megakernel, dim3(grid), dim3(512), LDS_BYTES, stream, a); }
    a.ph_lo = 100; a.ph_hi = 101; hipLaunchKernelGGL(fwd_megakernel, dim3(grid), dim3(512), LDS_BYTES, stream, a);
#else
    for (int p = 0; p < 9; ++p) { a.ph_lo = p; a.ph_hi = p + 1; hipLaunchKernelGGL(fwd_megakernel, dim3(grid), dim3(512), LDS_BYTES, stream, a); }
#endif
#endif
}
```

```cpp
#include <hip/hip_runtime.h>
#include <hip/hip_cooperative_groups.h>
#include <cstdio>
#include <cstdint>
namespace cg = cooperative_groups;

#define LAS __attribute__((address_space(3)))
typedef unsigned short bf16_t;
typedef short bf16x8 __attribute__((ext_vector_type(8)));
typedef float f32x4 __attribute__((ext_vector_type(4)));
typedef float f32x2 __attribute__((ext_vector_type(2)));
typedef unsigned u32x4 __attribute__((ext_vector_type(4)));
typedef unsigned u32x2 __attribute__((ext_vector_type(2)));

constexpr int DM = 1024, NB = 4, SEQ = 8192, TOK = NB * SEQ;
constexpr int NH = 4, HD = 128, BW = 512;
constexpr int CHUNK = 64, NCH = SEQ / CHUNK;
constexpr int NMEM = 256, DFF = 4096, DIN = 7176, NPROJ = 7168;
constexpr float EPS = 1e-6f;

constexpr size_t MiB = 1u << 20;
constexpr size_t WS_CTL = 0;
constexpr size_t WS_WIN = 1 * MiB;
constexpr size_t WS_WMKV = 15 * MiB;
constexpr size_t WS_WBR = 17 * MiB;
constexpr size_t WS_WO = 20 * MiB;
constexpr size_t WS_WUP = 22 * MiB;
constexpr size_t WS_WDN = 30 * MiB;
constexpr size_t WS_MEMN = 38 * MiB;
constexpr size_t WS_MEMKV = 40 * MiB;
constexpr size_t WS_AB = 42 * MiB;
constexpr size_t WS_SSQ = 43 * MiB;
constexpr size_t WS_GL = 45 * MiB;
constexpr size_t WS_H = 46 * MiB;
constexpr size_t WS_GDNI = 110 * MiB;
constexpr size_t GI_W = 0, GI_QD = 32 * MiB, GI_KDT = 64 * MiB, GI_UT = 96 * MiB, GI_A = 128 * MiB;
constexpr size_t WS_GZ = 254 * MiB;
constexpr size_t WS_GQKV = 286 * MiB;
constexpr size_t WS_OG = 318 * MiB;
constexpr size_t WS_OS = 350 * MiB;
constexpr size_t WS_SQKV = 382 * MiB;
constexpr size_t WS_MQ = 478 * MiB;
constexpr size_t WS_GATES = 110 * MiB;
constexpr size_t WS_MIXF = 382 * MiB;
constexpr size_t WS_MIX = 46 * MiB;
constexpr size_t WS_X1B = 110 * MiB;
constexpr size_t WS_ACT = 174 * MiB;
constexpr size_t WS_END = 510 * MiB;

constexpr int LDS_BYTES = 147456;

typedef __bf16 bf16x2_t __attribute__((ext_vector_type(2)));
__device__ __forceinline__ unsigned cvt_pk_bf16_mfma(float lo, float hi) { f32x2 v = {lo, hi}; bf16x2_t b = __builtin_convertvector(v, bf16x2_t); return __builtin_bit_cast(unsigned, b); }
__device__ __forceinline__ unsigned cvt_pk_bf16(float lo, float hi) { unsigned r; asm volatile("v_cvt_pk_bf16_f32 %0, %1, %2" : "=v"(r) : "v"(lo), "v"(hi)); return r; }
__device__ __forceinline__ float bflo(unsigned u) { return __uint_as_float(u << 16); }
__device__ __forceinline__ float bfhi(unsigned u) { return __uint_as_float(u & 0xffff0000u); }
__device__ __forceinline__ float wave_sum(float v) {
#pragma unroll
    for (int o = 1; o < 64; o <<= 1) v += __shfl_xor(v, o);
    return v;
}
__device__ __forceinline__ float sigmoidf_(float x) { return 1.0f / (1.0f + __expf(-x)); }
__device__ __forceinline__ float softplusf_(float x) { return fmaxf(x, 0.f) + __logf(1.0f + __expf(-fabsf(x))); }
__device__ __forceinline__ u32x2 ld8_agent(const void* p) { const unsigned long long v = __hip_atomic_load((const unsigned long long*)p, __ATOMIC_RELAXED, __HIP_MEMORY_SCOPE_AGENT); u32x2 r; r.x = (unsigned)v; r.y = (unsigned)(v >> 32); return r; }
#define MFMA16(x, y, c) __builtin_amdgcn_mfma_f32_16x16x32_bf16((x), (y), (c), 0, 0, 0)
#define LDS_WAIT() asm volatile("s_waitcnt lgkmcnt(0)" ::: "memory")
#define LDS_BARRIER() do { asm volatile("s_waitcnt lgkmcnt(0)" ::: "memory"); __builtin_amdgcn_s_barrier(); asm volatile("" ::: "memory"); } while (0)

namespace pg8 {
constexpr int BM = 256, BK = 64, HALF = 128, HTB = HALF * BK * 2, STAGE_BYTES = 8 * HTB, NXCD = 8, WGM = 8;
__host__ __device__ __forceinline__ int lds_byte(int r, int c) { const int st = (r >> 4) * 2 + (c >> 5), rr = r & 15, cc = c & 31, ob = rr * 64 + cc * 2; return st * 1024 + (ob ^ (((ob >> 9) & 1) << 5)); }
__host__ __device__ __forceinline__ void stage_rc(int b, int& R, int& C) { const int st = b / 1024, sb = b % 1024, swz = sb ^ (((sb >> 9) & 1) << 5); R = (st >> 1) * 16 + swz / 64; C = (st & 1) * 32 + (swz % 64) / 2; }
__host__ __device__ __forceinline__ int perm32(int rho) { const int n = rho >> 4, i = rho & 15; return 8 * (i >> 2) + 4 * n + (i & 3); }

struct Unit { int pm, pn, kind; const char* A; const char* B; };

__device__ __forceinline__ bool tile_order(int nM, int nN, int G, int c, int i, int& pm, int& pn) {
    const int nwg = nM * nN; const long L = (long)i * G + c; if (L >= nwg) return false;
    int wgid = (int)L; { const int q = nwg / NXCD, r = nwg % NXCD, xcd = wgid % NXCD, off = wgid / NXCD; wgid = (xcd < r ? xcd * (q + 1) : r * (q + 1) + (xcd - r) * q) + off; }
    const int nig = WGM * nN, gid = wgid / nig, fm = gid * WGM, gsz = (nM - fm) < WGM ? (nM - fm) : WGM;
    pm = fm + ((wgid % nig) % gsz); pn = (wgid % nig) / gsz; return true;
}

template <class Epi, class Sched, bool ALIGN_EPI, bool SP2>
__device__ __forceinline__ void gemm_phase(LAS unsigned char* lds, const int K, const Sched& S, const Epi& E) {
    const int tid = threadIdx.x, wid = __builtin_amdgcn_readfirstlane(tid >> 6), lane = tid & 63, wr = wid >> 2, wc = wid & 3, fr = lane & 15, fq = lane >> 4;
    const int nt = K / BK;
    unsigned voffA[2], voffB[2];
#pragma unroll
    for (int i = 0; i < 2; ++i) { int R, C; stage_rc(tid * 16 + i * 8192, R, C); const int Rb = Epi::PERM ? ((R & ~31) + perm32(R & 31)) : R;
        voffA[i] = (unsigned)(R * K + C) * 2u; voffB[i] = (unsigned)(Rb * K + C) * 2u; }
    const size_t kstep = (size_t)(BK * 2);
    const size_t hstep = (size_t)HALF * K * 2;
    const unsigned ldsw = (unsigned)wid * 1024u;
    const int aoff = lds_byte(wr * 64 + fr, fq * 8), boff = lds_byte(wc * 32 + fr, fq * 8);
#define PG8_SA(b, h) (((b) * 2 + (h)) * HTB)
#define PG8_SB(b, h) ((4 + (b) * 2 + (h)) * HTB)
#define PG8_STAGE(bufoff, gbase, voff) do { _Pragma("unroll") for (int _i = 0; _i < 2; ++_i) \
        __builtin_amdgcn_global_load_lds((const unsigned*)((const char*)(gbase) + (voff)[_i]), (LAS unsigned*)(lds + (bufoff) + ldsw + _i * 8192), 16, 0, 0); } while (0)
#define PG8_LDA(dst, b, h) do { _Pragma("unroll") for (int m = 0; m < 4; ++m) _Pragma("unroll") for (int k = 0; k < 2; ++k) dst[m][k] = *(const LAS bf16x8*)(lds + PG8_SA(b, h) + aoff + m * 2048 + k * 1024); } while (0)
#define PG8_LDB(dst, b, h) do { _Pragma("unroll") for (int n = 0; n < 2; ++n) _Pragma("unroll") for (int k = 0; k < 2; ++k) dst[n][k] = *(const LAS bf16x8*)(lds + PG8_SB(b, h) + boff + n * 2048 + k * 1024); } while (0)
#define PG8_MMA(ai, bj, At, Bt) do { __builtin_amdgcn_s_setprio(1); _Pragma("unroll") for (int m = 0; m < 4; ++m) _Pragma("unroll") for (int n = 0; n < 2; ++n) _Pragma("unroll") for (int k = 0; k < 2; ++k) \
        acc[ai][bj][m][n] = __builtin_amdgcn_mfma_f32_16x16x32_bf16(Bt[n][k], At[m][k], acc[ai][bj][m][n], 0, 0, 0); __builtin_amdgcn_s_setprio(0); } while (0)
#define PG8_WAIT_V(n) asm volatile("s_waitcnt vmcnt(" #n ")" ::: "memory")
#define PG8_WAIT_L(n) asm volatile("s_waitcnt lgkmcnt(" #n ")" ::: "memory")
#define PG8_BAR __builtin_amdgcn_s_barrier()
#define PG8_SCHED __builtin_amdgcn_sched_barrier(0)
    Unit cur, nxt; int ui = 0;
    if (!S.next(0, cur)) return;
    f32x4 acc[2][2][4][2];
#pragma unroll
    for (int a = 0; a < 2; ++a)
#pragma unroll
        for (int b = 0; b < 2; ++b)
#pragma unroll
            for (int m = 0; m < 4; ++m)
#pragma unroll
                for (int n = 0; n < 2; ++n) acc[a][b][m][n] = (f32x4){0.f, 0.f, 0.f, 0.f};
    bf16x8 At[4][2], B0[2][2], B1[2][2];
    const char* cA = cur.A; const char* cB = cur.B;
    if constexpr (SP2) {
        PG8_STAGE(PG8_SB(0, 0), cB, voffB); PG8_STAGE(PG8_SB(0, 1), cB + hstep, voffB); PG8_STAGE(PG8_SA(0, 0), cA, voffA); PG8_STAGE(PG8_SA(0, 1), cA + hstep, voffA);
        if (wr == 1) PG8_BAR;
        PG8_WAIT_V(2); PG8_BAR;
        PG8_STAGE(PG8_SB(1, 0), cB + kstep, voffB); PG8_STAGE(PG8_SA(1, 0), cA + kstep, voffA); PG8_STAGE(PG8_SB(1, 1), cB + hstep + kstep, voffB);
        PG8_WAIT_V(6); PG8_BAR;
    } else {
        PG8_STAGE(PG8_SB(0, 0), cB, voffB); PG8_STAGE(PG8_SA(0, 0), cA, voffA); PG8_STAGE(PG8_SB(0, 1), cB + hstep, voffB); PG8_STAGE(PG8_SA(0, 1), cA + hstep, voffA);
        if (wr == 1) PG8_BAR;
        PG8_WAIT_V(4); PG8_BAR;
        PG8_STAGE(PG8_SB(1, 0), cB + kstep, voffB); PG8_STAGE(PG8_SA(1, 0), cA + kstep, voffA); PG8_STAGE(PG8_SB(1, 1), cB + hstep + kstep, voffB);
        PG8_WAIT_V(6); PG8_BAR;
    }
    for (;;) {
        const bool has_next = S.next(ui + 1, nxt);
        const char* nA = has_next ? nxt.A : cA; const char* nB = has_next ? nxt.B : cB;
        for (int t = 0; t < nt; t += 2) {
            const bool last = (t == nt - 2);
            const char* a1 = cA + (size_t)(t + 1) * kstep;
            const char* a2 = last ? nA : cA + (size_t)(t + 2) * kstep; const char* b2 = last ? nB : cB + (size_t)(t + 2) * kstep;
            const char* a3 = a2 + kstep; const char* b3 = b2 + kstep;
            if constexpr (SP2) {
            PG8_LDB(B0, 0, 0); PG8_LDB(B1, 0, 1); PG8_SCHED; PG8_LDA(At, 0, 0); PG8_STAGE(PG8_SA(1, 1), a1 + hstep, voffA);
            PG8_WAIT_V(8); PG8_WAIT_L(0); PG8_BAR; PG8_MMA(0, 0, At, B0); PG8_MMA(0, 1, At, B1); PG8_BAR; PG8_SCHED;
            PG8_LDA(At, 0, 1); PG8_STAGE(PG8_SB(0, 0), b2, voffB); PG8_STAGE(PG8_SB(0, 1), b2 + hstep, voffB); PG8_STAGE(PG8_SA(0, 0), a2, voffA);
            PG8_WAIT_V(8); PG8_WAIT_L(0); PG8_BAR; PG8_MMA(1, 0, At, B0); PG8_MMA(1, 1, At, B1); PG8_BAR; PG8_SCHED;
            PG8_LDB(B0, 1, 0); PG8_LDB(B1, 1, 1); PG8_SCHED; PG8_LDA(At, 1, 0); PG8_STAGE(PG8_SA(0, 1), a2 + hstep, voffA);
            PG8_WAIT_V(8); PG8_WAIT_L(0); PG8_BAR; PG8_MMA(0, 0, At, B0); PG8_MMA(0, 1, At, B1); PG8_BAR; PG8_SCHED;
            PG8_LDA(At, 1, 1); PG8_STAGE(PG8_SB(1, 0), b3, voffB); PG8_STAGE(PG8_SB(1, 1), b3 + hstep, voffB); PG8_STAGE(PG8_SA(1, 0), a3, voffA);
            PG8_WAIT_V(8); PG8_WAIT_L(0); PG8_BAR; PG8_MMA(1, 0, At, B0); PG8_MMA(1, 1, At, B1); PG8_BAR; PG8_SCHED;
            } else {
            PG8_LDB(B0, 0, 0); PG8_SCHED; PG8_LDA(At, 0, 0); PG8_STAGE(PG8_SA(1, 1), a1 + hstep, voffA);
            PG8_WAIT_L(8); PG8_BAR; PG8_WAIT_L(0); PG8_MMA(0, 0, At, B0); PG8_BAR; PG8_SCHED;
            PG8_LDB(B1, 0, 1); PG8_STAGE(PG8_SB(0, 0), b2, voffB);
            PG8_BAR; PG8_WAIT_L(0); PG8_MMA(0, 1, At, B1); PG8_BAR;
            PG8_LDA(At, 0, 1); PG8_STAGE(PG8_SA(0, 0), a2, voffA);
            PG8_BAR; PG8_WAIT_L(0); PG8_MMA(1, 0, At, B0); PG8_BAR; PG8_SCHED;
            PG8_STAGE(PG8_SB(0, 1), b2 + hstep, voffB);
            PG8_WAIT_V(6); PG8_BAR; PG8_MMA(1, 1, At, B1); PG8_BAR;
            PG8_LDB(B0, 1, 0); PG8_SCHED; PG8_LDA(At, 1, 0); PG8_STAGE(PG8_SA(0, 1), a2 + hstep, voffA);
            PG8_WAIT_L(8); PG8_BAR; PG8_WAIT_L(0); PG8_MMA(0, 0, At, B0); PG8_BAR; PG8_SCHED;
            PG8_LDB(B1, 1, 1); PG8_STAGE(PG8_SB(1, 0), b3, voffB);
            PG8_BAR; PG8_WAIT_L(0); PG8_MMA(0, 1, At, B1); PG8_BAR;
            PG8_LDA(At, 1, 1); PG8_STAGE(PG8_SA(1, 0), a3, voffA);
            PG8_BAR; PG8_WAIT_L(0); PG8_MMA(1, 0, At, B0); PG8_BAR; PG8_SCHED;
            PG8_STAGE(PG8_SB(1, 1), b3 + hstep, voffB);
            PG8_WAIT_V(6); PG8_BAR; PG8_MMA(1, 1, At, B1); PG8_BAR;
            }
        }
        if constexpr (ALIGN_EPI) { if (wr == 0) PG8_BAR; }
        E(acc, cur, wr, wc, fr, fq);
        if (!has_next) break;
#pragma unroll
        for (int a = 0; a < 2; ++a)
#pragma unroll
            for (int b = 0; b < 2; ++b)
#pragma unroll
                for (int m = 0; m < 4; ++m)
#pragma unroll
                    for (int n = 0; n < 2; ++n) acc[a][b][m][n] = (f32x4){0.f, 0.f, 0.f, 0.f};
        cur = nxt; cA = nA; cB = nB; ++ui;
        if constexpr (ALIGN_EPI) { if (wr == 1) PG8_BAR; }
    }
    PG8_WAIT_V(0);
    if constexpr (!ALIGN_EPI) { if (wr == 0) PG8_BAR; }
    PG8_BAR;
#undef PG8_SA
#undef PG8_SB
#undef PG8_STAGE
#undef PG8_LDA
#undef PG8_LDB
#undef PG8_MMA
#undef PG8_WAIT_V
#undef PG8_WAIT_L
#undef PG8_BAR
#undef PG8_SCHED
}
}

struct Args {
    const float* in[21];
    float* out; unsigned char* ws;
    int ph_lo, ph_hi;
};
enum { I_X = 0, I_MEM, I_N1G, I_WIN, I_CONVW, I_ALOG, I_DTB, I_GDNG, I_SBQG, I_SBKG, I_MEMNG, I_WMKV, I_MQG, I_MKG, I_WBRG, I_WBRS, I_WBRM, I_WO, I_N2G, I_WUP, I_WDN };

struct SchedGrid {
    const char* A; const char* B; int nM, nN, G, c; size_t tstep;
    __device__ __forceinline__ bool next(int i, pg8::Unit& u) const {
        if (!pg8::tile_order(nM, nN, G, c, i, u.pm, u.pn)) return false;
        u.kind = 0; u.A = A + (size_t)u.pm * tstep; u.B = B + (size_t)u.pn * tstep; return true;
    }
};
struct SchedBranch {
    const char* A0; const char* A1; const char* A2; const char* B; int G, c; size_t tstep;
    __device__ __forceinline__ bool next(int i, pg8::Unit& u) const {
        const int t = i / 3, br = i - 3 * t;
        if (!pg8::tile_order(TOK / 256, DM / 256, G, c, t, u.pm, u.pn)) return false;
        u.kind = br; u.A = (br == 0 ? A0 : (br == 1 ? A1 : A2)) + (size_t)u.pm * tstep; u.B = B + (size_t)br * ((size_t)DM * BW * 2) + (size_t)u.pn * tstep; return true;
    }
};

struct EpiP1 {
    static constexpr bool PERM = true;
    bf16_t* gqkv; bf16_t* gz; bf16_t* sqkv; bf16_t* mq; bf16_t* gates; bf16_t* memkv; int is_mem;
    __device__ __forceinline__ void operator()(const f32x4 (&acc)[2][2][4][2], const pg8::Unit& u, int wr, int wc, int fr, int fq) const {
        bf16_t* base; int ldc, c0; bool sig = false; const int pn = u.pn;
        if (is_mem == 1) { base = memkv; ldc = 1024; c0 = pn * 256; }
        else if (is_mem == 2) { base = gates; ldc = 3072; c0 = pn * 256; sig = true; }
        else if (pn < 6) { base = gqkv; ldc = 1536; c0 = pn * 256; }
        else if (pn < 8) { base = gz; ldc = 512; c0 = (pn - 6) * 256; }
        else if (pn < 14) { base = sqkv; ldc = 1536; c0 = (pn - 8) * 256; }
        else { base = mq; ldc = 512; c0 = (pn - 14) * 256; }
        const int row0 = u.pm * 256 + wr * 64 + fr, col0 = c0 + wc * 32 + 8 * fq;
#pragma unroll
        for (int ai = 0; ai < 2; ++ai)
#pragma unroll
            for (int m = 0; m < 4; ++m) { bf16_t* rowp = base + (size_t)(row0 + ai * 128 + m * 16) * ldc + col0;
#pragma unroll
                for (int bj = 0; bj < 2; ++bj) { f32x4 v0 = acc[ai][bj][m][0], v1 = acc[ai][bj][m][1];
                    if (sig) {
#pragma unroll
                        for (int e = 0; e < 4; ++e) { v0[e] = sigmoidf_(v0[e]); v1[e] = sigmoidf_(v1[e]); } }
                    u32x4 w; w.x = cvt_pk_bf16_mfma(v0[0], v0[1]); w.y = cvt_pk_bf16_mfma(v0[2], v0[3]); w.z = cvt_pk_bf16_mfma(v1[0], v1[1]); w.w = cvt_pk_bf16_mfma(v1[2], v1[3]);
                    *(u32x4*)(rowp + bj * 128) = w; } }
    }
};
struct EpiP3 {
    static constexpr bool PERM = true;
    const bf16_t* gates; float* priv; bf16_t* mix;
    __device__ __forceinline__ void operator()(const f32x4 (&acc)[2][2][4][2], const pg8::Unit& u, int wr, int wc, int fr, int fq) const {
        const int br = u.kind; int opq; asm volatile("v_mov_b32 %0, 0" : "=v"(opq));
        const unsigned row0 = (unsigned)(u.pm * 256 + wr * 64 + fr + opq), col0 = (unsigned)(u.pn * 256 + wc * 32 + 8 * fq);
        const unsigned goff0 = row0 * 3072u + (unsigned)br * 1024u + col0, moff0 = row0 * 1024u + col0;
        f32x4* pv = (f32x4*)priv + threadIdx.x + opq;
        if (br > 0) asm volatile("s_waitcnt vmcnt(0)" ::: "memory");
#pragma unroll
        for (int ai = 0; ai < 2; ++ai)
#pragma unroll
            for (int m = 0; m < 4; ++m) {
#pragma unroll
                for (int bj = 0; bj < 2; ++bj) {
                    const u32x4 g = *(const u32x4*)(gates + (goff0 + (unsigned)((ai * 128 + m * 16) * 3072 + bj * 128)));
                    f32x4 v0 = acc[ai][bj][m][0], v1 = acc[ai][bj][m][1];
                    v0[0] *= bflo(g.x); v0[1] *= bfhi(g.x); v0[2] *= bflo(g.y); v0[3] *= bfhi(g.y);
                    v1[0] *= bflo(g.z); v1[1] *= bfhi(g.z); v1[2] *= bflo(g.w); v1[3] *= bfhi(g.w);
                    const int ri = ((ai * 2 + bj) * 4 + m) * 2;
#ifndef P3_NORMW
                    if (br > 0) { v0 += pv[ri * 512]; v1 += pv[(ri + 1) * 512]; }
                    if (br < 2) { pv[ri * 512] = v0; pv[(ri + 1) * 512] = v1; }
#else
                    if (br < 2) { }
#endif
                    else { u32x4 w; w.x = cvt_pk_bf16(v0[0], v0[1]); w.y = cvt_pk_bf16(v0[2], v0[3]); w.z = cvt_pk_bf16(v1[0], v1[1]); w.w = cvt_pk_bf16(v1[2], v1[3]);
                        *(u32x4*)(mix + (moff0 + (unsigned)((ai * 128 + m * 16) * 1024 + bj * 128))) = w; } }
                asm volatile("" ::: "memory"); }
    }
};
struct EpiP4 {
    static constexpr bool PERM = true;
    const float* x; float* out; bf16_t* x1b; float* ssq;
    __device__ __forceinline__ void operator()(const f32x4 (&acc)[2][2][4][2], const pg8::Unit& u, int wr, int wc, int fr, int fq) const {
        int opq; asm volatile("v_mov_b32 %0, 0" : "=v"(opq));
        const unsigned row0 = (unsigned)(u.pm * 256 + wr * 64 + fr + opq), col0 = (unsigned)(u.pn * 256 + wc * 32 + 8 * fq);
#pragma unroll
        for (int ai = 0; ai < 2; ++ai)
#pragma unroll
            for (int m = 0; m < 4; ++m) { const unsigned row = row0 + ai * 128 + m * 16; float s = 0.f;
#pragma unroll
                for (int bj = 0; bj < 2; ++bj) { const unsigned off = row * 1024u + col0 + bj * 128;
#ifdef P4_MINIMAL
                    const f32x4 o0 = acc[ai][bj][m][0], o1 = acc[ai][bj][m][1];
#else
                    const f32x4 o0 = *(const f32x4*)(x + off) + acc[ai][bj][m][0], o1 = *(const f32x4*)(x + off + 4) + acc[ai][bj][m][1];
#endif
                    s += (o0[0] * o0[0] + o0[1] * o0[1]) + (o0[2] * o0[2] + o0[3] * o0[3]) + (o1[0] * o1[0] + o1[1] * o1[1]) + (o1[2] * o1[2] + o1[3] * o1[3]);
                    u32x4 w; w.x = cvt_pk_bf16(o0[0], o0[1]); w.y = cvt_pk_bf16(o0[2], o0[3]); w.z = cvt_pk_bf16(o1[0], o1[1]); w.w = cvt_pk_bf16(o1[2], o1[3]);
                    *(u32x4*)(x1b + off) = w; }
#ifndef NO_SSQ
                s += __shfl_xor(s, 16); s += __shfl_xor(s, 32);
                if (fq == 0) ssq[(size_t)u.pn * (TOK * 4) + row * 4 + wc] = s;
#endif
                asm volatile("" ::: "memory"); }
    }
};
struct EpiP6 {
    static constexpr bool PERM = true;
    const float* ssq; bf16_t* act;
    __device__ __forceinline__ void operator()(const f32x4 (&acc)[2][2][4][2], const pg8::Unit& u, int wr, int wc, int fr, int fq) const {
        const int row0 = u.pm * 256 + wr * 64 + fr, col0 = u.pn * 256 + wc * 32 + 8 * fq;
#pragma unroll
        for (int ai = 0; ai < 2; ++ai)
#pragma unroll
            for (int m = 0; m < 4; ++m) { const size_t row = (size_t)(row0 + ai * 128 + m * 16);
                const f32x4 p = *(const f32x4*)(ssq + (size_t)fq * (TOK * 4) + row * 4); float s = (p[0] + p[1]) + (p[2] + p[3]);
                s += __shfl_xor(s, 16); s += __shfl_xor(s, 32);
                const float rstd = rsqrtf(s * (1.0f / DM) + EPS);
#pragma unroll
                for (int bj = 0; bj < 2; ++bj) { f32x4 v0 = acc[ai][bj][m][0] * rstd, v1 = acc[ai][bj][m][1] * rstd;
#pragma unroll
                    for (int e = 0; e < 4; ++e) { const float a = fmaxf(v0[e], 0.f), b = fmaxf(v1[e], 0.f); v0[e] = a * a; v1[e] = b * b; }
                    u32x4 w; w.x = cvt_pk_bf16(v0[0], v0[1]); w.y = cvt_pk_bf16(v0[2], v0[3]); w.z = cvt_pk_bf16(v1[0], v1[1]); w.w = cvt_pk_bf16(v1[2], v1[3]);
                    *(u32x4*)(act + row * 4096 + col0 + bj * 128) = w; } }
    }
};
struct EpiP7 {
    static constexpr bool PERM = false;
    const bf16_t* x1b; float* out;
    __device__ __forceinline__ void operator()(const f32x4 (&acc)[2][2][4][2], const pg8::Unit& u, int wr, int wc, int fr, int fq) const {
        int opq; asm volatile("v_mov_b32 %0, 0" : "=v"(opq));
        const unsigned row0 = (unsigned)(u.pm * 256 + wr * 64 + fr + opq), col0 = (unsigned)(u.pn * 256 + wc * 32 + 4 * fq);
#pragma unroll
        for (int ai = 0; ai < 2; ++ai)
#pragma unroll
            for (int m = 0; m < 4; ++m) { const unsigned row = row0 + ai * 128 + m * 16;
#pragma unroll
                for (int bj = 0; bj < 2; ++bj)
#pragma unroll
                    for (int n = 0; n < 2; ++n) { const unsigned off = row * 1024u + col0 + bj * 128 + n * 16;
                        const u32x2 xb = *(const u32x2*)(x1b + off);
                        f32x4 o = acc[ai][bj][m][n];
#ifndef P7_NOX
                        o[0] += bflo(xb.x); o[1] += bfhi(xb.x); o[2] += bflo(xb.y); o[3] += bfhi(xb.y);
#endif
                        *(f32x4*)(out + off) = o; }
                asm volatile("" ::: "memory"); }
    }
};

__device__ __forceinline__ void p0_transpose_item(const float* W, int K, int ldw, int N, bf16_t* WT, const float* kscale, int skip_at, LAS float* scr, int item, int lane) {
    const int nblk = N / 32, kb = item / nblk, nb = item % nblk, k0 = 64 * kb, n0 = 32 * nb;
    const int src0 = n0 + (n0 >= skip_at ? 8 : 0);
#pragma unroll 8
    for (int i = 0; i < 32; ++i) { const int kk = 2 * i + (lane >> 5); float v = W[(size_t)(k0 + kk) * ldw + src0 + (lane & 31)]; if (kscale) v *= kscale[k0 + kk]; scr[kk * 33 + (lane & 31)] = v; }
    LDS_WAIT(); asm volatile("" ::: "memory");
    const int c = lane & 7;
#pragma unroll
    for (int j = 0; j < 4; ++j) { const int n = (lane >> 3) + 8 * j; const LAS float* s = scr + (8 * c) * 33 + n;
        u32x4 o; o.x = cvt_pk_bf16(s[0 * 33], s[1 * 33]); o.y = cvt_pk_bf16(s[2 * 33], s[3 * 33]); o.z = cvt_pk_bf16(s[4 * 33], s[5 * 33]); o.w = cvt_pk_bf16(s[6 * 33], s[7 * 33]);
        *(u32x4*)(WT + (size_t)(n0 + n) * K + k0 + 8 * c) = o; }
    LDS_WAIT(); asm volatile("" ::: "memory");
}

__device__ __forceinline__ void phase0(const Args& a, LAS unsigned char* lds, int vcu, int G) {
    const int tid = threadIdx.x, lane = tid & 63, wave = __builtin_amdgcn_readfirstlane(tid >> 6);
    unsigned char* ws = a.ws;
    LAS float* wab = (LAS float*)(lds + 8 * 8448);
    for (int e = tid; e < 8192; e += 512) wab[e] = a.in[I_WIN][(size_t)(e >> 3) * DIN + 2048 + (e & 7)];
    LAS float* scr = (LAS float*)(lds + wave * 8448);
    const int gw = vcu * 8 + wave, NGW = G * 8;
    constexpr int I_IN = 16 * 224, I_MKV = 16 * 32, I_BR = 8 * 32, I_O = 16 * 32, I_UP = 16 * 128, I_DN = 64 * 32;
    constexpr int NITEMS = I_IN + I_MKV + 3 * I_BR + I_O + I_UP + I_DN;
    for (int it = gw; it < NITEMS; it += NGW) {
        int r = it;
        if (r < I_IN) { p0_transpose_item(a.in[I_WIN], 1024, DIN, NPROJ, (bf16_t*)(ws + WS_WIN), nullptr, 2048, scr, r, lane); continue; } r -= I_IN;
        if (r < I_MKV) { p0_transpose_item(a.in[I_WMKV], 1024, 1024, 1024, (bf16_t*)(ws + WS_WMKV), nullptr, 1 << 30, scr, r, lane); continue; } r -= I_MKV;
        if (r < I_BR) { p0_transpose_item(a.in[I_WBRG], 512, 1024, 1024, (bf16_t*)(ws + WS_WBR), nullptr, 1 << 30, scr, r, lane); continue; } r -= I_BR;
        if (r < I_BR) { p0_transpose_item(a.in[I_WBRS], 512, 1024, 1024, (bf16_t*)(ws + WS_WBR) + (size_t)DM * BW, nullptr, 1 << 30, scr, r, lane); continue; } r -= I_BR;
        if (r < I_BR) { p0_transpose_item(a.in[I_WBRM], 512, 1024, 1024, (bf16_t*)(ws + WS_WBR) + (size_t)2 * DM * BW, nullptr, 1 << 30, scr, r, lane); continue; } r -= I_BR;
        if (r < I_O) { p0_transpose_item(a.in[I_WO], 1024, 1024, 1024, (bf16_t*)(ws + WS_WO), nullptr, 1 << 30, scr, r, lane); continue; } r -= I_O;
        if (r < I_UP) { p0_transpose_item(a.in[I_WUP], 1024, 4096, 4096, (bf16_t*)(ws + WS_WUP), a.in[I_N2G], 1 << 30, scr, r, lane); continue; } r -= I_UP;
        p0_transpose_item(a.in[I_WDN], 4096, 1024, 1024, (bf16_t*)(ws + WS_WDN), nullptr, 1 << 30, scr, r, lane);
    }
    __syncthreads();
    const float* g1 = a.in[I_N1G]; bf16_t* H = (bf16_t*)(ws + WS_H); float* AB = (float*)(ws + WS_AB);
    f32x4 gv[4];
#pragma unroll
    for (int j = 0; j < 4; ++j) gv[j] = *(const f32x4*)(g1 + 256 * j + 4 * lane);
    for (int m = gw; m < TOK; m += NGW) {
        const f32x4* xr = (const f32x4*)(a.in[I_X] + (size_t)m * DM) + lane;
        f32x4 v[4]; float s = 0.f;
#pragma unroll
        for (int j = 0; j < 4; ++j) { v[j] = xr[64 * j]; s += (v[j].x * v[j].x + v[j].y * v[j].y) + (v[j].z * v[j].z + v[j].w * v[j].w); }
        const float rstd = rsqrtf(wave_sum(s) * (1.f / DM) + EPS);
        float p[8];
#pragma unroll
        for (int c = 0; c < 8; ++c) p[c] = 0.f;
        u32x2* o8 = (u32x2*)(H + (size_t)m * DM) + lane;
#pragma unroll
        for (int j = 0; j < 4; ++j) { v[j] = v[j] * rstd * gv[j];
            u32x2 w; w.x = cvt_pk_bf16(v[j].x, v[j].y); w.y = cvt_pk_bf16(v[j].z, v[j].w); o8[64 * j] = w;
#pragma unroll
            for (int e = 0; e < 4; ++e) { const LAS f32x4* wp = (const LAS f32x4*)(wab + (256 * j + 4 * lane + e) * 8); const f32x4 w0 = wp[0], w1 = wp[1]; const float hv = v[j][e];
                p[0] += hv * w0.x; p[1] += hv * w0.y; p[2] += hv * w0.z; p[3] += hv * w0.w; p[4] += hv * w1.x; p[5] += hv * w1.y; p[6] += hv * w1.z; p[7] += hv * w1.w; } }
#pragma unroll
        for (int c = 0; c < 8; ++c) p[c] = wave_sum(p[c]);
        if (lane == 0) { f32x4* ab = (f32x4*)(AB + (size_t)m * 8); ab[0] = (f32x4){p[0], p[1], p[2], p[3]}; ab[1] = (f32x4){p[4], p[5], p[6], p[7]}; }
    }
    const float* gm = a.in[I_MEMNG]; bf16_t* MN = (bf16_t*)(ws + WS_MEMN);
#pragma unroll
    for (int j = 0; j < 4; ++j) gv[j] = *(const f32x4*)(gm + 256 * j + 4 * lane);
    for (int m = gw; m < NB * NMEM; m += NGW) {
        const f32x4* xr = (const f32x4*)(a.in[I_MEM] + (size_t)m * DM) + lane;
        f32x4 v[4]; float s = 0.f;
#pragma unroll
        for (int j = 0; j < 4; ++j) { v[j] = xr[64 * j]; s += (v[j].x * v[j].x + v[j].y * v[j].y) + (v[j].z * v[j].z + v[j].w * v[j].w); }
        const float rstd = rsqrtf(wave_sum(s) * (1.f / DM) + EPS);
        u32x2* o8 = (u32x2*)(MN + (size_t)m * DM) + lane;
#pragma unroll
        for (int j = 0; j < 4; ++j) { v[j] = v[j] * rstd * gv[j]; u32x2 w; w.x = cvt_pk_bf16(v[j].x, v[j].y); w.y = cvt_pk_bf16(v[j].z, v[j].w); o8[64 * j] = w; }
    }
}

constexpr int PQ_LD = 136;
__device__ __forceinline__ void gdn_prep_unit(const Args& a, LAS unsigned char* lds, int cid) {
    const int tid = threadIdx.x, lane = tid & 63, wave = __builtin_amdgcn_readfirstlane(tid >> 6), fr = lane & 15, fq = lane >> 4;
    unsigned char* ws = a.ws;
    const int n = cid & (NCH - 1), bh = cid >> 7, h = bh & 3, b = bh >> 2;
    const size_t row0 = (size_t)b * SEQ + (size_t)n * CHUNK;
    LAS bf16_t* Qb = (LAS bf16_t*)lds;
    LAS bf16_t* Kb = (LAS bf16_t*)(lds + 17408);
    LAS float* Kf = (LAS float*)(lds + 34816);
    LAS float* Vf = (LAS float*)(lds + 34816 + 32768);
    LAS float* Lm = (LAS float*)(lds + 34816 + 65536);
    LAS float* gcs = (LAS float*)(lds + 34816 + 65536 + 16384);
    LAS float* bet = gcs + 64;
    LAS float* bge = gcs + 128;
    const bf16_t* GQ = (const bf16_t*)a.out;
    if (wave == 0) {
        const float* AB = (const float*)(ws + WS_AB) + (row0 + lane) * 8;
        const float al = AB[h], bl = AB[4 + h];
        float g = -__expf(a.in[I_ALOG][h]) * softplusf_(al + a.in[I_DTB][h]);
#pragma unroll
        for (int o = 1; o < 64; o <<= 1) { const float t = __shfl_up(g, o); if (lane >= o) g += t; }
        const float be = sigmoidf_(bl);
        gcs[lane] = g; bet[lane] = be; bge[lane] = be * __expf(g);
        { const float gle = __expf(__shfl(g, 63)); if (lane < 32) ((float*)(ws + WS_GL))[cid * 32 + lane] = gle; }
    }
    {
        const float* cw = a.in[I_CONVW];
        float wq[4][2], wk[4][2], wv[4][2];
#pragma unroll
        for (int j = 0; j < 4; ++j) { const float* p = cw + j * 1536 + h * 128 + 2 * lane; wq[j][0] = p[0]; wq[j][1] = p[1]; wk[j][0] = p[512]; wk[j][1] = p[513]; wv[j][0] = p[1024]; wv[j][1] = p[1025]; }
        unsigned rq[11], rk[11], rv[11];
#pragma unroll
        for (int i = 0; i < 11; ++i) { const int rr = wave * 8 + i - 3; const bool ok = (n > 0) || (rr >= 0);
            const bf16_t* p = GQ + (row0 + rr) * 1536 + h * 128 + 2 * lane;
            rq[i] = ok ? *(const unsigned*)p : 0u; rk[i] = ok ? *(const unsigned*)(p + 512) : 0u; rv[i] = ok ? *(const unsigned*)(p + 1024) : 0u; }
#pragma unroll
        for (int i = 0; i < 8; ++i) { const int r = wave * 8 + i;
            float q0 = 0.f, q1 = 0.f, k0 = 0.f, k1 = 0.f, v0 = 0.f, v1 = 0.f;
#pragma unroll
            for (int j = 0; j < 4; ++j) { q0 += wq[j][0] * bflo(rq[i + j]); q1 += wq[j][1] * bfhi(rq[i + j]); k0 += wk[j][0] * bflo(rk[i + j]); k1 += wk[j][1] * bfhi(rk[i + j]);
                v0 += wv[j][0] * bflo(rv[i + j]); v1 += wv[j][1] * bfhi(rv[i + j]); }
            q0 *= sigmoidf_(q0); q1 *= sigmoidf_(q1); k0 *= sigmoidf_(k0); k1 *= sigmoidf_(k1); v0 *= sigmoidf_(v0); v1 *= sigmoidf_(v1);
            const float qn = rsqrtf(wave_sum(q0 * q0 + q1 * q1) + EPS) * 0.08838834764831845f, kn = rsqrtf(wave_sum(k0 * k0 + k1 * k1) + EPS);
            q0 *= qn; q1 *= qn; k0 *= kn; k1 *= kn;
            *(LAS unsigned*)(Qb + r * PQ_LD + 2 * lane) = cvt_pk_bf16(q0, q1);
            *(LAS unsigned*)(Kb + r * PQ_LD + 2 * lane) = cvt_pk_bf16(k0, k1);
            *(LAS f32x2*)(Kf + r * 128 + 2 * lane) = (f32x2){k0, k1};
            *(LAS f32x2*)(Vf + r * 128 + 2 * lane) = (f32x2){v0, v1}; }
    }
    __syncthreads();
    {
        const int mat = wave >> 2, ct = wave & 3;
        const LAS bf16_t* Xb = mat ? Qb : Kb;
        bf16x8 xf[4];
#pragma unroll
        for (int ks = 0; ks < 4; ++ks) xf[ks] = *(const LAS bf16x8*)(Xb + (ct * 16 + fr) * PQ_LD + ks * 32 + 8 * fq);
        bf16_t* Ag = (bf16_t*)(ws + WS_GDNI + GI_A) + (size_t)cid * 4096;
#pragma unroll
        for (int st = 0; st < 4; ++st) {
            f32x4 d = (f32x4){0.f, 0.f, 0.f, 0.f};
#pragma unroll
            for (int ks = 0; ks < 4; ++ks) { const bf16x8 yf = *(const LAS bf16x8*)(Kb + (st * 16 + fr) * PQ_LD + ks * 32 + 8 * fq); d = MFMA16(xf[ks], yf, d); }
            const int s = st * 16 + fr; const float gs = gcs[s];
#pragma unroll
            for (int i = 0; i < 4; ++i) { const int c = ct * 16 + 4 * fq + i; const float dec = __expf(fminf(gcs[c] - gs, 0.f));
                if (mat == 0) Lm[c * 64 + s] = (c > s) ? bet[c] * d[i] * dec : 0.f;
                else Ag[c * 64 + s] = (bf16_t)(cvt_pk_bf16((c >= s) ? d[i] * dec : 0.f, 0.f) & 0xffffu); }
        }
    }
    __syncthreads();
    const size_t gbase = (size_t)cid * 8192;
    if (wave < 4) {
        const int col = (wave & 1) * 64 + lane; const bool isw = wave >= 2;
        const LAS float* src = isw ? Kf : Vf; const LAS float* scl = isw ? bge : bet;
        float xv[64]; int opq; asm volatile("v_mov_b32 %0, 0" : "=v"(opq));
        const LAS float* Lmv = Lm + opq;
#pragma unroll
        for (int i = 0; i < 64; ++i) xv[i] = 0.f;
#pragma unroll
        for (int i = 0; i < 64; ++i) {
            float r0 = src[i * 128 + col] * scl[i], r1 = 0.f, r2 = 0.f, r3 = 0.f;
#pragma unroll
            for (int j4 = 0; j4 < (i + 3) / 4; ++j4) { const f32x4 lv = *(const LAS f32x4*)(Lmv + i * 64 + 4 * j4);
                r0 -= lv.x * xv[4 * j4]; r1 -= lv.y * xv[4 * j4 + 1]; r2 -= lv.z * xv[4 * j4 + 2]; r3 -= lv.w * xv[4 * j4 + 3]; }
            xv[i] = (r0 + r1) + (r2 + r3);
        }
        if (!isw) {
            u32x4* up = (u32x4*)((bf16_t*)(ws + WS_GDNI + GI_UT) + gbase + (size_t)col * 64);
#pragma unroll
            for (int j = 0; j < 8; ++j) { u32x4 w; w.x = cvt_pk_bf16(xv[8 * j], xv[8 * j + 1]); w.y = cvt_pk_bf16(xv[8 * j + 2], xv[8 * j + 3]); w.z = cvt_pk_bf16(xv[8 * j + 4], xv[8 * j + 5]); w.w = cvt_pk_bf16(xv[8 * j + 6], xv[8 * j + 7]); up[j] = w; }
        } else {
            bf16_t* wp = (bf16_t*)(ws + WS_GDNI + GI_W) + gbase + col;
#pragma unroll
            for (int i = 0; i < 64; ++i) wp[i * 128] = (bf16_t)(cvt_pk_bf16(xv[i], 0.f) & 0xffffu);
        }
    } else {
        const int t = tid - 256; const float gl = gcs[63];
        bf16_t* qd = (bf16_t*)(ws + WS_GDNI + GI_QD) + gbase; bf16_t* kdt = (bf16_t*)(ws + WS_GDNI + GI_KDT) + gbase;
#pragma unroll
        for (int j = 0; j < 4; ++j) { const int task = t + 256 * j, c = task >> 4, seg = task & 15; const float e = __expf(gcs[c]);
            const u32x4 qv = *(const LAS u32x4*)(Qb + c * PQ_LD + seg * 8);
            u32x4 w; w.x = cvt_pk_bf16(bflo(qv.x) * e, bfhi(qv.x) * e); w.y = cvt_pk_bf16(bflo(qv.y) * e, bfhi(qv.y) * e); w.z = cvt_pk_bf16(bflo(qv.z) * e, bfhi(qv.z) * e); w.w = cvt_pk_bf16(bflo(qv.w) * e, bfhi(qv.w) * e);
            *(u32x4*)(qd + c * 128 + seg * 8) = w; }
#pragma unroll
        for (int j = 0; j < 4; ++j) { const int task = t + 256 * j, dk = task & 127, c8 = task >> 7; float v[8];
#pragma unroll
            for (int e = 0; e < 8; ++e) { const int c = c8 * 8 + e; v[e] = Kf[c * 128 + dk] * __expf(gl - gcs[c]); }
            u32x4 w; w.x = cvt_pk_bf16(v[0], v[1]); w.y = cvt_pk_bf16(v[2], v[3]); w.z = cvt_pk_bf16(v[4], v[5]); w.w = cvt_pk_bf16(v[6], v[7]);
            *(u32x4*)(kdt + dk * 64 + c8 * 8) = w; }
    }
    asm volatile("s_waitcnt vmcnt(0)" ::: "memory"); __syncthreads();
}

constexpr int ST_LD = 136, VN_LD = 72;
__device__ __forceinline__ void gdn_scan_unit(const Args& a, LAS unsigned char* lds, int unit) {
    const int tid = threadIdx.x, lane = tid & 63, wave = __builtin_amdgcn_readfirstlane(tid >> 6), fr = lane & 15, fq = lane >> 4;
    unsigned char* ws = a.ws;
    const int bh = unit >> 2, sl = unit & 3, h = bh & 3, b = bh >> 2;
    LAS bf16_t* St = (LAS bf16_t*)lds;
    LAS bf16_t* VNt = (LAS bf16_t*)(lds + 2 * 32 * ST_LD * 2);
    LAS float* red = (LAS float*)(lds + 2 * 32 * ST_LD * 2 + 32 * VN_LD * 2);
    for (int e = tid; e < 32 * ST_LD / 2; e += 512) ((LAS unsigned*)St)[e] = 0u;
    f32x4 sacc[2];
    sacc[0] = (f32x4){0.f, 0.f, 0.f, 0.f}; sacc[1] = sacc[0];
    const int ct = wave >> 1, tt = wave & 1;
    const int dvg = sl * 32 + tt * 16;
    const bf16_t* Wg = (const bf16_t*)(ws + WS_GDNI + GI_W); const bf16_t* QDg = (const bf16_t*)(ws + WS_GDNI + GI_QD);
    const bf16_t* KDTg = (const bf16_t*)(ws + WS_GDNI + GI_KDT); const bf16_t* UTg = (const bf16_t*)(ws + WS_GDNI + GI_UT); const bf16_t* Ag = (const bf16_t*)(ws + WS_GDNI + GI_A);
    const bf16_t* GZ = (const bf16_t*)(ws + WS_GZ); bf16_t* OG = (bf16_t*)(ws + WS_OG); float* PART = (float*)(ws + WS_SSQ);
    const f32x4 gnj = *(const f32x4*)(a.in[I_GDNG] + dvg + 4 * fq);
    const float ealog = __expf(a.in[I_ALOG][h]), dtb = a.in[I_DTB][h];
    __syncthreads();
#define SCAN_LOAD(nn, WF, UV, AL, QF, AF, KF, ZV) do { const int cid_ = bh * NCH + (nn); const size_t gb_ = (size_t)cid_ * 8192; \
        _Pragma("unroll") for (int ks = 0; ks < 4; ++ks) { WF[ks] = *(const bf16x8*)(Wg + gb_ + (ct * 16 + fr) * 128 + ks * 32 + 8 * fq); QF[ks] = *(const bf16x8*)(QDg + gb_ + (ct * 16 + fr) * 128 + ks * 32 + 8 * fq); } \
        _Pragma("unroll") for (int ks = 0; ks < 2; ++ks) { AF[ks] = *(const bf16x8*)(Ag + (size_t)cid_ * 4096 + (ct * 16 + fr) * 64 + ks * 32 + 8 * fq); KF[ks] = *(const bf16x8*)(KDTg + gb_ + (wave * 16 + fr) * 64 + ks * 32 + 8 * fq); } \
        UV = *(const u32x2*)(UTg + gb_ + (dvg + fr) * 64 + ct * 16 + 4 * fq); \
        ZV = *(const u32x2*)(GZ + ((size_t)b * SEQ + (size_t)(nn) * CHUNK + ct * 16 + fr) * 512 + h * 128 + dvg + 4 * fq); \
        AL = ((const float*)(ws + WS_AB))[((size_t)b * SEQ + (size_t)(nn) * CHUNK + lane) * 8 + h]; } while (0)
#define SCAN_STEP(n, WF, UV, AL, QF, AF, KF, zv) do { \
        const LAS bf16_t* Sc = St + ((n) & 1) * 32 * ST_LD; LAS bf16_t* Sn = St + (((n) + 1) & 1) * 32 * ST_LD; \
        const size_t trow = (size_t)b * SEQ + (size_t)(n) * CHUNK + ct * 16 + fr; \
        const float gl = __expf(wave_sum(-ealog * softplusf_(AL + dtb))); \
          \
        { bf16x8 yb[4]; \
          _Pragma("unroll") for (int ks = 0; ks < 4; ++ks) yb[ks] = *(const LAS bf16x8*)(Sc + (tt * 16 + fr) * ST_LD + ks * 32 + 8 * fq); \
          __builtin_amdgcn_sched_barrier(0); \
          f32x4 d = (f32x4){0.f, 0.f, 0.f, 0.f}; \
          _Pragma("unroll") for (int ks = 0; ks < 4; ++ks) d = MFMA16(WF[ks], yb[ks], d); \
          __builtin_amdgcn_sched_barrier(0); \
          const float v0 = bflo(UV.x) - d[0], v1 = bfhi(UV.x) - d[1], v2 = bflo(UV.y) - d[2], v3 = bfhi(UV.y) - d[3]; \
          u32x2 w; w.x = cvt_pk_bf16(v0, v1); w.y = cvt_pk_bf16(v2, v3); \
          *(LAS u32x2*)(VNt + (tt * 16 + fr) * VN_LD + ct * 16 + 4 * fq) = w; } \
        LDS_BARRIER(); \
          \
        f32x4 od; float ss; \
        { bf16x8 xb[4], vb[2], yb3[2][2]; \
          _Pragma("unroll") for (int ks = 0; ks < 4; ++ks) xb[ks] = *(const LAS bf16x8*)(Sc + (tt * 16 + fr) * ST_LD + ks * 32 + 8 * fq); \
          _Pragma("unroll") for (int ks = 0; ks < 2; ++ks) vb[ks] = *(const LAS bf16x8*)(VNt + (tt * 16 + fr) * VN_LD + ks * 32 + 8 * fq); \
          _Pragma("unroll") for (int t = 0; t < 2; ++t) _Pragma("unroll") for (int ks = 0; ks < 2; ++ks) yb3[t][ks] = *(const LAS bf16x8*)(VNt + (t * 16 + fr) * VN_LD + ks * 32 + 8 * fq); \
          f32x4 dd[2]; dd[0] = sacc[0] * gl; dd[1] = sacc[1] * gl; \
          __builtin_amdgcn_sched_barrier(0); \
          f32x4 d = (f32x4){0.f, 0.f, 0.f, 0.f}; \
            \
          _Pragma("unroll") for (int ks = 0; ks < 4; ++ks) { d = MFMA16(xb[ks], QF[ks], d); if (ks < 2) { dd[0] = MFMA16(KF[ks], yb3[0][ks], dd[0]); dd[1] = MFMA16(KF[ks], yb3[1][ks], dd[1]); } } \
          _Pragma("unroll") for (int ks = 0; ks < 2; ++ks) d = MFMA16(vb[ks], AF[ks], d); \
          __builtin_amdgcn_sched_barrier(0); \
          od = d; ss = (d[0] * d[0] + d[1] * d[1]) + (d[2] * d[2] + d[3] * d[3]); \
          _Pragma("unroll") for (int t = 0; t < 2; ++t) { sacc[t] = dd[t]; \
              u32x2 w; w.x = cvt_pk_bf16_mfma(dd[t][0], dd[t][1]); w.y = cvt_pk_bf16_mfma(dd[t][2], dd[t][3]); \
              *(LAS u32x2*)(Sn + (t * 16 + fr) * ST_LD + wave * 16 + 4 * fq) = w; } } \
        ss += __shfl_xor(ss, 16); ss += __shfl_xor(ss, 32); \
        if (fq == 0) red[(ct * 2 + tt) * 16 + fr] = ss; \
        LDS_BARRIER(); \
          \
        if (tt == 0 && fq == 0) PART[(trow * 4 + h) * 4 + sl] = red[(ct * 2) * 16 + fr] + red[(ct * 2 + 1) * 16 + fr]; \
        { const float z0 = bflo(zv.x), z1 = bfhi(zv.x), z2 = bflo(zv.y), z3 = bfhi(zv.y); \
          const float o0 = od[0] * gnj[0] * (z0 * sigmoidf_(z0)), o1 = od[1] * gnj[1] * (z1 * sigmoidf_(z1)); \
          const float o2 = od[2] * gnj[2] * (z2 * sigmoidf_(z2)), o3 = od[3] * gnj[3] * (z3 * sigmoidf_(z3)); \
          u32x2 w; w.x = cvt_pk_bf16(o0, o1); w.y = cvt_pk_bf16(o2, o3); \
          *(u32x2*)(OG + trow * 512 + h * 128 + dvg + 4 * fq) = w; } } while (0)
#define SCAN_WAIT(nn) do { if (((nn) & 7) == 0) { const unsigned* fp_ = flags + bh * NCH + (nn) + (lane & 7); \
        while (!__all(__hip_atomic_load(fp_, __ATOMIC_RELAXED, __HIP_MEMORY_SCOPE_AGENT) != 0u)) __builtin_amdgcn_s_sleep(2); \
        __builtin_amdgcn_fence(__ATOMIC_ACQUIRE, "agent"); asm volatile("s_waitcnt vmcnt(0)" ::: "memory"); } } while (0)
    const unsigned* flags = (const unsigned*)(ws + WS_CTL) + 1024;
    bf16x8 wfA[4], wfB[4], qfA[4], afA[2], qfB[4], afB[2], kfA[2], kfB[2]; u32x2 uvA, uvB, zvA, zvB; float alA, alB;
    SCAN_WAIT(0);
    SCAN_LOAD(0, wfA, uvA, alA, qfA, afA, kfA, zvA);
    for (int n = 0; n < NCH; n += 2) {
        SCAN_LOAD(n + 1, wfB, uvB, alB, qfB, afB, kfB, zvB);
        SCAN_STEP(n, wfA, uvA, alA, qfA, afA, kfA, zvA);
        const int n2 = (n + 2 < NCH) ? n + 2 : NCH - 1;
        SCAN_WAIT(n2); SCAN_LOAD(n2, wfA, uvA, alA, qfA, afA, kfA, zvA);
        SCAN_STEP(n + 1, wfB, uvB, alB, qfB, afB, kfB, zvB);
    }
#undef SCAN_LOAD
#undef SCAN_STEP
#undef SCAN_WAIT
    __syncthreads();
}
__device__ __forceinline__ void gdn_norm_pass(const Args& a, int bx, int G) {
    bf16_t* OG = (bf16_t*)(a.ws + WS_OG); const float* PART = (const float*)(a.ws + WS_SSQ);
    for (size_t g = (size_t)bx * 512 + threadIdx.x; g < (size_t)TOK * 4 * 16; g += (size_t)G * 512) {
        const size_t pair = g >> 4; const int seg = (int)(g & 15);
        const f32x4 p = *(const f32x4*)(PART + pair * 4);
        const float rstd = rsqrtf(((p[0] + p[1]) + (p[2] + p[3])) * (1.f / HD) + EPS);
        u32x4* ptr = (u32x4*)(OG + pair * 128 + seg * 8); const u32x4 v = *ptr; u32x4 w;
#pragma unroll
        for (int e = 0; e < 4; ++e) w[e] = cvt_pk_bf16(bflo(v[e]) * rstd, bfhi(v[e]) * rstd);
        *ptr = w;
    }
}

constexpr int KS_LD = 136, VT_LD = 72;
__device__ __forceinline__ void sb_unit(const Args& a, LAS unsigned char* lds, int uid) {
    const int tid = threadIdx.x, lane = tid & 63, wave = __builtin_amdgcn_readfirstlane(tid >> 6), fr = lane & 15, fq = lane >> 4;
    const int qb = uid & 63, bh = uid >> 6, h = bh & 3, b = bh >> 2;
    const bf16_t* SQ = (const bf16_t*)(a.ws + WS_SQKV); bf16_t* OS = (bf16_t*)(a.ws + WS_OS);
    LAS bf16_t* Ks = (LAS bf16_t*)lds;
    LAS bf16_t* Vt = (LAS bf16_t*)(lds + 64 * KS_LD * 2);
    LAS int* flags = (LAS int*)(lds + 64 * KS_LD * 2 + 128 * VT_LD * 2);
    const int q0 = qb * 128, tq = q0 + wave * 16 + fr;
    const size_t brow = (size_t)b * SEQ;
    bf16x8 qf[4];
    {
        u32x4 raw[4]; float s = 0.f;
#pragma unroll
        for (int ks = 0; ks < 4; ++ks) { raw[ks] = *(const u32x4*)(SQ + (brow + tq) * 1536 + h * 128 + ks * 32 + 8 * fq);
#pragma unroll
            for (int e = 0; e < 4; ++e) { const float lo = bflo(raw[ks][e]), hi = bfhi(raw[ks][e]); s += lo * lo + hi * hi; } }
        s += __shfl_xor(s, 16); s += __shfl_xor(s, 32);
        const float rs = rsqrtf(s * (1.f / HD) + EPS) * 0.08838834764831845f;
#pragma unroll
        for (int ks = 0; ks < 4; ++ks) { const float* gp = a.in[I_SBQG] + ks * 32 + 8 * fq; u32x4 w;
#pragma unroll
            for (int e = 0; e < 4; ++e) w[e] = cvt_pk_bf16(bflo(raw[ks][e]) * rs * gp[2 * e], bfhi(raw[ks][e]) * rs * gp[2 * e + 1]);
            qf[ks] = __builtin_bit_cast(bf16x8, w); }
    }
    f32x4 oacc[8];
#pragma unroll
    for (int j = 0; j < 8; ++j) oacc[j] = (f32x4){0.f, 0.f, 0.f, 0.f};
    float carry = 0.f;
    for (int kt = qb * 2 + 1; kt >= 0; --kt) {
#pragma unroll
        for (int j = 0; j < 2; ++j) { const int task = tid + 512 * j, r = task >> 4, seg = task & 15;
            const bf16_t* kp = SQ + (brow + kt * 64 + r) * 1536 + 512 + h * 128 + seg * 8;
            const u32x4 kr = *(const u32x4*)kp;
            float s = 0.f;
#pragma unroll
            for (int e = 0; e < 4; ++e) { const float lo = bflo(kr[e]), hi = bfhi(kr[e]); s += lo * lo + hi * hi; }
            s += __shfl_xor(s, 1); s += __shfl_xor(s, 2); s += __shfl_xor(s, 4); s += __shfl_xor(s, 8);
            const float rs = rsqrtf(s * (1.f / HD) + EPS); const float* gp = a.in[I_SBKG] + seg * 8; u32x4 w;
#pragma unroll
            for (int e = 0; e < 4; ++e) w[e] = cvt_pk_bf16(bflo(kr[e]) * rs * gp[2 * e], bfhi(kr[e]) * rs * gp[2 * e + 1]);
            *(LAS u32x4*)(Ks + r * KS_LD + seg * 8) = w; }
#pragma unroll
        for (int j = 0; j < 2; ++j) { const int task = tid + 512 * j, r = task & 63, seg = task >> 6;
            const u32x4 vr = *(const u32x4*)(SQ + (brow + kt * 64 + r) * 1536 + 1024 + h * 128 + seg * 8);
            const int xt = r >> 4, kfq = (r & 15) >> 2, ii = r & 3, slot = (xt >> 1) * 32 + kfq * 8 + (xt & 1) * 4 + ii;
#pragma unroll
            for (int e = 0; e < 4; ++e) { Vt[(seg * 8 + 2 * e) * VT_LD + slot] = (bf16_t)(vr[e] & 0xffffu); Vt[(seg * 8 + 2 * e + 1) * VT_LD + slot] = (bf16_t)(vr[e] >> 16); } }
        __syncthreads();
        f32x4 z[4];
#pragma unroll
        for (int xt = 0; xt < 4; ++xt) { f32x4 d = (f32x4){0.f, 0.f, 0.f, 0.f};
#pragma unroll
            for (int ks = 0; ks < 4; ++ks) { const bf16x8 xf = *(const LAS bf16x8*)(Ks + (xt * 16 + fr) * KS_LD + ks * 32 + 8 * fq); d = MFMA16(xf, qf[ks], d); }
            z[xt] = d; }
        float s4[4], lsg[4][4]; bool val[4][4];
#pragma unroll
        for (int xt = 0; xt < 4; ++xt) { s4[xt] = 0.f;
#pragma unroll
            for (int i = 0; i < 4; ++i) { const int key = kt * 64 + xt * 16 + 4 * fq + i; val[xt][i] = key < tq;
                const float sp = softplusf_(z[xt][i]); const float l = val[xt][i] ? -sp : 0.f; lsg[xt][i] = z[xt][i] - sp; z[xt][i] = l; s4[xt] += l; } }
        float R[4], Hh[4];
#pragma unroll
        for (int xt = 0; xt < 4; ++xt) { const float v1 = __shfl_xor(s4[xt], 16), v2 = __shfl_xor(s4[xt], 32), v3 = __shfl_xor(s4[xt], 48);
            R[xt] = s4[xt] + v1 + v2 + v3;
            Hh[xt] = (((fq ^ 1) > fq) ? v1 : 0.f) + (((fq ^ 2) > fq) ? v2 : 0.f) + (((fq ^ 3) > fq) ? v3 : 0.f); }
        float above = carry;
        u32x4 pw[2];
#pragma unroll
        for (int xt = 3; xt >= 0; --xt) { const float base = above + Hh[xt];
            const float b3 = base, b2 = b3 + z[xt][3], b1 = b2 + z[xt][2], b0 = b1 + z[xt][1];
            const float p0 = val[xt][0] ? __expf(lsg[xt][0] + b0) : 0.f, p1 = val[xt][1] ? __expf(lsg[xt][1] + b1) : 0.f;
            const float p2 = val[xt][2] ? __expf(lsg[xt][2] + b2) : 0.f, p3 = val[xt][3] ? __expf(lsg[xt][3] + b3) : 0.f;
            pw[xt >> 1][(xt & 1) * 2] = cvt_pk_bf16(p0, p1); pw[xt >> 1][(xt & 1) * 2 + 1] = cvt_pk_bf16(p2, p3);
            above += R[xt]; }
        carry = above;
#pragma unroll
        for (int ks = 0; ks < 2; ++ks) { const bf16x8 pf = __builtin_bit_cast(bf16x8, pw[ks]);
#pragma unroll
            for (int dt = 0; dt < 8; ++dt) { const bf16x8 xf = *(const LAS bf16x8*)(Vt + (dt * 16 + fr) * VT_LD + ks * 32 + 8 * fq); oacc[dt] = MFMA16(xf, pf, oacc[dt]); } }
        const bool done = __all(carry < -110.0f);
        if (lane == 0) flags[wave] = done ? 1 : 0;
        __syncthreads();
        int alld = 1;
#pragma unroll
        for (int w = 0; w < 8; ++w) alld &= flags[w];
        if (alld) break;
        __syncthreads();
    }
#pragma unroll
    for (int dt = 0; dt < 8; ++dt) { u32x2 w; w.x = cvt_pk_bf16_mfma(oacc[dt][0], oacc[dt][1]); w.y = cvt_pk_bf16_mfma(oacc[dt][2], oacc[dt][3]);
        *(u32x2*)(OS + (brow + tq) * 512 + h * 128 + dt * 16 + 4 * fq) = w; }
    __syncthreads();
}

constexpr int MK_LD = 136, MV_LD = 264;
__device__ __forceinline__ void mem_unit(const Args& a, LAS unsigned char* lds, int uid) {
    const int tid = threadIdx.x, lane = tid & 63, wave = __builtin_amdgcn_readfirstlane(tid >> 6), fr = lane & 15, fq = lane >> 4;
    const int qb = uid & 31, bh = uid >> 5, h = bh & 3, b = bh >> 2;
    bf16_t* MQ = (bf16_t*)(a.ws + WS_MQ); const bf16_t* KV = (const bf16_t*)(a.ws + WS_MEMKV);
    {
        const unsigned* cnt = (const unsigned*)(a.ws + WS_CTL) + 128;
        while (__hip_atomic_load(cnt, __ATOMIC_RELAXED, __HIP_MEMORY_SCOPE_AGENT) < 16u) __builtin_amdgcn_s_sleep(8);
        __builtin_amdgcn_fence(__ATOMIC_ACQUIRE, "agent"); asm volatile("s_waitcnt vmcnt(0)" ::: "memory");
    }
    LAS bf16_t* Km = (LAS bf16_t*)lds;
    LAS bf16_t* Vt = (LAS bf16_t*)(lds + 256 * MK_LD * 2);
#pragma unroll
    for (int j = 0; j < 8; ++j) { const int task = tid + 512 * j, r = task >> 4, seg = task & 15;
        const bf16_t* kp = KV + (size_t)(b * NMEM + r) * 1024 + h * 128 + seg * 8;
        const u32x4 kr = *(const u32x4*)kp; const u32x4 vr = *(const u32x4*)(kp + 512);
        float s = 0.f;
#pragma unroll
        for (int e = 0; e < 4; ++e) { const float lo = bflo(kr[e]), hi = bfhi(kr[e]); s += lo * lo + hi * hi; }
        s += __shfl_xor(s, 1); s += __shfl_xor(s, 2); s += __shfl_xor(s, 4); s += __shfl_xor(s, 8);
        const float rs = rsqrtf(s * (1.f / HD) + EPS); const float* gp = a.in[I_MKG] + seg * 8; u32x4 w;
#pragma unroll
        for (int e = 0; e < 4; ++e) w[e] = cvt_pk_bf16(bflo(kr[e]) * rs * gp[2 * e], bfhi(kr[e]) * rs * gp[2 * e + 1]);
        *(LAS u32x4*)(Km + r * MK_LD + seg * 8) = w;
        const int xt = r >> 4, kfq = (r & 15) >> 2, ii = r & 3, slot = (xt >> 1) * 32 + kfq * 8 + (xt & 1) * 4 + ii;
#pragma unroll
        for (int e = 0; e < 4; ++e) { Vt[(seg * 8 + 2 * e) * MV_LD + slot] = (bf16_t)(vr[e] & 0xffffu); Vt[(seg * 8 + 2 * e + 1) * MV_LD + slot] = (bf16_t)(vr[e] >> 16); } }
    __syncthreads();
    for (int pass = 0; pass < 2; ++pass) {
        const size_t trow = (size_t)b * SEQ + qb * 256 + pass * 128 + wave * 16 + fr;
        bf16x8 qf[4];
        {
            u32x4 raw[4]; float s = 0.f;
#pragma unroll
            for (int ks = 0; ks < 4; ++ks) { raw[ks] = *(const u32x4*)(MQ + trow * 512 + h * 128 + ks * 32 + 8 * fq);
#pragma unroll
                for (int e = 0; e < 4; ++e) { const float lo = bflo(raw[ks][e]), hi = bfhi(raw[ks][e]); s += lo * lo + hi * hi; } }
            s += __shfl_xor(s, 16); s += __shfl_xor(s, 32);
            const float rs = rsqrtf(s * (1.f / HD) + EPS) * 0.08838834764831845f;
#pragma unroll
            for (int ks = 0; ks < 4; ++ks) { const float* gp = a.in[I_MQG] + ks * 32 + 8 * fq; u32x4 w;
#pragma unroll
                for (int e = 0; e < 4; ++e) w[e] = cvt_pk_bf16(bflo(raw[ks][e]) * rs * gp[2 * e], bfhi(raw[ks][e]) * rs * gp[2 * e + 1]);
                qf[ks] = __builtin_bit_cast(bf16x8, w); }
        }
        f32x4 z[16]; float mx = -3.0e38f;
#pragma unroll
        for (int xt = 0; xt < 16; ++xt) { f32x4 d = (f32x4){0.f, 0.f, 0.f, 0.f};
#pragma unroll
            for (int ks = 0; ks < 4; ++ks) { const bf16x8 xf = *(const LAS bf16x8*)(Km + (xt * 16 + fr) * MK_LD + ks * 32 + 8 * fq); d = MFMA16(xf, qf[ks], d); }
            z[xt] = d; mx = fmaxf(mx, fmaxf(fmaxf(d[0], d[1]), fmaxf(d[2], d[3]))); }
        mx = fmaxf(mx, __shfl_xor(mx, 16)); mx = fmaxf(mx, __shfl_xor(mx, 32));
        float sum = 0.f;
#pragma unroll
        for (int xt = 0; xt < 16; ++xt) {
#pragma unroll
            for (int i = 0; i < 4; ++i) { const float p = __expf(z[xt][i] - mx); z[xt][i] = p; sum += p; } }
        sum += __shfl_xor(sum, 16); sum += __shfl_xor(sum, 32);
        const float inv = 1.0f / sum;
        f32x4 oacc[8];
#pragma unroll
        for (int j = 0; j < 8; ++j) oacc[j] = (f32x4){0.f, 0.f, 0.f, 0.f};
#pragma unroll
        for (int ks = 0; ks < 8; ++ks) { u32x4 pw; pw.x = cvt_pk_bf16(z[2 * ks][0], z[2 * ks][1]); pw.y = cvt_pk_bf16(z[2 * ks][2], z[2 * ks][3]); pw.z = cvt_pk_bf16(z[2 * ks + 1][0], z[2 * ks + 1][1]); pw.w = cvt_pk_bf16(z[2 * ks + 1][2], z[2 * ks + 1][3]);
            const bf16x8 pf = __builtin_bit_cast(bf16x8, pw);
#pragma unroll
            for (int dt = 0; dt < 8; ++dt) { const bf16x8 xf = *(const LAS bf16x8*)(Vt + (dt * 16 + fr) * MV_LD + ks * 32 + 8 * fq); oacc[dt] = MFMA16(xf, pf, oacc[dt]); } }
#pragma unroll
        for (int dt = 0; dt < 8; ++dt) { u32x2 w; w.x = cvt_pk_bf16(oacc[dt][0] * inv, oacc[dt][1] * inv); w.y = cvt_pk_bf16(oacc[dt][2] * inv, oacc[dt][3] * inv);
            *(u32x2*)(MQ + trow * 512 + h * 128 + dt * 16 + 4 * fq) = w; }
    }
    __syncthreads();
}

__device__ __forceinline__ void l2_flush(const float* x, int bx, int tid, float* sink) {
    const f32x4* p = (const f32x4*)x + (size_t)bx * 32768 + tid;
    f32x4 a = (f32x4){0.f, 0.f, 0.f, 0.f};
#pragma unroll 8
    for (int i = 0; i < 64; ++i) a += p[(size_t)i * 512];
    if (a[0] + a[1] + a[2] + a[3] == 1.2345e38f) *sink = a[0];
}

__global__ void __launch_bounds__(512) fwd_megakernel(Args args) {
    extern __shared__ __attribute__((aligned(16))) unsigned char lds_raw[];
    LAS unsigned char* lds = (LAS unsigned char*)lds_raw;
    cg::grid_group grid = cg::this_grid();
    const int G = gridDim.x, bx = blockIdx.x, tid = threadIdx.x;
    const int vcu = (G % 8 == 0) ? (bx % 8) * (G / 8) + bx / 8 : bx;
    unsigned char* ws = args.ws;
    unsigned* ctl = (unsigned*)(ws + WS_CTL);
    LAS int* qslot = (LAS int*)(lds + LDS_BYTES - 64);
    const int lo = args.ph_lo, hi = args.ph_hi;
#ifndef PH_MASK
#define PH_MASK 0x1ff
#endif
#ifdef TIME_MASK
    unsigned long long t_ph0 = 0;
#define PH_T0(k) do { if ((TIME_MASK >> (k)) & 1) t_ph0 = __builtin_amdgcn_s_memrealtime(); } while (0)
#define PH_T1(k) do { if ((TIME_MASK >> (k)) & 1) { const unsigned long long t1_ = __builtin_amdgcn_s_memrealtime(); const unsigned long long d_ = t1_ - t_ph0; while (__builtin_amdgcn_s_memrealtime() - t1_ < d_) __builtin_amdgcn_s_sleep(8); } } while (0)
#else
#define PH_T0(k) do { } while (0)
#define PH_T1(k) do { } while (0)
#endif
#define INR(k) (lo <= (k) && (k) < hi)
#define IN(k) (((PH_MASK >> (k)) & 1) && INR(k))
#define SEAM(k) do { if (INR(k) && INR((k) + 1)) { asm volatile("s_waitcnt vmcnt(0)" ::: "memory"); grid.sync(); \
        __builtin_amdgcn_fence(__ATOMIC_ACQUIRE, "agent"); asm volatile("s_waitcnt vmcnt(0)" ::: "memory"); } } while (0)

    PH_T0(0); if (IN(0)) phase0(args, lds, vcu, G);
    SEAM(0); PH_T1(0);
#ifdef TEST_GEMM
    if (IN(1)) {
        EpiP7 E{(const bf16_t*)(ws + WS_H), args.out};
        SchedGrid S{(const char*)(ws + WS_H), (const char*)(ws + WS_WO), TOK / 256, DM / 256, G, bx, (size_t)256 * 1024 * 2};
        pg8::gemm_phase<EpiP7, SchedGrid, true, true>(lds, 1024, S, E);
    }
#endif
#ifdef TEST_GEMM
    if (false) {
#else
    PH_T0(1); if (IN(1)) {
#endif
        EpiP1 E{(bf16_t*)args.out, (bf16_t*)(ws + WS_GZ), (bf16_t*)(ws + WS_SQKV), (bf16_t*)(ws + WS_MQ), (bf16_t*)(ws + WS_GATES), (bf16_t*)(ws + WS_MEMKV), 0};
        SchedGrid S{(const char*)(ws + WS_H), (const char*)(ws + WS_WIN), TOK / 256, 16, G, bx, (size_t)256 * 1024 * 2};
        pg8::gemm_phase<EpiP1, SchedGrid, true, true>(lds, 1024, S, E);
    }
    SEAM(1); PH_T1(1);
    PH_T0(3); if (IN(3)) {
#ifdef TIME_SCAN
        if (bx < NB * NH * 4) { const unsigned long long t0_ = __builtin_amdgcn_s_memrealtime(); gdn_scan_unit(args, lds, bx); const unsigned long long t1_ = __builtin_amdgcn_s_memrealtime(); while (__builtin_amdgcn_s_memrealtime() - t1_ < (t1_ - t0_)) __builtin_amdgcn_s_sleep(8); }
#else
        if (bx < NB * NH * 4) gdn_scan_unit(args, lds, bx);
        else { const int nprep = G - NB * NH * 4;
            int pend = -1;
            for (int u = bx - NB * NH * 4; u < NB * NH * NCH; u += nprep) { const int cid = (u & 15) * NCH + (u >> 4);
                gdn_prep_unit(args, lds, cid);
                const bool flush = (pend >= 0) || (u + nprep >= NB * NH * NCH) || (u < 2 * nprep);
                if (flush) { if (tid == 0) { __builtin_amdgcn_fence(__ATOMIC_RELEASE, "agent"); asm volatile("s_waitcnt vmcnt(0)" ::: "memory");
                        if (pend >= 0) __hip_atomic_store(ctl + 1024 + pend, 1u, __ATOMIC_RELAXED, __HIP_MEMORY_SCOPE_AGENT);
                        __hip_atomic_store(ctl + 1024 + cid, 1u, __ATOMIC_RELAXED, __HIP_MEMORY_SCOPE_AGENT); } pend = -1; }
                else pend = cid; }
            if (bx - NB * NH * 4 < 16) {
                EpiP1 E2{(bf16_t*)args.out, (bf16_t*)(ws + WS_GZ), (bf16_t*)(ws + WS_SQKV), (bf16_t*)(ws + WS_MQ), (bf16_t*)(ws + WS_GATES), (bf16_t*)(ws + WS_MEMKV), 1};
                SchedGrid S2{(const char*)(ws + WS_MEMN), (const char*)(ws + WS_WMKV), 4, 4, G, bx - NB * NH * 4, (size_t)256 * 1024 * 2};
                pg8::gemm_phase<EpiP1, SchedGrid, true, true>(lds, 1024, S2, E2);
                asm volatile("s_waitcnt vmcnt(0)" ::: "memory"); __syncthreads();
                if (tid == 0) { __builtin_amdgcn_fence(__ATOMIC_RELEASE, "agent"); asm volatile("s_waitcnt vmcnt(0)" ::: "memory");
                    __hip_atomic_fetch_add(ctl + 128, 1u, __ATOMIC_RELAXED, __HIP_MEMORY_SCOPE_AGENT); }
            }
        }
#endif
        for (;;) {
            if (tid == 0) *qslot = (int)atomicAdd(ctl + 64, 1u);
            __syncthreads();
            const int it = *qslot;
            __syncthreads();
            if (it >= 1024 + 512) break;
            if (it < 1024) sb_unit(args, lds, it); else mem_unit(args, lds, it - 1024);
        }
    }
    SEAM(3); PH_T1(3);
    PH_T0(4); if (IN(4)) {
        gdn_norm_pass(args, bx, G);
        EpiP1 E{(bf16_t*)args.out, (bf16_t*)(ws + WS_GZ), (bf16_t*)(ws + WS_SQKV), (bf16_t*)(ws + WS_MQ), (bf16_t*)(ws + WS_GATES), (bf16_t*)(ws + WS_MEMKV), 2};
        SchedGrid S{(const char*)(ws + WS_H), (const char*)(ws + WS_WIN) + (size_t)4096 * 1024 * 2, TOK / 256, 12, G, bx, (size_t)256 * 1024 * 2};
        pg8::gemm_phase<EpiP1, SchedGrid, true, true>(lds, 1024, S, E);
    }
    SEAM(4); PH_T1(4);
    PH_T0(5); if (IN(5)) {
        EpiP3 E{(const bf16_t*)(ws + WS_GATES), (float*)(ws + WS_MIXF + (size_t)bx * 262144), (bf16_t*)(ws + WS_MIX)};
        SchedBranch S{(const char*)(ws + WS_OG), (const char*)(ws + WS_OS), (const char*)(ws + WS_MQ), (const char*)(ws + WS_WBR), G, bx, (size_t)256 * 512 * 2};
        pg8::gemm_phase<EpiP3, SchedBranch, true, true>(lds, 512, S, E);
    }
    SEAM(5); PH_T1(5);
    PH_T0(6); if (IN(6)) {
        EpiP4 E{args.in[I_X], args.out, (bf16_t*)(ws + WS_X1B), (float*)(ws + WS_SSQ)};
        SchedGrid S{(const char*)(ws + WS_MIX), (const char*)(ws + WS_WO), TOK / 256, DM / 256, G, bx, (size_t)256 * 1024 * 2};
        pg8::gemm_phase<EpiP4, SchedGrid, true, true>(lds, 1024, S, E);
    }
    SEAM(6); PH_T1(6);
    PH_T0(7); if (IN(7)) {
        EpiP6 E{(const float*)(ws + WS_SSQ), (bf16_t*)(ws + WS_ACT)};
        SchedGrid S{(const char*)(ws + WS_X1B), (const char*)(ws + WS_WUP), TOK / 256, DFF / 256, G, bx, (size_t)256 * 1024 * 2};
        pg8::gemm_phase<EpiP6, SchedGrid, true, true>(lds, 1024, S, E);
    }
    SEAM(7); PH_T1(7);
    PH_T0(8); if (IN(8)) {
#ifdef P7_VIA_WS
        EpiP7 E{(const bf16_t*)(ws + WS_X1B), (float*)(ws + 46 * MiB)};
#else
        EpiP7 E{(const bf16_t*)(ws + WS_X1B), args.out};
#endif
#ifdef TEST_P7
        E.x1b = (const bf16_t*)(ws + TEST_A);
        SchedGrid S{(const char*)(ws + TEST_A), (const char*)(ws + WS_WO), TOK / 256, DM / 256, G, bx, (size_t)256 * 1024 * 2};
        pg8::gemm_phase<EpiP7, SchedGrid, true, true>(lds, 1024, S, E);
#else
        SchedGrid S{(const char*)(ws + WS_ACT), (const char*)(ws + WS_WDN), TOK / 256, DM / 256, G, bx, (size_t)256 * 4096 * 2};
        pg8::gemm_phase<EpiP7, SchedGrid, true, true>(lds, 4096, S, E);
#endif
    }
#ifdef P7_VIA_WS
    { asm volatile("s_waitcnt vmcnt(0)" ::: "memory"); grid.sync(); __builtin_amdgcn_fence(__ATOMIC_ACQUIRE, "agent"); asm volatile("s_waitcnt vmcnt(0)" ::: "memory");
      const f32x4* src = (const f32x4*)(ws + 46 * MiB); f32x4* dst = (f32x4*)args.out;
      for (size_t i = (size_t)bx * 512 + tid; i < (size_t)TOK * DM / 4; i += (size_t)G * 512) dst[i] = src[i]; }
#endif
    asm volatile("s_waitcnt vmcnt(0)" ::: "memory"); __syncthreads();
    if (tid == 0) { __builtin_amdgcn_fence(__ATOMIC_RELEASE, "agent"); asm volatile("s_waitcnt vmcnt(0)" ::: "memory"); }
#ifdef DUMP_OFF
    if (lo == 0) { asm volatile("s_waitcnt vmcnt(0)" ::: "memory"); grid.sync(); __builtin_amdgcn_fence(__ATOMIC_ACQUIRE, "agent"); asm volatile("s_waitcnt vmcnt(0)" ::: "memory"); }
    if (lo == 100 || lo == 0) {
        const unsigned* src = (const unsigned*)(ws + (size_t)DUMP_OFF);
        { const int xcd = bx & 7, k = bx >> 3, pmt = xcd * 16 + (k >> 1), half = k & 1;
          const size_t base = ((size_t)pmt * 256 + (size_t)half * 128) * 512;
          for (int j = tid; j < 128 * 512; j += 512) { const size_t i = base + j; const unsigned u = src[i]; args.out[2 * i] = bflo(u); args.out[2 * i + 1] = bfhi(u); } }
    }
    asm volatile("s_waitcnt vmcnt(0)" ::: "memory"); __syncthreads();
    if (tid == 0) { __builtin_amdgcn_fence(__ATOMIC_RELEASE, "agent"); asm volatile("s_waitcnt vmcnt(0)" ::: "memory"); }
#endif
#undef IN
#undef SEAM
}

#ifndef MK_N_LAUNCHES
#define MK_N_LAUNCHES 1
#endif
extern "C" void kernel_launch(void* const* d_in, const int* in_sizes, int n_in, void* d_out, int out_size, void* d_ws, size_t ws_size, hipStream_t stream) {
    static int grid = 0;
    if (grid == 0) {
        if (n_in != 21 || out_size != TOK * DM || ws_size < WS_END) { fprintf(stderr, "kernel_launch: unexpected shapes (n_in %d, out %d, ws %zu)\n", n_in, out_size, ws_size); grid = -1; return; }
        int dev = 0, cus = 0, per_cu = 0;
        hipGetDevice(&dev); hipDeviceGetAttribute(&cus, hipDeviceAttributeMultiprocessorCount, dev);
        hipFuncSetAttribute((const void*)fwd_megakernel, hipFuncAttributeMaxDynamicSharedMemorySize, LDS_BYTES);
        hipOccupancyMaxActiveBlocksPerMultiprocessor(&per_cu, (const void*)fwd_megakernel, 512, LDS_BYTES);
        (void)hipGetLastError();
        if (per_cu < 1) { fprintf(stderr, "kernel_launch: occupancy query says %d workgroups per CU\n", per_cu); per_cu = 1; }
        grid = cus;
    }
    if (grid < 0) return;
    hipMemsetAsync((char*)d_ws + WS_CTL, 0, 16384, stream);
    Args a{};
    for (int i = 0; i < 21; ++i) a.in[i] = (const float*)d_in[i];
    a.out = (float*)d_out; a.ws = (unsigned char*)d_ws;
#if MK_N_LAUNCHES == 1
#ifdef DUMP_OFF
    a.ph_lo = 0; a.ph_hi = DUMP_AFTER + 1;
#elif defined(TEST_GEMM)
    a.ph_lo = 0; a.ph_hi = 2;
#else
    a.ph_lo = 0; a.ph_hi = 9;
#endif
    void* kargs[] = {&a};
    hipError_t e = hipLaunchCooperativeKernel((const void*)fwd_megakernel, dim3(grid), dim3(512), kargs, LDS_BYTES, stream);
    if (e != hipSuccess) fprintf(stderr, "cooperative launch failed: %s (grid %d)\n", hipGetErrorString(e), grid);
#else
#ifdef DUMP_OFF
    for (int p = 0; p <= DUMP_AFTER; ++p) { a.ph_lo = p; a.ph_hi = p + 1; hipLaunchKernelGGL(fwd_megakernel, dim3(grid), dim3(512), LDS_BYTES, stream, a); }
    a.ph_lo = 100; a.ph_hi = 101; hipLaunchKernelGGL(fwd_megakernel, dim3(grid), dim3(512), LDS_BYTES, stream, a);
#else
    for (int p = 0; p < 9; ++p) { a.ph_lo = p; a.ph_hi = p + 1; hipLaunchKernelGGL(fwd_megakernel, dim3(grid), dim3(512), LDS_BYTES, stream, a); }
#endif
#endif
}
```

```cpp
#include <hip/hip_runtime.h>
#include <hip/hip_cooperative_groups.h>
#include <cstdio>
#include <cstdint>
namespace cg = cooperative_groups;

#define LAS __attribute__((address_space(3)))
typedef unsigned short bf16_t;
typedef short bf16x8 __attribute__((ext_vector_type(8)));
typedef float f32x4 __attribute__((ext_vector_type(4)));
typedef float f32x2 __attribute__((ext_vector_type(2)));
typedef unsigned u32x4 __attribute__((ext_vector_type(4)));
typedef unsigned u32x2 __attribute__((ext_vector_type(2)));

constexpr int DM = 1024, NB = 4, SEQ = 8192, TOK = NB * SEQ;
constexpr int NH = 4, HD = 128, BW = 512;
constexpr int CHUNK = 64, NCH = SEQ / CHUNK;
constexpr int NMEM = 256, DFF = 4096, DIN = 7176, NPROJ = 7168;
constexpr float EPS = 1e-6f;

constexpr size_t MiB = 1u << 20;
constexpr size_t WS_CTL = 0;
constexpr size_t WS_WIN = 1 * MiB;
constexpr size_t WS_WMKV = 15 * MiB;
constexpr size_t WS_WBR = 17 * MiB;
constexpr size_t WS_WO = 20 * MiB;
constexpr size_t WS_WUP = 22 * MiB;
constexpr size_t WS_WDN = 30 * MiB;
constexpr size_t WS_MEMN = 38 * MiB;
constexpr size_t WS_MEMKV = 40 * MiB;
constexpr size_t WS_AB = 42 * MiB;
constexpr size_t WS_SSQ = 43 * MiB;
constexpr size_t WS_GL = 45 * MiB;
constexpr size_t WS_H = 46 * MiB;
constexpr size_t WS_GDNI = 110 * MiB;
constexpr size_t GI_W = 0, GI_QD = 32 * MiB, GI_KDT = 64 * MiB, GI_UT = 96 * MiB, GI_A = 128 * MiB;
constexpr size_t WS_GZ = 254 * MiB;
constexpr size_t WS_GQKV = 286 * MiB;
constexpr size_t WS_OG = 318 * MiB;
constexpr size_t WS_OS = 350 * MiB;
constexpr size_t WS_SQKV = 382 * MiB;
constexpr size_t WS_MQ = 478 * MiB;
constexpr size_t WS_GATES = 110 * MiB;
constexpr size_t WS_MIXF = 382 * MiB;
constexpr size_t WS_MIX = 46 * MiB;
constexpr size_t WS_X1B = 110 * MiB;
constexpr size_t WS_ACT = 174 * MiB;
constexpr size_t WS_END = 510 * MiB;

constexpr int LDS_BYTES = 147456;

typedef __bf16 bf16x2_t __attribute__((ext_vector_type(2)));
__device__ __forceinline__ unsigned cvt_pk_bf16_mfma(float lo, float hi) { f32x2 v = {lo, hi}; bf16x2_t b = __builtin_convertvector(v, bf16x2_t); return __builtin_bit_cast(unsigned, b); }
__device__ __forceinline__ unsigned cvt_pk_bf16(float lo, float hi) { unsigned r; asm volatile("v_cvt_pk_bf16_f32 %0, %1, %2" : "=v"(r) : "v"(lo), "v"(hi)); return r; }
__device__ __forceinline__ float bflo(unsigned u) { return __uint_as_float(u << 16); }
__device__ __forceinline__ float bfhi(unsigned u) { return __uint_as_float(u & 0xffff0000u); }
__device__ __forceinline__ float wave_sum(float v) {
#pragma unroll
    for (int o = 1; o < 64; o <<= 1) v += __shfl_xor(v, o);
    return v;
}
__device__ __forceinline__ float sigmoidf_(float x) { return 1.0f / (1.0f + __expf(-x)); }
__device__ __forceinline__ float softplusf_(float x) { return fmaxf(x, 0.f) + __logf(1.0f + __expf(-fabsf(x))); }
__device__ __forceinline__ u32x2 ld8_agent(const void* p) { const unsigned long long v = __hip_atomic_load((const unsigned long long*)p, __ATOMIC_RELAXED, __HIP_MEMORY_SCOPE_AGENT); u32x2 r; r.x = (unsigned)v; r.y = (unsigned)(v >> 32); return r; }
#define MFMA16(x, y, c) __builtin_amdgcn_mfma_f32_16x16x32_bf16((x), (y), (c), 0, 0, 0)
#define LDS_WAIT() asm volatile("s_waitcnt lgkmcnt(0)" ::: "memory")
#define LDS_BARRIER() do { asm volatile("s_waitcnt lgkmcnt(0)" ::: "memory"); __builtin_amdgcn_s_barrier(); asm volatile("" ::: "memory"); } while (0)

namespace pg8 {
constexpr int BM = 256, BK = 64, HALF = 128, HTB = HALF * BK * 2, STAGE_BYTES = 8 * HTB, NXCD = 8, WGM = 8;
__host__ __device__ __forceinline__ int lds_byte(int r, int c) { const int st = (r >> 4) * 2 + (c >> 5), rr = r & 15, cc = c & 31, ob = rr * 64 + cc * 2; return st * 1024 + (ob ^ (((ob >> 9) & 1) << 5)); }
__host__ __device__ __forceinline__ void stage_rc(int b, int& R, int& C) { const int st = b / 1024, sb = b % 1024, swz = sb ^ (((sb >> 9) & 1) << 5); R = (st >> 1) * 16 + swz / 64; C = (st & 1) * 32 + (swz % 64) / 2; }
__host__ __device__ __forceinline__ int perm32(int rho) { const int n = rho >> 4, i = rho & 15; return 8 * (i >> 2) + 4 * n + (i & 3); }

struct Unit { int pm, pn, kind; const char* A; const char* B; };

__device__ __forceinline__ bool tile_order(int nM, int nN, int G, int c, int i, int& pm, int& pn) {
    const int nwg = nM * nN; const long L = (long)i * G + c; if (L >= nwg) return false;
    int wgid = (int)L; { const int q = nwg / NXCD, r = nwg % NXCD, xcd = wgid % NXCD, off = wgid / NXCD; wgid = (xcd < r ? xcd * (q + 1) : r * (q + 1) + (xcd - r) * q) + off; }
    const int nig = WGM * nN, gid = wgid / nig, fm = gid * WGM, gsz = (nM - fm) < WGM ? (nM - fm) : WGM;
    pm = fm + ((wgid % nig) % gsz); pn = (wgid % nig) / gsz; return true;
}

template <class Epi, class Sched, bool ALIGN_EPI, bool SP2>
__device__ __forceinline__ void gemm_phase(LAS unsigned char* lds, const int K, const Sched& S, const Epi& E) {
    const int tid = threadIdx.x, wid = __builtin_amdgcn_readfirstlane(tid >> 6), lane = tid & 63, wr = wid >> 2, wc = wid & 3, fr = lane & 15, fq = lane >> 4;
    const int nt = K / BK;
    unsigned voffA[2], voffB[2];
#pragma unroll
    for (int i = 0; i < 2; ++i) { int R, C; stage_rc(tid * 16 + i * 8192, R, C); const int Rb = Epi::PERM ? ((R & ~31) + perm32(R & 31)) : R;
        voffA[i] = (unsigned)(R * K + C) * 2u; voffB[i] = (unsigned)(Rb * K + C) * 2u; }
    const size_t kstep = (size_t)(BK * 2);
    const size_t hstep = (size_t)HALF * K * 2;
    const unsigned ldsw = (unsigned)wid * 1024u;
    const int aoff = lds_byte(wr * 64 + fr, fq * 8), boff = lds_byte(wc * 32 + fr, fq * 8);
#define PG8_SA(b, h) (((b) * 2 + (h)) * HTB)
#define PG8_SB(b, h) ((4 + (b) * 2 + (h)) * HTB)
#define PG8_STAGE(bufoff, gbase, voff) do { _Pragma("unroll") for (int _i = 0; _i < 2; ++_i) \
        __builtin_amdgcn_global_load_lds((const unsigned*)((const char*)(gbase) + (voff)[_i]), (LAS unsigned*)(lds + (bufoff) + ldsw + _i * 8192), 16, 0, 0); } while (0)
#define PG8_LDA(dst, b, h) do { _Pragma("unroll") for (int m = 0; m < 4; ++m) _Pragma("unroll") for (int k = 0; k < 2; ++k) dst[m][k] = *(const LAS bf16x8*)(lds + PG8_SA(b, h) + aoff + m * 2048 + k * 1024); } while (0)
#define PG8_LDB(dst, b, h) do { _Pragma("unroll") for (int n = 0; n < 2; ++n) _Pragma("unroll") for (int k = 0; k < 2; ++k) dst[n][k] = *(const LAS bf16x8*)(lds + PG8_SB(b, h) + boff + n * 2048 + k * 1024); } while (0)
#define PG8_MMA(ai, bj, At, Bt) do { __builtin_amdgcn_s_setprio(1); _Pragma("unroll") for (int m = 0; m < 4; ++m) _Pragma("unroll") for (int n = 0; n < 2; ++n) _Pragma("unroll") for (int k = 0; k < 2; ++k) \
        acc[ai][bj][m][n] = __builtin_amdgcn_mfma_f32_16x16x32_bf16(Bt[n][k], At[m][k], acc[ai][bj][m][n], 0, 0, 0); __builtin_amdgcn_s_setprio(0); } while (0)
#define PG8_WAIT_V(n) asm volatile("s_waitcnt vmcnt(" #n ")" ::: "memory")
#define PG8_WAIT_L(n) asm volatile("s_waitcnt lgkmcnt(" #n ")" ::: "memory")
#define PG8_BAR __builtin_amdgcn_s_barrier()
#define PG8_SCHED __builtin_amdgcn_sched_barrier(0)
    Unit cur, nxt; int ui = 0;
    if (!S.next(0, cur)) return;
    f32x4 acc[2][2][4][2];
#pragma unroll
    for (int a = 0; a < 2; ++a)
#pragma unroll
        for (int b = 0; b < 2; ++b)
#pragma unroll
            for (int m = 0; m < 4; ++m)
#pragma unroll
                for (int n = 0; n < 2; ++n) acc[a][b][m][n] = (f32x4){0.f, 0.f, 0.f, 0.f};
    bf16x8 At[4][2], B0[2][2], B1[2][2];
    const char* cA = cur.A; const char* cB = cur.B;
    if constexpr (SP2) {
        PG8_STAGE(PG8_SB(0, 0), cB, voffB); PG8_STAGE(PG8_SB(0, 1), cB + hstep, voffB); PG8_STAGE(PG8_SA(0, 0), cA, voffA); PG8_STAGE(PG8_SA(0, 1), cA + hstep, voffA);
        if (wr == 1) PG8_BAR;
        PG8_WAIT_V(2); PG8_BAR;
        PG8_STAGE(PG8_SB(1, 0), cB + kstep, voffB); PG8_STAGE(PG8_SA(1, 0), cA + kstep, voffA); PG8_STAGE(PG8_SB(1, 1), cB + hstep + kstep, voffB);
        PG8_WAIT_V(6); PG8_BAR;
    } else {
        PG8_STAGE(PG8_SB(0, 0), cB, voffB); PG8_STAGE(PG8_SA(0, 0), cA, voffA); PG8_STAGE(PG8_SB(0, 1), cB + hstep, voffB); PG8_STAGE(PG8_SA(0, 1), cA + hstep, voffA);
        if (wr == 1) PG8_BAR;
        PG8_WAIT_V(4); PG8_BAR;
        PG8_STAGE(PG8_SB(1, 0), cB + kstep, voffB); PG8_STAGE(PG8_SA(1, 0), cA + kstep, voffA); PG8_STAGE(PG8_SB(1, 1), cB + hstep + kstep, voffB);
        PG8_WAIT_V(6); PG8_BAR;
    }
    for (;;) {
        const bool has_next = S.next(ui + 1, nxt);
        const char* nA = has_next ? nxt.A : cA; const char* nB = has_next ? nxt.B : cB;
        for (int t = 0; t < nt; t += 2) {
            const bool last = (t == nt - 2);
            const char* a1 = cA + (size_t)(t + 1) * kstep;
            const char* a2 = last ? nA : cA + (size_t)(t + 2) * kstep; const char* b2 = last ? nB : cB + (size_t)(t + 2) * kstep;
            const char* a3 = a2 + kstep; const char* b3 = b2 + kstep;
            if constexpr (SP2) {
            PG8_LDB(B0, 0, 0); PG8_LDB(B1, 0, 1); PG8_SCHED; PG8_LDA(At, 0, 0); PG8_STAGE(PG8_SA(1, 1), a1 + hstep, voffA);
            PG8_WAIT_V(8); PG8_WAIT_L(0); PG8_BAR; PG8_MMA(0, 0, At, B0); PG8_MMA(0, 1, At, B1); PG8_BAR; PG8_SCHED;
            PG8_LDA(At, 0, 1); PG8_STAGE(PG8_SB(0, 0), b2, voffB); PG8_STAGE(PG8_SB(0, 1), b2 + hstep, voffB); PG8_STAGE(PG8_SA(0, 0), a2, voffA);
            PG8_WAIT_V(8); PG8_WAIT_L(0); PG8_BAR; PG8_MMA(1, 0, At, B0); PG8_MMA(1, 1, At, B1); PG8_BAR; PG8_SCHED;
            PG8_LDB(B0, 1, 0); PG8_LDB(B1, 1, 1); PG8_SCHED; PG8_LDA(At, 1, 0); PG8_STAGE(PG8_SA(0, 1), a2 + hstep, voffA);
            PG8_WAIT_V(8); PG8_WAIT_L(0); PG8_BAR; PG8_MMA(0, 0, At, B0); PG8_MMA(0, 1, At, B1); PG8_BAR; PG8_SCHED;
            PG8_LDA(At, 1, 1); PG8_STAGE(PG8_SB(1, 0), b3, voffB); PG8_STAGE(PG8_SB(1, 1), b3 + hstep, voffB); PG8_STAGE(PG8_SA(1, 0), a3, voffA);
            PG8_WAIT_V(8); PG8_WAIT_L(0); PG8_BAR; PG8_MMA(1, 0, At, B0); PG8_MMA(1, 1, At, B1); PG8_BAR; PG8_SCHED;
            } else {
            PG8_LDB(B0, 0, 0); PG8_SCHED; PG8_LDA(At, 0, 0); PG8_STAGE(PG8_SA(1, 1), a1 + hstep, voffA);
            PG8_WAIT_L(8); PG8_BAR; PG8_WAIT_L(0); PG8_MMA(0, 0, At, B0); PG8_BAR; PG8_SCHED;
            PG8_LDB(B1, 0, 1); PG8_STAGE(PG8_SB(0, 0), b2, voffB);
            PG8_BAR; PG8_WAIT_L(0); PG8_MMA(0, 1, At, B1); PG8_BAR;
            PG8_LDA(At, 0, 1); PG8_STAGE(PG8_SA(0, 0), a2, voffA);
            PG8_BAR; PG8_WAIT_L(0); PG8_MMA(1, 0, At, B0); PG8_BAR; PG8_SCHED;
            PG8_STAGE(PG8_SB(0, 1), b2 + hstep, voffB);
            PG8_WAIT_V(6); PG8_BAR; PG8_MMA(1, 1, At, B1); PG8_BAR;
            PG8_LDB(B0, 1, 0); PG8_SCHED; PG8_LDA(At, 1, 0); PG8_STAGE(PG8_SA(0, 1), a2 + hstep, voffA);
            PG8_WAIT_L(8); PG8_BAR; PG8_WAIT_L(0); PG8_MMA(0, 0, At, B0); PG8_BAR; PG8_SCHED;
            PG8_LDB(B1, 1, 1); PG8_STAGE(PG8_SB(1, 0), b3, voffB);
            PG8_BAR; PG8_WAIT_L(0); PG8_MMA(0, 1, At, B1); PG8_BAR;
            PG8_LDA(At, 1, 1); PG8_STAGE(PG8_SA(1, 0), a3, voffA);
            PG8_BAR; PG8_WAIT_L(0); PG8_MMA(1, 0, At, B0); PG8_BAR; PG8_SCHED;
            PG8_STAGE(PG8_SB(1, 1), b3 + hstep, voffB);
            PG8_WAIT_V(6); PG8_BAR; PG8_MMA(1, 1, At, B1); PG8_BAR;
            }
        }
        if constexpr (ALIGN_EPI) { if (wr == 0) PG8_BAR; }
        E(acc, cur, wr, wc, fr, fq);
        if (!has_next) break;
#pragma unroll
        for (int a = 0; a < 2; ++a)
#pragma unroll
            for (int b = 0; b < 2; ++b)
#pragma unroll
                for (int m = 0; m < 4; ++m)
#pragma unroll
                    for (int n = 0; n < 2; ++n) acc[a][b][m][n] = (f32x4){0.f, 0.f, 0.f, 0.f};
        cur = nxt; cA = nA; cB = nB; ++ui;
        if constexpr (ALIGN_EPI) { if (wr == 1) PG8_BAR; }
    }
    PG8_WAIT_V(0);
    if constexpr (!ALIGN_EPI) { if (wr == 0) PG8_BAR; }
    PG8_BAR;
#undef PG8_SA
#undef PG8_SB
#undef PG8_STAGE
#undef PG8_LDA
#undef PG8_LDB
#undef PG8_MMA
#undef PG8_WAIT_V
#undef PG8_WAIT_L
#undef PG8_BAR
#undef PG8_SCHED
}
}

struct Args {
    const float* in[21];
    float* out; unsigned char* ws;
    int ph_lo, ph_hi;
};
enum { I_X = 0, I_MEM, I_N1G, I_WIN, I_CONVW, I_ALOG, I_DTB, I_GDNG, I_SBQG, I_SBKG, I_MEMNG, I_WMKV, I_MQG, I_MKG, I_WBRG, I_WBRS, I_WBRM, I_WO, I_N2G, I_WUP, I_WDN };

struct SchedGrid {
    const char* A; const char* B; int nM, nN, G, c; size_t tstep;
    __device__ __forceinline__ bool next(int i, pg8::Unit& u) const {
        if (!pg8::tile_order(nM, nN, G, c, i, u.pm, u.pn)) return false;
        u.kind = 0; u.A = A + (size_t)u.pm * tstep; u.B = B + (size_t)u.pn * tstep; return true;
    }
};
struct SchedBranch {
    const char* A0; const char* A1; const char* A2; const char* B; int G, c; size_t tstep;
    __device__ __forceinline__ bool next(int i, pg8::Unit& u) const {
        const int t = i / 3, br = i - 3 * t;
        if (!pg8::tile_order(TOK / 256, DM / 256, G, c, t, u.pm, u.pn)) return false;
        u.kind = br; u.A = (br == 0 ? A0 : (br == 1 ? A1 : A2)) + (size_t)u.pm * tstep; u.B = B + (size_t)br * ((size_t)DM * BW * 2) + (size_t)u.pn * tstep; return true;
    }
};

struct EpiP1 {
    static constexpr bool PERM = true;
    bf16_t* gqkv; bf16_t* gz; bf16_t* sqkv; bf16_t* mq; bf16_t* gates; bf16_t* memkv; int is_mem;
    __device__ __forceinline__ void operator()(const f32x4 (&acc)[2][2][4][2], const pg8::Unit& u, int wr, int wc, int fr, int fq) const {
        bf16_t* base; int ldc, c0; bool sig = false; const int pn = u.pn;
        if (is_mem == 1) { base = memkv; ldc = 1024; c0 = pn * 256; }
        else if (is_mem == 2) { base = gates; ldc = 3072; c0 = pn * 256; sig = true; }
        else if (pn < 6) { base = gqkv; ldc = 1536; c0 = pn * 256; }
        else if (pn < 8) { base = gz; ldc = 512; c0 = (pn - 6) * 256; }
        else if (pn < 14) { base = sqkv; ldc = 1536; c0 = (pn - 8) * 256; }
        else { base = mq; ldc = 512; c0 = (pn - 14) * 256; }
        const int row0 = u.pm * 256 + wr * 64 + fr, col0 = c0 + wc * 32 + 8 * fq;
#pragma unroll
        for (int ai = 0; ai < 2; ++ai)
#pragma unroll
            for (int m = 0; m < 4; ++m) { bf16_t* rowp = base + (size_t)(row0 + ai * 128 + m * 16) * ldc + col0;
#pragma unroll
                for (int bj = 0; bj < 2; ++bj) { f32x4 v0 = acc[ai][bj][m][0], v1 = acc[ai][bj][m][1];
                    if (sig) {
#pragma unroll
                        for (int e = 0; e < 4; ++e) { v0[e] = sigmoidf_(v0[e]); v1[e] = sigmoidf_(v1[e]); } }
                    u32x4 w; w.x = cvt_pk_bf16_mfma(v0[0], v0[1]); w.y = cvt_pk_bf16_mfma(v0[2], v0[3]); w.z = cvt_pk_bf16_mfma(v1[0], v1[1]); w.w = cvt_pk_bf16_mfma(v1[2], v1[3]);
                    *(u32x4*)(rowp + bj * 128) = w; } }
    }
};
struct EpiP3 {
    static constexpr bool PERM = true;
    const bf16_t* gates; float* priv; bf16_t* mix;
    __device__ __forceinline__ void operator()(const f32x4 (&acc)[2][2][4][2], const pg8::Unit& u, int wr, int wc, int fr, int fq) const {
        const int br = u.kind; int opq; asm volatile("v_mov_b32 %0, 0" : "=v"(opq));
        const unsigned row0 = (unsigned)(u.pm * 256 + wr * 64 + fr + opq), col0 = (unsigned)(u.pn * 256 + wc * 32 + 8 * fq);
        const unsigned goff0 = row0 * 3072u + (unsigned)br * 1024u + col0, moff0 = row0 * 1024u + col0;
        u32x4* pv = (u32x4*)priv + threadIdx.x + opq;
        if (br > 0) asm volatile("s_waitcnt vmcnt(0)" ::: "memory");
#pragma unroll
        for (int ai = 0; ai < 2; ++ai)
#pragma unroll
            for (int m = 0; m < 4; ++m) {
#pragma unroll
                for (int bj = 0; bj < 2; ++bj) {
                    const u32x4 g = *(const u32x4*)(gates + (goff0 + (unsigned)((ai * 128 + m * 16) * 3072 + bj * 128)));
                    f32x4 v0 = acc[ai][bj][m][0], v1 = acc[ai][bj][m][1];
                    v0[0] *= bflo(g.x); v0[1] *= bfhi(g.x); v0[2] *= bflo(g.y); v0[3] *= bfhi(g.y);
                    v1[0] *= bflo(g.z); v1[1] *= bfhi(g.z); v1[2] *= bflo(g.w); v1[3] *= bfhi(g.w);
                    const int ri = (ai * 2 + bj) * 4 + m;
                    if (br > 0) { const u32x4 p = pv[ri * 512];
                        v0[0] += bflo(p.x); v0[1] += bfhi(p.x); v0[2] += bflo(p.y); v0[3] += bfhi(p.y);
                        v1[0] += bflo(p.z); v1[1] += bfhi(p.z); v1[2] += bflo(p.w); v1[3] += bfhi(p.w); }
                    u32x4 w; w.x = cvt_pk_bf16(v0[0], v0[1]); w.y = cvt_pk_bf16(v0[2], v0[3]); w.z = cvt_pk_bf16(v1[0], v1[1]); w.w = cvt_pk_bf16(v1[2], v1[3]);
                    if (br < 2) pv[ri * 512] = w;
                    else *(u32x4*)(mix + (moff0 + (unsigned)((ai * 128 + m * 16) * 1024 + bj * 128))) = w; }
                asm volatile("" ::: "memory"); }
    }
};
struct EpiP4 {
    static constexpr bool PERM = true;
    const float* x; float* out; bf16_t* x1b; float* ssq;
    __device__ __forceinline__ void operator()(const f32x4 (&acc)[2][2][4][2], const pg8::Unit& u, int wr, int wc, int fr, int fq) const {
        int opq; asm volatile("v_mov_b32 %0, 0" : "=v"(opq));
        const unsigned row0 = (unsigned)(u.pm * 256 + wr * 64 + fr + opq), col0 = (unsigned)(u.pn * 256 + wc * 32 + 8 * fq);
#pragma unroll
        for (int ai = 0; ai < 2; ++ai)
#pragma unroll
            for (int m = 0; m < 4; ++m) { const unsigned row = row0 + ai * 128 + m * 16; float s = 0.f;
#pragma unroll
                for (int bj = 0; bj < 2; ++bj) { const unsigned off = row * 1024u + col0 + bj * 128;
#ifdef P4_MINIMAL
                    const f32x4 o0 = acc[ai][bj][m][0], o1 = acc[ai][bj][m][1];
#else
                    const f32x4 o0 = *(const f32x4*)(x + off) + acc[ai][bj][m][0], o1 = *(const f32x4*)(x + off + 4) + acc[ai][bj][m][1];
#endif
                    s += (o0[0] * o0[0] + o0[1] * o0[1]) + (o0[2] * o0[2] + o0[3] * o0[3]) + (o1[0] * o1[0] + o1[1] * o1[1]) + (o1[2] * o1[2] + o1[3] * o1[3]);
                    u32x4 w; w.x = cvt_pk_bf16(o0[0], o0[1]); w.y = cvt_pk_bf16(o0[2], o0[3]); w.z = cvt_pk_bf16(o1[0], o1[1]); w.w = cvt_pk_bf16(o1[2], o1[3]);
                    *(u32x4*)(x1b + off) = w; }
#ifndef NO_SSQ
                s += __shfl_xor(s, 16); s += __shfl_xor(s, 32);
                if (fq == 0) ssq[(size_t)u.pn * (TOK * 4) + row * 4 + wc] = s;
#endif
                asm volatile("" ::: "memory"); }
    }
};
struct EpiP6 {
    static constexpr bool PERM = true;
    const float* ssq; bf16_t* act;
    __device__ __forceinline__ void operator()(const f32x4 (&acc)[2][2][4][2], const pg8::Unit& u, int wr, int wc, int fr, int fq) const {
        const int row0 = u.pm * 256 + wr * 64 + fr, col0 = u.pn * 256 + wc * 32 + 8 * fq;
#pragma unroll
        for (int ai = 0; ai < 2; ++ai)
#pragma unroll
            for (int m = 0; m < 4; ++m) { const size_t row = (size_t)(row0 + ai * 128 + m * 16);
                const f32x4 p = *(const f32x4*)(ssq + (size_t)fq * (TOK * 4) + row * 4); float s = (p[0] + p[1]) + (p[2] + p[3]);
                s += __shfl_xor(s, 16); s += __shfl_xor(s, 32);
                const float rstd = rsqrtf(s * (1.0f / DM) + EPS);
#pragma unroll
                for (int bj = 0; bj < 2; ++bj) { f32x4 v0 = acc[ai][bj][m][0] * rstd, v1 = acc[ai][bj][m][1] * rstd;
#pragma unroll
                    for (int e = 0; e < 4; ++e) { const float a = fmaxf(v0[e], 0.f), b = fmaxf(v1[e], 0.f); v0[e] = a * a; v1[e] = b * b; }
                    u32x4 w; w.x = cvt_pk_bf16(v0[0], v0[1]); w.y = cvt_pk_bf16(v0[2], v0[3]); w.z = cvt_pk_bf16(v1[0], v1[1]); w.w = cvt_pk_bf16(v1[2], v1[3]);
                    *(u32x4*)(act + row * 4096 + col0 + bj * 128) = w; } }
    }
};
struct EpiP7 {
    static constexpr bool PERM = false;
    const bf16_t* x1b; float* out;
    __device__ __forceinline__ void operator()(const f32x4 (&acc)[2][2][4][2], const pg8::Unit& u, int wr, int wc, int fr, int fq) const {
        int opq; asm volatile("v_mov_b32 %0, 0" : "=v"(opq));
        const unsigned row0 = (unsigned)(u.pm * 256 + wr * 64 + fr + opq), col0 = (unsigned)(u.pn * 256 + wc * 32 + 4 * fq);
#pragma unroll
        for (int ai = 0; ai < 2; ++ai)
#pragma unroll
            for (int m = 0; m < 4; ++m) { const unsigned row = row0 + ai * 128 + m * 16;
#pragma unroll
                for (int bj = 0; bj < 2; ++bj)
#pragma unroll
                    for (int n = 0; n < 2; ++n) { const unsigned off = row * 1024u + col0 + bj * 128 + n * 16;
                        const u32x2 xb = *(const u32x2*)(x1b + off);
                        f32x4 o = acc[ai][bj][m][n];
#ifndef P7_NOX
                        o[0] += bflo(xb.x); o[1] += bfhi(xb.x); o[2] += bflo(xb.y); o[3] += bfhi(xb.y);
#endif
                        *(f32x4*)(out + off) = o; }
                asm volatile("" ::: "memory"); }
    }
};

__device__ __forceinline__ void p0_transpose_item(const float* W, int K, int ldw, int N, bf16_t* WT, const float* kscale, int skip_at, LAS float* scr, int item, int lane) {
    const int nblk = N / 32, kb = item / nblk, nb = item % nblk, k0 = 64 * kb, n0 = 32 * nb;
    const int src0 = n0 + (n0 >= skip_at ? 8 : 0);
#pragma unroll 8
    for (int i = 0; i < 32; ++i) { const int kk = 2 * i + (lane >> 5); float v = W[(size_t)(k0 + kk) * ldw + src0 + (lane & 31)]; if (kscale) v *= kscale[k0 + kk]; scr[kk * 33 + (lane & 31)] = v; }
    LDS_WAIT(); asm volatile("" ::: "memory");
    const int c = lane & 7;
#pragma unroll
    for (int j = 0; j < 4; ++j) { const int n = (lane >> 3) + 8 * j; const LAS float* s = scr + (8 * c) * 33 + n;
        u32x4 o; o.x = cvt_pk_bf16(s[0 * 33], s[1 * 33]); o.y = cvt_pk_bf16(s[2 * 33], s[3 * 33]); o.z = cvt_pk_bf16(s[4 * 33], s[5 * 33]); o.w = cvt_pk_bf16(s[6 * 33], s[7 * 33]);
        *(u32x4*)(WT + (size_t)(n0 + n) * K + k0 + 8 * c) = o; }
    LDS_WAIT(); asm volatile("" ::: "memory");
}

__device__ __forceinline__ void phase0(const Args& a, LAS unsigned char* lds, int vcu, int G) {
    const int tid = threadIdx.x, lane = tid & 63, wave = __builtin_amdgcn_readfirstlane(tid >> 6);
    unsigned char* ws = a.ws;
    LAS float* wab = (LAS float*)(lds + 8 * 8448);
    for (int e = tid; e < 8192; e += 512) wab[e] = a.in[I_WIN][(size_t)(e >> 3) * DIN + 2048 + (e & 7)];
    LAS float* scr = (LAS float*)(lds + wave * 8448);
    const int gw = vcu * 8 + wave, NGW = G * 8;
    constexpr int I_IN = 16 * 224, I_MKV = 16 * 32, I_BR = 8 * 32, I_O = 16 * 32, I_UP = 16 * 128, I_DN = 64 * 32;
    constexpr int NITEMS = I_IN + I_MKV + 3 * I_BR + I_O + I_UP + I_DN;
    for (int it = gw; it < NITEMS; it += NGW) {
        int r = it;
        if (r < I_IN) { p0_transpose_item(a.in[I_WIN], 1024, DIN, NPROJ, (bf16_t*)(ws + WS_WIN), nullptr, 2048, scr, r, lane); continue; } r -= I_IN;
        if (r < I_MKV) { p0_transpose_item(a.in[I_WMKV], 1024, 1024, 1024, (bf16_t*)(ws + WS_WMKV), nullptr, 1 << 30, scr, r, lane); continue; } r -= I_MKV;
        if (r < I_BR) { p0_transpose_item(a.in[I_WBRG], 512, 1024, 1024, (bf16_t*)(ws + WS_WBR), nullptr, 1 << 30, scr, r, lane); continue; } r -= I_BR;
        if (r < I_BR) { p0_transpose_item(a.in[I_WBRS], 512, 1024, 1024, (bf16_t*)(ws + WS_WBR) + (size_t)DM * BW, nullptr, 1 << 30, scr, r, lane); continue; } r -= I_BR;
        if (r < I_BR) { p0_transpose_item(a.in[I_WBRM], 512, 1024, 1024, (bf16_t*)(ws + WS_WBR) + (size_t)2 * DM * BW, nullptr, 1 << 30, scr, r, lane); continue; } r -= I_BR;
        if (r < I_O) { p0_transpose_item(a.in[I_WO], 1024, 1024, 1024, (bf16_t*)(ws + WS_WO), nullptr, 1 << 30, scr, r, lane); continue; } r -= I_O;
        if (r < I_UP) { p0_transpose_item(a.in[I_WUP], 1024, 4096, 4096, (bf16_t*)(ws + WS_WUP), a.in[I_N2G], 1 << 30, scr, r, lane); continue; } r -= I_UP;
        p0_transpose_item(a.in[I_WDN], 4096, 1024, 1024, (bf16_t*)(ws + WS_WDN), nullptr, 1 << 30, scr, r, lane);
    }
    __syncthreads();
    const float* g1 = a.in[I_N1G]; bf16_t* H = (bf16_t*)(ws + WS_H); float* AB = (float*)(ws + WS_AB);
    f32x4 gv[4];
#pragma unroll
    for (int j = 0; j < 4; ++j) gv[j] = *(const f32x4*)(g1 + 256 * j + 4 * lane);
    for (int m = gw; m < TOK; m += NGW) {
        const f32x4* xr = (const f32x4*)(a.in[I_X] + (size_t)m * DM) + lane;
        f32x4 v[4]; float s = 0.f;
#pragma unroll
        for (int j = 0; j < 4; ++j) { v[j] = xr[64 * j]; s += (v[j].x * v[j].x + v[j].y * v[j].y) + (v[j].z * v[j].z + v[j].w * v[j].w); }
        const float rstd = rsqrtf(wave_sum(s) * (1.f / DM) + EPS);
        float p[8];
#pragma unroll
        for (int c = 0; c < 8; ++c) p[c] = 0.f;
        u32x2* o8 = (u32x2*)(H + (size_t)m * DM) + lane;
#pragma unroll
        for (int j = 0; j < 4; ++j) { v[j] = v[j] * rstd * gv[j];
            u32x2 w; w.x = cvt_pk_bf16(v[j].x, v[j].y); w.y = cvt_pk_bf16(v[j].z, v[j].w); o8[64 * j] = w;
#pragma unroll
            for (int e = 0; e < 4; ++e) { const LAS f32x4* wp = (const LAS f32x4*)(wab + (256 * j + 4 * lane + e) * 8); const f32x4 w0 = wp[0], w1 = wp[1]; const float hv = v[j][e];
                p[0] += hv * w0.x; p[1] += hv * w0.y; p[2] += hv * w0.z; p[3] += hv * w0.w; p[4] += hv * w1.x; p[5] += hv * w1.y; p[6] += hv * w1.z; p[7] += hv * w1.w; } }
#pragma unroll
        for (int c = 0; c < 8; ++c) p[c] = wave_sum(p[c]);
        if (lane == 0) { f32x4* ab = (f32x4*)(AB + (size_t)m * 8); ab[0] = (f32x4){p[0], p[1], p[2], p[3]}; ab[1] = (f32x4){p[4], p[5], p[6], p[7]}; }
    }
    const float* gm = a.in[I_MEMNG]; bf16_t* MN = (bf16_t*)(ws + WS_MEMN);
#pragma unroll
    for (int j = 0; j < 4; ++j) gv[j] = *(const f32x4*)(gm + 256 * j + 4 * lane);
    for (int m = gw; m < NB * NMEM; m += NGW) {
        const f32x4* xr = (const f32x4*)(a.in[I_MEM] + (size_t)m * DM) + lane;
        f32x4 v[4]; float s = 0.f;
#pragma unroll
        for (int j = 0; j < 4; ++j) { v[j] = xr[64 * j]; s += (v[j].x * v[j].x + v[j].y * v[j].y) + (v[j].z * v[j].z + v[j].w * v[j].w); }
        const float rstd = rsqrtf(wave_sum(s) * (1.f / DM) + EPS);
        u32x2* o8 = (u32x2*)(MN + (size_t)m * DM) + lane;
#pragma unroll
        for (int j = 0; j < 4; ++j) { v[j] = v[j] * rstd * gv[j]; u32x2 w; w.x = cvt_pk_bf16(v[j].x, v[j].y); w.y = cvt_pk_bf16(v[j].z, v[j].w); o8[64 * j] = w; }
    }
}

constexpr int PQ_LD = 136;
__device__ __forceinline__ void gdn_prep_unit(const Args& a, LAS unsigned char* lds, int cid) {
    const int tid = threadIdx.x, lane = tid & 63, wave = __builtin_amdgcn_readfirstlane(tid >> 6), fr = lane & 15, fq = lane >> 4;
    unsigned char* ws = a.ws;
    const int n = cid & (NCH - 1), bh = cid >> 7, h = bh & 3, b = bh >> 2;
    const size_t row0 = (size_t)b * SEQ + (size_t)n * CHUNK;
    LAS bf16_t* Qb = (LAS bf16_t*)lds;
    LAS bf16_t* Kb = (LAS bf16_t*)(lds + 17408);
    LAS float* Kf = (LAS float*)(lds + 34816);
    LAS float* Vf = (LAS float*)(lds + 34816 + 32768);
    LAS float* Lm = (LAS float*)(lds + 34816 + 65536);
    LAS float* gcs = (LAS float*)(lds + 34816 + 65536 + 16384);
    LAS float* bet = gcs + 64;
    LAS float* bge = gcs + 128;
    const bf16_t* GQ = (const bf16_t*)a.out;
    if (wave == 0) {
        const float* AB = (const float*)(ws + WS_AB) + (row0 + lane) * 8;
        const float al = AB[h], bl = AB[4 + h];
        float g = -__expf(a.in[I_ALOG][h]) * softplusf_(al + a.in[I_DTB][h]);
#pragma unroll
        for (int o = 1; o < 64; o <<= 1) { const float t = __shfl_up(g, o); if (lane >= o) g += t; }
        const float be = sigmoidf_(bl);
        gcs[lane] = g; bet[lane] = be; bge[lane] = be * __expf(g);
        { const float gle = __expf(__shfl(g, 63)); if (lane < 32) ((float*)(ws + WS_GL))[cid * 32 + lane] = gle; }
    }
    {
        const float* cw = a.in[I_CONVW];
        float wq[4][2], wk[4][2], wv[4][2];
#pragma unroll
        for (int j = 0; j < 4; ++j) { const float* p = cw + j * 1536 + h * 128 + 2 * lane; wq[j][0] = p[0]; wq[j][1] = p[1]; wk[j][0] = p[512]; wk[j][1] = p[513]; wv[j][0] = p[1024]; wv[j][1] = p[1025]; }
        unsigned rq[11], rk[11], rv[11];
#pragma unroll
        for (int i = 0; i < 11; ++i) { const int rr = wave * 8 + i - 3; const bool ok = (n > 0) || (rr >= 0);
            const bf16_t* p = GQ + (row0 + rr) * 1536 + h * 128 + 2 * lane;
            rq[i] = ok ? *(const unsigned*)p : 0u; rk[i] = ok ? *(const unsigned*)(p + 512) : 0u; rv[i] = ok ? *(const unsigned*)(p + 1024) : 0u; }
#pragma unroll
        for (int i = 0; i < 8; ++i) { const int r = wave * 8 + i;
            float q0 = 0.f, q1 = 0.f, k0 = 0.f, k1 = 0.f, v0 = 0.f, v1 = 0.f;
#pragma unroll
            for (int j = 0; j < 4; ++j) { q0 += wq[j][0] * bflo(rq[i + j]); q1 += wq[j][1] * bfhi(rq[i + j]); k0 += wk[j][0] * bflo(rk[i + j]); k1 += wk[j][1] * bfhi(rk[i + j]);
                v0 += wv[j][0] * bflo(rv[i + j]); v1 += wv[j][1] * bfhi(rv[i + j]); }
            q0 *= sigmoidf_(q0); q1 *= sigmoidf_(q1); k0 *= sigmoidf_(k0); k1 *= sigmoidf_(k1); v0 *= sigmoidf_(v0); v1 *= sigmoidf_(v1);
            const float qn = rsqrtf(wave_sum(q0 * q0 + q1 * q1) + EPS) * 0.08838834764831845f, kn = rsqrtf(wave_sum(k0 * k0 + k1 * k1) + EPS);
            q0 *= qn; q1 *= qn; k0 *= kn; k1 *= kn;
            *(LAS unsigned*)(Qb + r * PQ_LD + 2 * lane) = cvt_pk_bf16(q0, q1);
            *(LAS unsigned*)(Kb + r * PQ_LD + 2 * lane) = cvt_pk_bf16(k0, k1);
            *(LAS f32x2*)(Kf + r * 128 + 2 * lane) = (f32x2){k0, k1};
            *(LAS f32x2*)(Vf + r * 128 + 2 * lane) = (f32x2){v0, v1}; }
    }
    __syncthreads();
    {
        const int mat = wave >> 2, ct = wave & 3;
        const LAS bf16_t* Xb = mat ? Qb : Kb;
        bf16x8 xf[4];
#pragma unroll
        for (int ks = 0; ks < 4; ++ks) xf[ks] = *(const LAS bf16x8*)(Xb + (ct * 16 + fr) * PQ_LD + ks * 32 + 8 * fq);
        bf16_t* Ag = (bf16_t*)(ws + WS_GDNI + GI_A) + (size_t)cid * 4096;
#pragma unroll
        for (int st = 0; st < 4; ++st) {
            f32x4 d = (f32x4){0.f, 0.f, 0.f, 0.f};
#pragma unroll
            for (int ks = 0; ks < 4; ++ks) { const bf16x8 yf = *(const LAS bf16x8*)(Kb + (st * 16 + fr) * PQ_LD + ks * 32 + 8 * fq); d = MFMA16(xf[ks], yf, d); }
            const int s = st * 16 + fr; const float gs = gcs[s];
#pragma unroll
            for (int i = 0; i < 4; ++i) { const int c = ct * 16 + 4 * fq + i; const float dec = __expf(fminf(gcs[c] - gs, 0.f));
                if (mat == 0) Lm[c * 64 + s] = (c > s) ? bet[c] * d[i] * dec : 0.f;
                else Ag[c * 64 + s] = (bf16_t)(cvt_pk_bf16((c >= s) ? d[i] * dec : 0.f, 0.f) & 0xffffu); }
        }
    }
    __syncthreads();
    const size_t gbase = (size_t)cid * 8192;
    if (wave < 4) {
        const int col = (wave & 1) * 64 + lane; const bool isw = wave >= 2;
        const LAS float* src = isw ? Kf : Vf; const LAS float* scl = isw ? bge : bet;
        float xv[64]; int opq; asm volatile("v_mov_b32 %0, 0" : "=v"(opq));
        const LAS float* Lmv = Lm + opq;
#pragma unroll
        for (int i = 0; i < 64; ++i) xv[i] = 0.f;
#pragma unroll
        for (int i = 0; i < 64; ++i) {
            float r0 = src[i * 128 + col] * scl[i], r1 = 0.f, r2 = 0.f, r3 = 0.f;
#pragma unroll
            for (int j4 = 0; j4 < (i + 3) / 4; ++j4) { const f32x4 lv = *(const LAS f32x4*)(Lmv + i * 64 + 4 * j4);
                r0 -= lv.x * xv[4 * j4]; r1 -= lv.y * xv[4 * j4 + 1]; r2 -= lv.z * xv[4 * j4 + 2]; r3 -= lv.w * xv[4 * j4 + 3]; }
            xv[i] = (r0 + r1) + (r2 + r3);
        }
        if (!isw) {
            u32x4* up = (u32x4*)((bf16_t*)(ws + WS_GDNI + GI_UT) + gbase + (size_t)col * 64);
#pragma unroll
            for (int j = 0; j < 8; ++j) { u32x4 w; w.x = cvt_pk_bf16(xv[8 * j], xv[8 * j + 1]); w.y = cvt_pk_bf16(xv[8 * j + 2], xv[8 * j + 3]); w.z = cvt_pk_bf16(xv[8 * j + 4], xv[8 * j + 5]); w.w = cvt_pk_bf16(xv[8 * j + 6], xv[8 * j + 7]); up[j] = w; }
        } else {
            bf16_t* wp = (bf16_t*)(ws + WS_GDNI + GI_W) + gbase + col;
#pragma unroll
            for (int i = 0; i < 64; ++i) wp[i * 128] = (bf16_t)(cvt_pk_bf16(xv[i], 0.f) & 0xffffu);
        }
    } else {
        const int t = tid - 256; const float gl = gcs[63];
        bf16_t* qd = (bf16_t*)(ws + WS_GDNI + GI_QD) + gbase; bf16_t* kdt = (bf16_t*)(ws + WS_GDNI + GI_KDT) + gbase;
#pragma unroll
        for (int j = 0; j < 4; ++j) { const int task = t + 256 * j, c = task >> 4, seg = task & 15; const float e = __expf(gcs[c]);
            const u32x4 qv = *(const LAS u32x4*)(Qb + c * PQ_LD + seg * 8);
            u32x4 w; w.x = cvt_pk_bf16(bflo(qv.x) * e, bfhi(qv.x) * e); w.y = cvt_pk_bf16(bflo(qv.y) * e, bfhi(qv.y) * e); w.z = cvt_pk_bf16(bflo(qv.z) * e, bfhi(qv.z) * e); w.w = cvt_pk_bf16(bflo(qv.w) * e, bfhi(qv.w) * e);
            *(u32x4*)(qd + c * 128 + seg * 8) = w; }
#pragma unroll
        for (int j = 0; j < 4; ++j) { const int task = t + 256 * j, dk = task & 127, c8 = task >> 7; float v[8];
#pragma unroll
            for (int e = 0; e < 8; ++e) { const int c = c8 * 8 + e; v[e] = Kf[c * 128 + dk] * __expf(gl - gcs[c]); }
            u32x4 w; w.x = cvt_pk_bf16(v[0], v[1]); w.y = cvt_pk_bf16(v[2], v[3]); w.z = cvt_pk_bf16(v[4], v[5]); w.w = cvt_pk_bf16(v[6], v[7]);
            *(u32x4*)(kdt + dk * 64 + c8 * 8) = w; }
    }
    asm volatile("s_waitcnt vmcnt(0)" ::: "memory"); __syncthreads();
}

constexpr int ST_LD = 136, VN_LD = 72;
__device__ __forceinline__ void gdn_scan_unit(const Args& a, LAS unsigned char* lds, int unit) {
    const int tid = threadIdx.x, lane = tid & 63, wave = __builtin_amdgcn_readfirstlane(tid >> 6), fr = lane & 15, fq = lane >> 4;
    unsigned char* ws = a.ws;
    const int bh = unit >> 2, sl = unit & 3, h = bh & 3, b = bh >> 2;
    LAS bf16_t* St = (LAS bf16_t*)lds;
    LAS bf16_t* VNt = (LAS bf16_t*)(lds + 2 * 32 * ST_LD * 2);
    LAS float* red = (LAS float*)(lds + 2 * 32 * ST_LD * 2 + 32 * VN_LD * 2);
    for (int e = tid; e < 32 * ST_LD / 2; e += 512) ((LAS unsigned*)St)[e] = 0u;
    f32x4 sacc[2];
    sacc[0] = (f32x4){0.f, 0.f, 0.f, 0.f}; sacc[1] = sacc[0];
    const int ct = wave >> 1, tt = wave & 1;
    const int dvg = sl * 32 + tt * 16;
    const bf16_t* Wg = (const bf16_t*)(ws + WS_GDNI + GI_W); const bf16_t* QDg = (const bf16_t*)(ws + WS_GDNI + GI_QD);
    const bf16_t* KDTg = (const bf16_t*)(ws + WS_GDNI + GI_KDT); const bf16_t* UTg = (const bf16_t*)(ws + WS_GDNI + GI_UT); const bf16_t* Ag = (const bf16_t*)(ws + WS_GDNI + GI_A);
    const bf16_t* GZ = (const bf16_t*)(ws + WS_GZ); bf16_t* OG = (bf16_t*)(ws + WS_OG); float* PART = (float*)(ws + WS_SSQ);
    const f32x4 gnj = *(const f32x4*)(a.in[I_GDNG] + dvg + 4 * fq);
    const float ealog = __expf(a.in[I_ALOG][h]), dtb = a.in[I_DTB][h];
    __syncthreads();
#define SCAN_LOAD(nn, WF, UV, AL, QF, AF, KF, ZV) do { const int cid_ = bh * NCH + (nn); const size_t gb_ = (size_t)cid_ * 8192; \
        _Pragma("unroll") for (int ks = 0; ks < 4; ++ks) { WF[ks] = *(const bf16x8*)(Wg + gb_ + (ct * 16 + fr) * 128 + ks * 32 + 8 * fq); QF[ks] = *(const bf16x8*)(QDg + gb_ + (ct * 16 + fr) * 128 + ks * 32 + 8 * fq); } \
        _Pragma("unroll") for (int ks = 0; ks < 2; ++ks) { AF[ks] = *(const bf16x8*)(Ag + (size_t)cid_ * 4096 + (ct * 16 + fr) * 64 + ks * 32 + 8 * fq); KF[ks] = *(const bf16x8*)(KDTg + gb_ + (wave * 16 + fr) * 64 + ks * 32 + 8 * fq); } \
        UV = *(const u32x2*)(UTg + gb_ + (dvg + fr) * 64 + ct * 16 + 4 * fq); \
        ZV = *(const u32x2*)(GZ + ((size_t)b * SEQ + (size_t)(nn) * CHUNK + ct * 16 + fr) * 512 + h * 128 + dvg + 4 * fq); \
        AL = ((const float*)(ws + WS_AB))[((size_t)b * SEQ + (size_t)(nn) * CHUNK + lane) * 8 + h]; } while (0)
#define SCAN_STEP(n, WF, UV, AL, QF, AF, KF, zv) do { \
        const LAS bf16_t* Sc = St + ((n) & 1) * 32 * ST_LD; LAS bf16_t* Sn = St + (((n) + 1) & 1) * 32 * ST_LD; \
        const size_t trow = (size_t)b * SEQ + (size_t)(n) * CHUNK + ct * 16 + fr; \
        const float gl = __expf(wave_sum(-ealog * softplusf_(AL + dtb))); \
          \
        { bf16x8 yb[4]; \
          _Pragma("unroll") for (int ks = 0; ks < 4; ++ks) yb[ks] = *(const LAS bf16x8*)(Sc + (tt * 16 + fr) * ST_LD + ks * 32 + 8 * fq); \
          __builtin_amdgcn_sched_barrier(0); \
          f32x4 d = (f32x4){0.f, 0.f, 0.f, 0.f}; \
          _Pragma("unroll") for (int ks = 0; ks < 4; ++ks) d = MFMA16(WF[ks], yb[ks], d); \
          __builtin_amdgcn_sched_barrier(0); \
          const float v0 = bflo(UV.x) - d[0], v1 = bfhi(UV.x) - d[1], v2 = bflo(UV.y) - d[2], v3 = bfhi(UV.y) - d[3]; \
          u32x2 w; w.x = cvt_pk_bf16(v0, v1); w.y = cvt_pk_bf16(v2, v3); \
          *(LAS u32x2*)(VNt + (tt * 16 + fr) * VN_LD + ct * 16 + 4 * fq) = w; } \
        LDS_BARRIER(); \
          \
        f32x4 od; float ss; \
        { bf16x8 xb[4], vb[2], yb3[2][2]; \
          _Pragma("unroll") for (int ks = 0; ks < 4; ++ks) xb[ks] = *(const LAS bf16x8*)(Sc + (tt * 16 + fr) * ST_LD + ks * 32 + 8 * fq); \
          _Pragma("unroll") for (int ks = 0; ks < 2; ++ks) vb[ks] = *(const LAS bf16x8*)(VNt + (tt * 16 + fr) * VN_LD + ks * 32 + 8 * fq); \
          _Pragma("unroll") for (int t = 0; t < 2; ++t) _Pragma("unroll") for (int ks = 0; ks < 2; ++ks) yb3[t][ks] = *(const LAS bf16x8*)(VNt + (t * 16 + fr) * VN_LD + ks * 32 + 8 * fq); \
          f32x4 dd[2]; dd[0] = sacc[0] * gl; dd[1] = sacc[1] * gl; \
          __builtin_amdgcn_sched_barrier(0); \
          f32x4 d = (f32x4){0.f, 0.f, 0.f, 0.f}; \
            \
          _Pragma("unroll") for (int ks = 0; ks < 4; ++ks) { d = MFMA16(xb[ks], QF[ks], d); if (ks < 2) { dd[0] = MFMA16(KF[ks], yb3[0][ks], dd[0]); dd[1] = MFMA16(KF[ks], yb3[1][ks], dd[1]); } } \
          _Pragma("unroll") for (int ks = 0; ks < 2; ++ks) d = MFMA16(vb[ks], AF[ks], d); \
          __builtin_amdgcn_sched_barrier(0); \
          od = d; ss = (d[0] * d[0] + d[1] * d[1]) + (d[2] * d[2] + d[3] * d[3]); \
          _Pragma("unroll") for (int t = 0; t < 2; ++t) { sacc[t] = dd[t]; \
              u32x2 w; w.x = cvt_pk_bf16_mfma(dd[t][0], dd[t][1]); w.y = cvt_pk_bf16_mfma(dd[t][2], dd[t][3]); \
              *(LAS u32x2*)(Sn + (t * 16 + fr) * ST_LD + wave * 16 + 4 * fq) = w; } } \
        ss += __shfl_xor(ss, 16); ss += __shfl_xor(ss, 32); \
        if (fq == 0) red[(ct * 2 + tt) * 16 + fr] = ss; \
        LDS_BARRIER(); \
          \
        if (tt == 0 && fq == 0) PART[(trow * 4 + h) * 4 + sl] = red[(ct * 2) * 16 + fr] + red[(ct * 2 + 1) * 16 + fr]; \
        { const float z0 = bflo(zv.x), z1 = bfhi(zv.x), z2 = bflo(zv.y), z3 = bfhi(zv.y); \
          const float o0 = od[0] * gnj[0] * (z0 * sigmoidf_(z0)), o1 = od[1] * gnj[1] * (z1 * sigmoidf_(z1)); \
          const float o2 = od[2] * gnj[2] * (z2 * sigmoidf_(z2)), o3 = od[3] * gnj[3] * (z3 * sigmoidf_(z3)); \
          u32x2 w; w.x = cvt_pk_bf16(o0, o1); w.y = cvt_pk_bf16(o2, o3); \
          *(u32x2*)(OG + trow * 512 + h * 128 + dvg + 4 * fq) = w; } } while (0)
#define SCAN_WAIT(nn) do { if (((nn) & 7) == 0) { const unsigned* fp_ = flags + bh * NCH + (nn) + (lane & 7); \
        while (!__all(__hip_atomic_load(fp_, __ATOMIC_RELAXED, __HIP_MEMORY_SCOPE_AGENT) != 0u)) __builtin_amdgcn_s_sleep(2); \
        __builtin_amdgcn_fence(__ATOMIC_ACQUIRE, "agent"); asm volatile("s_waitcnt vmcnt(0)" ::: "memory"); } } while (0)
    const unsigned* flags = (const unsigned*)(ws + WS_CTL) + 1024;
    bf16x8 wfA[4], wfB[4], qfA[4], afA[2], qfB[4], afB[2], kfA[2], kfB[2]; u32x2 uvA, uvB, zvA, zvB; float alA, alB;
    SCAN_WAIT(0);
    SCAN_LOAD(0, wfA, uvA, alA, qfA, afA, kfA, zvA);
    for (int n = 0; n < NCH; n += 2) {
        SCAN_LOAD(n + 1, wfB, uvB, alB, qfB, afB, kfB, zvB);
        SCAN_STEP(n, wfA, uvA, alA, qfA, afA, kfA, zvA);
        const int n2 = (n + 2 < NCH) ? n + 2 : NCH - 1;
        SCAN_WAIT(n2); SCAN_LOAD(n2, wfA, uvA, alA, qfA, afA, kfA, zvA);
        SCAN_STEP(n + 1, wfB, uvB, alB, qfB, afB, kfB, zvB);
    }
#undef SCAN_LOAD
#undef SCAN_STEP
#undef SCAN_WAIT
    __syncthreads();
}
__device__ __forceinline__ void gdn_norm_pass(const Args& a, int bx, int G) {
    bf16_t* OG = (bf16_t*)(a.ws + WS_OG); const float* PART = (const float*)(a.ws + WS_SSQ);
    for (size_t g = (size_t)bx * 512 + threadIdx.x; g < (size_t)TOK * 4 * 16; g += (size_t)G * 512) {
        const size_t pair = g >> 4; const int seg = (int)(g & 15);
        const f32x4 p = *(const f32x4*)(PART + pair * 4);
        const float rstd = rsqrtf(((p[0] + p[1]) + (p[2] + p[3])) * (1.f / HD) + EPS);
        u32x4* ptr = (u32x4*)(OG + pair * 128 + seg * 8); const u32x4 v = *ptr; u32x4 w;
#pragma unroll
        for (int e = 0; e < 4; ++e) w[e] = cvt_pk_bf16(bflo(v[e]) * rstd, bfhi(v[e]) * rstd);
        *ptr = w;
    }
}

constexpr int KS_LD = 136, VT_LD = 72;
__device__ __forceinline__ void sb_unit(const Args& a, LAS unsigned char* lds, int uid) {
    const int tid = threadIdx.x, lane = tid & 63, wave = __builtin_amdgcn_readfirstlane(tid >> 6), fr = lane & 15, fq = lane >> 4;
    const int qb = uid & 63, bh = uid >> 6, h = bh & 3, b = bh >> 2;
    const bf16_t* SQ = (const bf16_t*)(a.ws + WS_SQKV); bf16_t* OS = (bf16_t*)(a.ws + WS_OS);
    LAS bf16_t* Ks = (LAS bf16_t*)lds;
    LAS bf16_t* Vt = (LAS bf16_t*)(lds + 64 * KS_LD * 2);
    LAS int* flags = (LAS int*)(lds + 64 * KS_LD * 2 + 128 * VT_LD * 2);
    const int q0 = qb * 128, tq = q0 + wave * 16 + fr;
    const size_t brow = (size_t)b * SEQ;
    bf16x8 qf[4];
    {
        u32x4 raw[4]; float s = 0.f;
#pragma unroll
        for (int ks = 0; ks < 4; ++ks) { raw[ks] = *(const u32x4*)(SQ + (brow + tq) * 1536 + h * 128 + ks * 32 + 8 * fq);
#pragma unroll
            for (int e = 0; e < 4; ++e) { const float lo = bflo(raw[ks][e]), hi = bfhi(raw[ks][e]); s += lo * lo + hi * hi; } }
        s += __shfl_xor(s, 16); s += __shfl_xor(s, 32);
        const float rs = rsqrtf(s * (1.f / HD) + EPS) * 0.08838834764831845f;
#pragma unroll
        for (int ks = 0; ks < 4; ++ks) { const float* gp = a.in[I_SBQG] + ks * 32 + 8 * fq; u32x4 w;
#pragma unroll
            for (int e = 0; e < 4; ++e) w[e] = cvt_pk_bf16(bflo(raw[ks][e]) * rs * gp[2 * e], bfhi(raw[ks][e]) * rs * gp[2 * e + 1]);
            qf[ks] = __builtin_bit_cast(bf16x8, w); }
    }
    f32x4 oacc[8];
#pragma unroll
    for (int j = 0; j < 8; ++j) oacc[j] = (f32x4){0.f, 0.f, 0.f, 0.f};
    float carry = 0.f;
    for (int kt = qb * 2 + 1; kt >= 0; --kt) {
#pragma unroll
        for (int j = 0; j < 2; ++j) { const int task = tid + 512 * j, r = task >> 4, seg = task & 15;
            const bf16_t* kp = SQ + (brow + kt * 64 + r) * 1536 + 512 + h * 128 + seg * 8;
            const u32x4 kr = *(const u32x4*)kp;
            float s = 0.f;
#pragma unroll
            for (int e = 0; e < 4; ++e) { const float lo = bflo(kr[e]), hi = bfhi(kr[e]); s += lo * lo + hi * hi; }
            s += __shfl_xor(s, 1); s += __shfl_xor(s, 2); s += __shfl_xor(s, 4); s += __shfl_xor(s, 8);
            const float rs = rsqrtf(s * (1.f / HD) + EPS); const float* gp = a.in[I_SBKG] + seg * 8; u32x4 w;
#pragma unroll
            for (int e = 0; e < 4; ++e) w[e] = cvt_pk_bf16(bflo(kr[e]) * rs * gp[2 * e], bfhi(kr[e]) * rs * gp[2 * e + 1]);
            *(LAS u32x4*)(Ks + r * KS_LD + seg * 8) = w; }
#pragma unroll
        for (int j = 0; j < 2; ++j) { const int task = tid + 512 * j, r = task & 63, seg = task >> 6;
            const u32x4 vr = *(const u32x4*)(SQ + (brow + kt * 64 + r) * 1536 + 1024 + h * 128 + seg * 8);
            const int xt = r >> 4, kfq = (r & 15) >> 2, ii = r & 3, slot = (xt >> 1) * 32 + kfq * 8 + (xt & 1) * 4 + ii;
#pragma unroll
            for (int e = 0; e < 4; ++e) { Vt[(seg * 8 + 2 * e) * VT_LD + slot] = (bf16_t)(vr[e] & 0xffffu); Vt[(seg * 8 + 2 * e + 1) * VT_LD + slot] = (bf16_t)(vr[e] >> 16); } }
        __syncthreads();
        f32x4 z[4];
#pragma unroll
        for (int xt = 0; xt < 4; ++xt) { f32x4 d = (f32x4){0.f, 0.f, 0.f, 0.f};
#pragma unroll
            for (int ks = 0; ks < 4; ++ks) { const bf16x8 xf = *(const LAS bf16x8*)(Ks + (xt * 16 + fr) * KS_LD + ks * 32 + 8 * fq); d = MFMA16(xf, qf[ks], d); }
            z[xt] = d; }
        float s4[4], lsg[4][4]; bool val[4][4];
#pragma unroll
        for (int xt = 0; xt < 4; ++xt) { s4[xt] = 0.f;
#pragma unroll
            for (int i = 0; i < 4; ++i) { const int key = kt * 64 + xt * 16 + 4 * fq + i; val[xt][i] = key < tq;
                const float sp = softplusf_(z[xt][i]); const float l = val[xt][i] ? -sp : 0.f; lsg[xt][i] = z[xt][i] - sp; z[xt][i] = l; s4[xt] += l; } }
        float R[4], Hh[4];
#pragma unroll
        for (int xt = 0; xt < 4; ++xt) { const float v1 = __shfl_xor(s4[xt], 16), v2 = __shfl_xor(s4[xt], 32), v3 = __shfl_xor(s4[xt], 48);
            R[xt] = s4[xt] + v1 + v2 + v3;
            Hh[xt] = (((fq ^ 1) > fq) ? v1 : 0.f) + (((fq ^ 2) > fq) ? v2 : 0.f) + (((fq ^ 3) > fq) ? v3 : 0.f); }
        float above = carry;
        u32x4 pw[2];
#pragma unroll
        for (int xt = 3; xt >= 0; --xt) { const float base = above + Hh[xt];
            const float b3 = base, b2 = b3 + z[xt][3], b1 = b2 + z[xt][2], b0 = b1 + z[xt][1];
            const float p0 = val[xt][0] ? __expf(lsg[xt][0] + b0) : 0.f, p1 = val[xt][1] ? __expf(lsg[xt][1] + b1) : 0.f;
            const float p2 = val[xt][2] ? __expf(lsg[xt][2] + b2) : 0.f, p3 = val[xt][3] ? __expf(lsg[xt][3] + b3) : 0.f;
            pw[xt >> 1][(xt & 1) * 2] = cvt_pk_bf16(p0, p1); pw[xt >> 1][(xt & 1) * 2 + 1] = cvt_pk_bf16(p2, p3);
            above += R[xt]; }
        carry = above;
#pragma unroll
        for (int ks = 0; ks < 2; ++ks) { const bf16x8 pf = __builtin_bit_cast(bf16x8, pw[ks]);
#pragma unroll
            for (int dt = 0; dt < 8; ++dt) { const bf16x8 xf = *(const LAS bf16x8*)(Vt + (dt * 16 + fr) * VT_LD + ks * 32 + 8 * fq); oacc[dt] = MFMA16(xf, pf, oacc[dt]); } }
        const bool done = __all(carry < -110.0f);
        if (lane == 0) flags[wave] = done ? 1 : 0;
        __syncthreads();
        int alld = 1;
#pragma unroll
        for (int w = 0; w < 8; ++w) alld &= flags[w];
        if (alld) break;
        __syncthreads();
    }
#pragma unroll
    for (int dt = 0; dt < 8; ++dt) { u32x2 w; w.x = cvt_pk_bf16_mfma(oacc[dt][0], oacc[dt][1]); w.y = cvt_pk_bf16_mfma(oacc[dt][2], oacc[dt][3]);
        *(u32x2*)(OS + (brow + tq) * 512 + h * 128 + dt * 16 + 4 * fq) = w; }
    __syncthreads();
}

constexpr int MK_LD = 136, MV_LD = 264;
__device__ __forceinline__ void mem_unit(const Args& a, LAS unsigned char* lds, int uid) {
    const int tid = threadIdx.x, lane = tid & 63, wave = __builtin_amdgcn_readfirstlane(tid >> 6), fr = lane & 15, fq = lane >> 4;
    const int qb = uid & 31, bh = uid >> 5, h = bh & 3, b = bh >> 2;
    bf16_t* MQ = (bf16_t*)(a.ws + WS_MQ); const bf16_t* KV = (const bf16_t*)(a.ws + WS_MEMKV);
    {
        const unsigned* cnt = (const unsigned*)(a.ws + WS_CTL) + 128;
        while (__hip_atomic_load(cnt, __ATOMIC_RELAXED, __HIP_MEMORY_SCOPE_AGENT) < 16u) __builtin_amdgcn_s_sleep(8);
        __builtin_amdgcn_fence(__ATOMIC_ACQUIRE, "agent"); asm volatile("s_waitcnt vmcnt(0)" ::: "memory");
    }
    LAS bf16_t* Km = (LAS bf16_t*)lds;
    LAS bf16_t* Vt = (LAS bf16_t*)(lds + 256 * MK_LD * 2);
#pragma unroll
    for (int j = 0; j < 8; ++j) { const int task = tid + 512 * j, r = task >> 4, seg = task & 15;
        const bf16_t* kp = KV + (size_t)(b * NMEM + r) * 1024 + h * 128 + seg * 8;
        const u32x4 kr = *(const u32x4*)kp; const u32x4 vr = *(const u32x4*)(kp + 512);
        float s = 0.f;
#pragma unroll
        for (int e = 0; e < 4; ++e) { const float lo = bflo(kr[e]), hi = bfhi(kr[e]); s += lo * lo + hi * hi; }
        s += __shfl_xor(s, 1); s += __shfl_xor(s, 2); s += __shfl_xor(s, 4); s += __shfl_xor(s, 8);
        const float rs = rsqrtf(s * (1.f / HD) + EPS); const float* gp = a.in[I_MKG] + seg * 8; u32x4 w;
#pragma unroll
        for (int e = 0; e < 4; ++e) w[e] = cvt_pk_bf16(bflo(kr[e]) * rs * gp[2 * e], bfhi(kr[e]) * rs * gp[2 * e + 1]);
        *(LAS u32x4*)(Km + r * MK_LD + seg * 8) = w;
        const int xt = r >> 4, kfq = (r & 15) >> 2, ii = r & 3, slot = (xt >> 1) * 32 + kfq * 8 + (xt & 1) * 4 + ii;
#pragma unroll
        for (int e = 0; e < 4; ++e) { Vt[(seg * 8 + 2 * e) * MV_LD + slot] = (bf16_t)(vr[e] & 0xffffu); Vt[(seg * 8 + 2 * e + 1) * MV_LD + slot] = (bf16_t)(vr[e] >> 16); } }
    __syncthreads();
    for (int pass = 0; pass < 2; ++pass) {
        const size_t trow = (size_t)b * SEQ + qb * 256 + pass * 128 + wave * 16 + fr;
        bf16x8 qf[4];
        {
            u32x4 raw[4]; float s = 0.f;
#pragma unroll
            for (int ks = 0; ks < 4; ++ks) { raw[ks] = *(const u32x4*)(MQ + trow * 512 + h * 128 + ks * 32 + 8 * fq);
#pragma unroll
                for (int e = 0; e < 4; ++e) { const float lo = bflo(raw[ks][e]), hi = bfhi(raw[ks][e]); s += lo * lo + hi * hi; } }
            s += __shfl_xor(s, 16); s += __shfl_xor(s, 32);
            const float rs = rsqrtf(s * (1.f / HD) + EPS) * 0.08838834764831845f;
#pragma unroll
            for (int ks = 0; ks < 4; ++ks) { const float* gp = a.in[I_MQG] + ks * 32 + 8 * fq; u32x4 w;
#pragma unroll
                for (int e = 0; e < 4; ++e) w[e] = cvt_pk_bf16(bflo(raw[ks][e]) * rs * gp[2 * e], bfhi(raw[ks][e]) * rs * gp[2 * e + 1]);
                qf[ks] = __builtin_bit_cast(bf16x8, w); }
        }
        f32x4 z[16]; float mx = -3.0e38f;
#pragma unroll
        for (int xt = 0; xt < 16; ++xt) { f32x4 d = (f32x4){0.f, 0.f, 0.f, 0.f};
#pragma unroll
            for (int ks = 0; ks < 4; ++ks) { const bf16x8 xf = *(const LAS bf16x8*)(Km + (xt * 16 + fr) * MK_LD + ks * 32 + 8 * fq); d = MFMA16(xf, qf[ks], d); }
            z[xt] = d; mx = fmaxf(mx, fmaxf(fmaxf(d[0], d[1]), fmaxf(d[2], d[3]))); }
        mx = fmaxf(mx, __shfl_xor(mx, 16)); mx = fmaxf(mx, __shfl_xor(mx, 32));
        float sum = 0.f;
#pragma unroll
        for (int xt = 0; xt < 16; ++xt) {
#pragma unroll
            for (int i = 0; i < 4; ++i) { const float p = __expf(z[xt][i] - mx); z[xt][i] = p; sum += p; } }
        sum += __shfl_xor(sum, 16); sum += __shfl_xor(sum, 32);
        const float inv = 1.0f / sum;
        f32x4 oacc[8];
#pragma unroll
        for (int j = 0; j < 8; ++j) oacc[j] = (f32x4){0.f, 0.f, 0.f, 0.f};
#pragma unroll
        for (int ks = 0; ks < 8; ++ks) { u32x4 pw; pw.x = cvt_pk_bf16(z[2 * ks][0], z[2 * ks][1]); pw.y = cvt_pk_bf16(z[2 * ks][2], z[2 * ks][3]); pw.z = cvt_pk_bf16(z[2 * ks + 1][0], z[2 * ks + 1][1]); pw.w = cvt_pk_bf16(z[2 * ks + 1][2], z[2 * ks + 1][3]);
            const bf16x8 pf = __builtin_bit_cast(bf16x8, pw);
#pragma unroll
            for (int dt = 0; dt < 8; ++dt) { const bf16x8 xf = *(const LAS bf16x8*)(Vt + (dt * 16 + fr) * MV_LD + ks * 32 + 8 * fq); oacc[dt] = MFMA16(xf, pf, oacc[dt]); } }
#pragma unroll
        for (int dt = 0; dt < 8; ++dt) { u32x2 w; w.x = cvt_pk_bf16(oacc[dt][0] * inv, oacc[dt][1] * inv); w.y = cvt_pk_bf16(oacc[dt][2] * inv, oacc[dt][3] * inv);
            *(u32x2*)(MQ + trow * 512 + h * 128 + dt * 16 + 4 * fq) = w; }
    }
    __syncthreads();
}

__device__ __forceinline__ void l2_flush(const float* x, int bx, int tid, float* sink) {
    const f32x4* p = (const f32x4*)x + (size_t)bx * 32768 + tid;
    f32x4 a = (f32x4){0.f, 0.f, 0.f, 0.f};
#pragma unroll 8
    for (int i = 0; i < 64; ++i) a += p[(size_t)i * 512];
    if (a[0] + a[1] + a[2] + a[3] == 1.2345e38f) *sink = a[0];
}

__global__ void __launch_bounds__(512) fwd_megakernel(Args args) {
    extern __shared__ __attribute__((aligned(16))) unsigned char lds_raw[];
    LAS unsigned char* lds = (LAS unsigned char*)lds_raw;
    cg::grid_group grid = cg::this_grid();
    const int G = gridDim.x, bx = blockIdx.x, tid = threadIdx.x;
    const int vcu = (G % 8 == 0) ? (bx % 8) * (G / 8) + bx / 8 : bx;
    unsigned char* ws = args.ws;
    unsigned* ctl = (unsigned*)(ws + WS_CTL);
    LAS int* qslot = (LAS int*)(lds + LDS_BYTES - 64);
    const int lo = args.ph_lo, hi = args.ph_hi;
#ifndef PH_MASK
#define PH_MASK 0x1ff
#endif
#ifdef TIME_MASK
    unsigned long long t_ph0 = 0;
#define PH_T0(k) do { if ((TIME_MASK >> (k)) & 1) t_ph0 = __builtin_amdgcn_s_memrealtime(); } while (0)
#define PH_T1(k) do { if ((TIME_MASK >> (k)) & 1) { const unsigned long long t1_ = __builtin_amdgcn_s_memrealtime(); const unsigned long long d_ = t1_ - t_ph0; while (__builtin_amdgcn_s_memrealtime() - t1_ < d_) __builtin_amdgcn_s_sleep(8); } } while (0)
#else
#define PH_T0(k) do { } while (0)
#define PH_T1(k) do { } while (0)
#endif
#define INR(k) (lo <= (k) && (k) < hi)
#define IN(k) (((PH_MASK >> (k)) & 1) && INR(k))
#define SEAM(k) do { if (INR(k) && INR((k) + 1)) { asm volatile("s_waitcnt vmcnt(0)" ::: "memory"); grid.sync(); \
        __builtin_amdgcn_fence(__ATOMIC_ACQUIRE, "agent"); asm volatile("s_waitcnt vmcnt(0)" ::: "memory"); } } while (0)

    PH_T0(0); if (IN(0)) phase0(args, lds, vcu, G);
    SEAM(0); PH_T1(0);
#ifdef TEST_GEMM
    if (IN(1)) {
        EpiP7 E{(const bf16_t*)(ws + WS_H), args.out};
        SchedGrid S{(const char*)(ws + WS_H), (const char*)(ws + WS_WO), TOK / 256, DM / 256, G, bx, (size_t)256 * 1024 * 2};
        pg8::gemm_phase<EpiP7, SchedGrid, true, true>(lds, 1024, S, E);
    }
#endif
#ifdef TEST_GEMM
    if (false) {
#else
    PH_T0(1); if (IN(1)) {
#endif
        EpiP1 E{(bf16_t*)args.out, (bf16_t*)(ws + WS_GZ), (bf16_t*)(ws + WS_SQKV), (bf16_t*)(ws + WS_MQ), (bf16_t*)(ws + WS_GATES), (bf16_t*)(ws + WS_MEMKV), 0};
        SchedGrid S{(const char*)(ws + WS_H), (const char*)(ws + WS_WIN), TOK / 256, 16, G, bx, (size_t)256 * 1024 * 2};
        pg8::gemm_phase<EpiP1, SchedGrid, true, true>(lds, 1024, S, E);
    }
    SEAM(1); PH_T1(1);
    PH_T0(3); if (IN(3)) {
#ifdef TIME_SCAN
        if (bx < NB * NH * 4) { const unsigned long long t0_ = __builtin_amdgcn_s_memrealtime(); gdn_scan_unit(args, lds, bx); const unsigned long long t1_ = __builtin_amdgcn_s_memrealtime(); while (__builtin_amdgcn_s_memrealtime() - t1_ < (t1_ - t0_)) __builtin_amdgcn_s_sleep(8); }
#else
        if (bx < NB * NH * 4) gdn_scan_unit(args, lds, bx);
        else { const int nprep = G - NB * NH * 4;
            int pend = -1;
            for (int u = bx - NB * NH * 4; u < NB * NH * NCH; u += nprep) { const int cid = (u & 15) * NCH + (u >> 4);
                gdn_prep_unit(args, lds, cid);
                const bool flush = (pend >= 0) || (u + nprep >= NB * NH * NCH) || (u < 2 * nprep);
                if (flush) { if (tid == 0) { __builtin_amdgcn_fence(__ATOMIC_RELEASE, "agent"); asm volatile("s_waitcnt vmcnt(0)" ::: "memory");
                        if (pend >= 0) __hip_atomic_store(ctl + 1024 + pend, 1u, __ATOMIC_RELAXED, __HIP_MEMORY_SCOPE_AGENT);
                        __hip_atomic_store(ctl + 1024 + cid, 1u, __ATOMIC_RELAXED, __HIP_MEMORY_SCOPE_AGENT); } pend = -1; }
                else pend = cid; }
            if (bx - NB * NH * 4 < 16) {
                EpiP1 E2{(bf16_t*)args.out, (bf16_t*)(ws + WS_GZ), (bf16_t*)(ws + WS_SQKV), (bf16_t*)(ws + WS_MQ), (bf16_t*)(ws + WS_GATES), (bf16_t*)(ws + WS_MEMKV), 1};
                SchedGrid S2{(const char*)(ws + WS_MEMN), (const char*)(ws + WS_WMKV), 4, 4, G, bx - NB * NH * 4, (size_t)256 * 1024 * 2};
                pg8::gemm_phase<EpiP1, SchedGrid, true, true>(lds, 1024, S2, E2);
                asm volatile("s_waitcnt vmcnt(0)" ::: "memory"); __syncthreads();
                if (tid == 0) { __builtin_amdgcn_fence(__ATOMIC_RELEASE, "agent"); asm volatile("s_waitcnt vmcnt(0)" ::: "memory");
                    __hip_atomic_fetch_add(ctl + 128, 1u, __ATOMIC_RELAXED, __HIP_MEMORY_SCOPE_AGENT); }
            }
        }
#endif
        for (;;) {
            if (tid == 0) *qslot = (int)atomicAdd(ctl + 64, 1u);
            __syncthreads();
            const int it = *qslot;
            __syncthreads();
            if (it >= 1024 + 512) break;
            if (it < 1024) sb_unit(args, lds, it); else mem_unit(args, lds, it - 1024);
        }
    }
    SEAM(3); PH_T1(3);
    PH_T0(4); if (IN(4)) {
        gdn_norm_pass(args, bx, G);
        EpiP1 E{(bf16_t*)args.out, (bf16_t*)(ws + WS_GZ), (bf16_t*)(ws + WS_SQKV), (bf16_t*)(ws + WS_MQ), (bf16_t*)(ws + WS_GATES), (bf16_t*)(ws + WS_MEMKV), 2};
        SchedGrid S{(const char*)(ws + WS_H), (const char*)(ws + WS_WIN) + (size_t)4096 * 1024 * 2, TOK / 256, 12, G, bx, (size_t)256 * 1024 * 2};
        pg8::gemm_phase<EpiP1, SchedGrid, true, true>(lds, 1024, S, E);
    }
    SEAM(4); PH_T1(4);
    PH_T0(5); if (IN(5)) {
        EpiP3 E{(const bf16_t*)(ws + WS_GATES), (float*)(ws + WS_MIXF + (size_t)bx * 262144), (bf16_t*)(ws + WS_MIX)};
        SchedBranch S{(const char*)(ws + WS_OG), (const char*)(ws + WS_OS), (const char*)(ws + WS_MQ), (const char*)(ws + WS_WBR), G, bx, (size_t)256 * 512 * 2};
        pg8::gemm_phase<EpiP3, SchedBranch, true, true>(lds, 512, S, E);
    }
    SEAM(5); PH_T1(5);
    PH_T0(6); if (IN(6)) {
        EpiP4 E{args.in[I_X], args.out, (bf16_t*)(ws + WS_X1B), (float*)(ws + WS_SSQ)};
        SchedGrid S{(const char*)(ws + WS_MIX), (const char*)(ws + WS_WO), TOK / 256, DM / 256, G, bx, (size_t)256 * 1024 * 2};
        pg8::gemm_phase<EpiP4, SchedGrid, true, true>(lds, 1024, S, E);
    }
    SEAM(6); PH_T1(6);
    PH_T0(7); if (IN(7)) {
        EpiP6 E{(const float*)(ws + WS_SSQ), (bf16_t*)(ws + WS_ACT)};
        SchedGrid S{(const char*)(ws + WS_X1B), (const char*)(ws + WS_WUP), TOK / 256, DFF / 256, G, bx, (size_t)256 * 1024 * 2};
        pg8::gemm_phase<EpiP6, SchedGrid, true, true>(lds, 1024, S, E);
    }
    SEAM(7); PH_T1(7);
    PH_T0(8); if (IN(8)) {
#ifdef P7_VIA_WS
        EpiP7 E{(const bf16_t*)(ws + WS_X1B), (float*)(ws + 46 * MiB)};
#else
        EpiP7 E{(const bf16_t*)(ws + WS_X1B), args.out};
#endif
#ifdef TEST_P7
        E.x1b = (const bf16_t*)(ws + TEST_A);
        SchedGrid S{(const char*)(ws + TEST_A), (const char*)(ws + WS_WO), TOK / 256, DM / 256, G, bx, (size_t)256 * 1024 * 2};
        pg8::gemm_phase<EpiP7, SchedGrid, true, true>(lds, 1024, S, E);
#else
        SchedGrid S{(const char*)(ws + WS_ACT), (const char*)(ws + WS_WDN), TOK / 256, DM / 256, G, bx, (size_t)256 * 4096 * 2};
        pg8::gemm_phase<EpiP7, SchedGrid, true, true>(lds, 4096, S, E);
#endif
    }
#ifdef P7_VIA_WS
    { asm volatile("s_waitcnt vmcnt(0)" ::: "memory"); grid.sync(); __builtin_amdgcn_fence(__ATOMIC_ACQUIRE, "agent"); asm volatile("s_waitcnt vmcnt(0)" ::: "memory");
      const f32x4* src = (const f32x4*)(ws + 46 * MiB); f32x4* dst = (f32x4*)args.out;
      for (size_t i = (size_t)bx * 512 + tid; i < (size_t)TOK * DM / 4; i += (size_t)G * 512) dst[i] = src[i]; }
#endif
    asm volatile("s_waitcnt vmcnt(0)" ::: "memory"); __syncthreads();
    if (tid == 0) { __builtin_amdgcn_fence(__ATOMIC_RELEASE, "agent"); asm volatile("s_waitcnt vmcnt(0)" ::: "memory"); }
#ifdef DUMP_OFF
    if (lo == 0) { asm volatile("s_waitcnt vmcnt(0)" ::: "memory"); grid.sync(); __builtin_amdgcn_fence(__ATOMIC_ACQUIRE, "agent"); asm volatile("s_waitcnt vmcnt(0)" ::: "memory"); }
    if (lo == 100 || lo == 0) {
        const unsigned* src = (const unsigned*)(ws + (size_t)DUMP_OFF);
        { const int xcd = bx & 7, k = bx >> 3, pmt = xcd * 16 + (k >> 1), half = k & 1;
          const size_t base = ((size_t)pmt * 256 + (size_t)half * 128) * 512;
          for (int j = tid; j < 128 * 512; j += 512) { const size_t i = base + j; const unsigned u = src[i]; args.out[2 * i] = bflo(u); args.out[2 * i + 1] = bfhi(u); } }
    }
    asm volatile("s_waitcnt vmcnt(0)" ::: "memory"); __syncthreads();
    if (tid == 0) { __builtin_amdgcn_fence(__ATOMIC_RELEASE, "agent"); asm volatile("s_waitcnt vmcnt(0)" ::: "memory"); }
#endif
#undef IN
#undef SEAM
}

#ifndef MK_N_LAUNCHES
#define MK_N_LAUNCHES 1
#endif
extern "C" void kernel_launch(void* const* d_in, const int* in_sizes, int n_in, void* d_out, int out_size, void* d_ws, size_t ws_size, hipStream_t stream) {
    static int grid = 0;
    if (grid == 0) {
        if (n_in != 21 || out_size != TOK * DM || ws_size < WS_END) { fprintf(stderr, "kernel_launch: unexpected shapes (n_in %d, out %d, ws %zu)\n", n_in, out_size, ws_size); grid = -1; return; }
        int dev = 0, cus = 0, per_cu = 0;
        hipGetDevice(&dev); hipDeviceGetAttribute(&cus, hipDeviceAttributeMultiprocessorCount, dev);
        hipFuncSetAttribute((const void*)fwd_megakernel, hipFuncAttributeMaxDynamicSharedMemorySize, LDS_BYTES);
        hipOccupancyMaxActiveBlocksPerMultiprocessor(&per_cu, (const void*)fwd_megakernel, 512, LDS_BYTES);
        (void)hipGetLastError();
        if (per_cu < 1) { fprintf(stderr, "kernel_launch: occupancy query says %d workgroups per CU\n", per_cu); per_cu = 1; }
        grid = cus;
    }
    if (grid < 0) return;
    hipMemsetAsync((char*)d_ws + WS_CTL, 0, 16384, stream);
    Args a{};
    for (int i = 0; i < 21; ++i) a.in[i] = (const float*)d_in[i];
    a.out = (float*)d_out; a.ws = (unsigned char*)d_ws;
#if MK_N_LAUNCHES == 1
#ifdef DUMP_OFF
    a.ph_lo = 0; a.ph_hi = DUMP_AFTER + 1;
#elif defined(TEST_GEMM)
    a.ph_lo = 0; a.ph_hi = 2;
#else
    a.ph_lo = 0; a.ph_hi = 9;
#endif
    void* kargs[] = {&a};
    hipError_t e = hipLaunchCooperativeKernel((const void*)fwd_megakernel, dim3(grid), dim3(512), kargs, LDS_BYTES, stream);
    if (e != hipSuccess) fprintf(stderr, "cooperative launch failed: %s (grid %d)\n", hipGetErrorString(e), grid);
#else
#ifdef DUMP_OFF
    for (int p = 0; p <= DUMP_AFTER; ++p) { a.ph_lo = p; a.ph_hi = p + 1; hipLaunchKernelGGL(fwd_megakernel, dim3(grid), dim3(512), LDS_BYTES, stream, a); }
    a.ph_lo = 100; a.ph_hi = 101; hipLaunchKernelGGL(fwd_megakernel, dim3(grid), dim3(512), LDS_BYTES, stream, a);
#else
    for (int p = 0; p < 9; ++p) { a.ph_lo = p; a.ph_hi = p + 1; hipLaunchKernelGGL(fwd_megakernel, dim3(grid), dim3(512), LDS_BYTES, stream, a); }
#endif
#endif
}
```

```cpp
#include <hip/hip_runtime.h>
#include <hip/hip_cooperative_groups.h>
#include <cstdio>
#include <cstdint>
namespace cg = cooperative_groups;

#define LAS __attribute__((address_space(3)))
typedef unsigned short bf16_t;
typedef short bf16x8 __attribute__((ext_vector_type(8)));
typedef float f32x4 __attribute__((ext_vector_type(4)));
typedef float f32x2 __attribute__((ext_vector_type(2)));
typedef unsigned u32x4 __attribute__((ext_vector_type(4)));
typedef unsigned u32x2 __attribute__((ext_vector_type(2)));

constexpr int DM = 1024, NB = 4, SEQ = 8192, TOK = NB * SEQ;
constexpr int NH = 4, HD = 128, BW = 512;
constexpr int CHUNK = 64, NCH = SEQ / CHUNK;
constexpr int NMEM = 256, DFF = 4096, DIN = 7176, NPROJ = 7168;
constexpr float EPS = 1e-6f;

constexpr size_t MiB = 1u << 20;
constexpr size_t WS_CTL = 0;
constexpr size_t WS_WIN = 1 * MiB;
constexpr size_t WS_WMKV = 15 * MiB;
constexpr size_t WS_WBR = 17 * MiB;
constexpr size_t WS_WO = 20 * MiB;
constexpr size_t WS_WUP = 22 * MiB;
constexpr size_t WS_WDN = 30 * MiB;
constexpr size_t WS_MEMN = 38 * MiB;
constexpr size_t WS_MEMKV = 40 * MiB;
constexpr size_t WS_AB = 42 * MiB;
constexpr size_t WS_SSQ = 43 * MiB;
constexpr size_t WS_GL = 45 * MiB;
constexpr size_t WS_H = 46 * MiB;
constexpr size_t WS_GDNI = 110 * MiB;
constexpr size_t GI_W = 0, GI_QD = 32 * MiB, GI_KDT = 64 * MiB, GI_UT = 96 * MiB, GI_A = 128 * MiB;
constexpr size_t WS_GZ = 254 * MiB;
constexpr size_t WS_GQKV = 286 * MiB;
constexpr size_t WS_OG = 318 * MiB;
constexpr size_t WS_OS = 350 * MiB;
constexpr size_t WS_SQKV = 382 * MiB;
constexpr size_t WS_MQ = 478 * MiB;
constexpr size_t WS_GATES = 110 * MiB;
constexpr size_t WS_MIXF = 382 * MiB;
constexpr size_t WS_MIX = 46 * MiB;
constexpr size_t WS_X1B = 110 * MiB;
constexpr size_t WS_ACT = 174 * MiB;
constexpr size_t WS_END = 510 * MiB;

constexpr int LDS_BYTES = 147456;

typedef __bf16 bf16x2_t __attribute__((ext_vector_type(2)));
__device__ __forceinline__ unsigned cvt_pk_bf16_mfma(float lo, float hi) { f32x2 v = {lo, hi}; bf16x2_t b = __builtin_convertvector(v, bf16x2_t); return __builtin_bit_cast(unsigned, b); }
__device__ __forceinline__ unsigned cvt_pk_bf16(float lo, float hi) { unsigned r; asm volatile("v_cvt_pk_bf16_f32 %0, %1, %2" : "=v"(r) : "v"(lo), "v"(hi)); return r; }
__device__ __forceinline__ float bflo(unsigned u) { return __uint_as_float(u << 16); }
__device__ __forceinline__ float bfhi(unsigned u) { return __uint_as_float(u & 0xffff0000u); }
__device__ __forceinline__ float wave_sum(float v) {
#pragma unroll
    for (int o = 1; o < 64; o <<= 1) v += __shfl_xor(v, o);
    return v;
}
__device__ __forceinline__ float sigmoidf_(float x) { return 1.0f / (1.0f + __expf(-x)); }
__device__ __forceinline__ float softplusf_(float x) { return fmaxf(x, 0.f) + __logf(1.0f + __expf(-fabsf(x))); }
__device__ __forceinline__ u32x2 ld8_agent(const void* p) { const unsigned long long v = __hip_atomic_load((const unsigned long long*)p, __ATOMIC_RELAXED, __HIP_MEMORY_SCOPE_AGENT); u32x2 r; r.x = (unsigned)v; r.y = (unsigned)(v >> 32); return r; }
#define MFMA16(x, y, c) __builtin_amdgcn_mfma_f32_16x16x32_bf16((x), (y), (c), 0, 0, 0)
#define LDS_WAIT() asm volatile("s_waitcnt lgkmcnt(0)" ::: "memory")
#define LDS_BARRIER() do { asm volatile("s_waitcnt lgkmcnt(0)" ::: "memory"); __builtin_amdgcn_s_barrier(); asm volatile("" ::: "memory"); } while (0)

namespace pg8 {
constexpr int BM = 256, BK = 64, HALF = 128, HTB = HALF * BK * 2, STAGE_BYTES = 8 * HTB, NXCD = 8, WGM = 8;
__host__ __device__ __forceinline__ int lds_byte(int r, int c) { const int st = (r >> 4) * 2 + (c >> 5), rr = r & 15, cc = c & 31, ob = rr * 64 + cc * 2; return st * 1024 + (ob ^ (((ob >> 9) & 1) << 5)); }
__host__ __device__ __forceinline__ void stage_rc(int b, int& R, int& C) { const int st = b / 1024, sb = b % 1024, swz = sb ^ (((sb >> 9) & 1) << 5); R = (st >> 1) * 16 + swz / 64; C = (st & 1) * 32 + (swz % 64) / 2; }
__host__ __device__ __forceinline__ int perm32(int rho) { const int n = rho >> 4, i = rho & 15; return 8 * (i >> 2) + 4 * n + (i & 3); }

struct Unit { int pm, pn, kind; const char* A; const char* B; };

__device__ __forceinline__ bool tile_order(int nM, int nN, int G, int c, int i, int& pm, int& pn) {
    const int nwg = nM * nN; const long L = (long)i * G + c; if (L >= nwg) return false;
    int wgid = (int)L; { const int q = nwg / NXCD, r = nwg % NXCD, xcd = wgid % NXCD, off = wgid / NXCD; wgid = (xcd < r ? xcd * (q + 1) : r * (q + 1) + (xcd - r) * q) + off; }
    const int nig = WGM * nN, gid = wgid / nig, fm = gid * WGM, gsz = (nM - fm) < WGM ? (nM - fm) : WGM;
    pm = fm + ((wgid % nig) % gsz); pn = (wgid % nig) / gsz; return true;
}

template <class Epi, class Sched, bool ALIGN_EPI, bool SP2>
__device__ __forceinline__ void gemm_phase(LAS unsigned char* lds, const int K, const Sched& S, const Epi& E) {
    const int tid = threadIdx.x, wid = __builtin_amdgcn_readfirstlane(tid >> 6), lane = tid & 63, wr = wid >> 2, wc = wid & 3, fr = lane & 15, fq = lane >> 4;
    const int nt = K / BK;
    unsigned voffA[2], voffB[2];
#pragma unroll
    for (int i = 0; i < 2; ++i) { int R, C; stage_rc(tid * 16 + i * 8192, R, C); const int Rb = Epi::PERM ? ((R & ~31) + perm32(R & 31)) : R;
        voffA[i] = (unsigned)(R * K + C) * 2u; voffB[i] = (unsigned)(Rb * K + C) * 2u; }
    const size_t kstep = (size_t)(BK * 2);
    const size_t hstep = (size_t)HALF * K * 2;
    const unsigned ldsw = (unsigned)wid * 1024u;
    const int aoff = lds_byte(wr * 64 + fr, fq * 8), boff = lds_byte(wc * 32 + fr, fq * 8);
#define PG8_SA(b, h) (((b) * 2 + (h)) * HTB)
#define PG8_SB(b, h) ((4 + (b) * 2 + (h)) * HTB)
#define PG8_STAGE(bufoff, gbase, voff) do { _Pragma("unroll") for (int _i = 0; _i < 2; ++_i) \
        __builtin_amdgcn_global_load_lds((const unsigned*)((const char*)(gbase) + (voff)[_i]), (LAS unsigned*)(lds + (bufoff) + ldsw + _i * 8192), 16, 0, 0); } while (0)
#define PG8_LDA(dst, b, h) do { _Pragma("unroll") for (int m = 0; m < 4; ++m) _Pragma("unroll") for (int k = 0; k < 2; ++k) dst[m][k] = *(const LAS bf16x8*)(lds + PG8_SA(b, h) + aoff + m * 2048 + k * 1024); } while (0)
#define PG8_LDB(dst, b, h) do { _Pragma("unroll") for (int n = 0; n < 2; ++n) _Pragma("unroll") for (int k = 0; k < 2; ++k) dst[n][k] = *(const LAS bf16x8*)(lds + PG8_SB(b, h) + boff + n * 2048 + k * 1024); } while (0)
#define PG8_MMA(ai, bj, At, Bt) do { __builtin_amdgcn_s_setprio(1); _Pragma("unroll") for (int m = 0; m < 4; ++m) _Pragma("unroll") for (int n = 0; n < 2; ++n) _Pragma("unroll") for (int k = 0; k < 2; ++k) \
        acc[ai][bj][m][n] = __builtin_amdgcn_mfma_f32_16x16x32_bf16(Bt[n][k], At[m][k], acc[ai][bj][m][n], 0, 0, 0); __builtin_amdgcn_s_setprio(0); } while (0)
#define PG8_WAIT_V(n) asm volatile("s_waitcnt vmcnt(" #n ")" ::: "memory")
#define PG8_WAIT_L(n) asm volatile("s_waitcnt lgkmcnt(" #n ")" ::: "memory")
#define PG8_BAR __builtin_amdgcn_s_barrier()
#define PG8_SCHED __builtin_amdgcn_sched_barrier(0)
    Unit cur, nxt; int ui = 0;
    if (!S.next(0, cur)) return;
    f32x4 acc[2][2][4][2];
#pragma unroll
    for (int a = 0; a < 2; ++a)
#pragma unroll
        for (int b = 0; b < 2; ++b)
#pragma unroll
            for (int m = 0; m < 4; ++m)
#pragma unroll
                for (int n = 0; n < 2; ++n) acc[a][b][m][n] = (f32x4){0.f, 0.f, 0.f, 0.f};
    bf16x8 At[4][2], B0[2][2], B1[2][2];
    const char* cA = cur.A; const char* cB = cur.B;
    if constexpr (SP2) {
        PG8_STAGE(PG8_SB(0, 0), cB, voffB); PG8_STAGE(PG8_SB(0, 1), cB + hstep, voffB); PG8_STAGE(PG8_SA(0, 0), cA, voffA); PG8_STAGE(PG8_SA(0, 1), cA + hstep, voffA);
        if (wr == 1) PG8_BAR;
        PG8_WAIT_V(2); PG8_BAR;
        PG8_STAGE(PG8_SB(1, 0), cB + kstep, voffB); PG8_STAGE(PG8_SA(1, 0), cA + kstep, voffA); PG8_STAGE(PG8_SB(1, 1), cB + hstep + kstep, voffB);
        PG8_WAIT_V(6); PG8_BAR;
    } else {
        PG8_STAGE(PG8_SB(0, 0), cB, voffB); PG8_STAGE(PG8_SA(0, 0), cA, voffA); PG8_STAGE(PG8_SB(0, 1), cB + hstep, voffB); PG8_STAGE(PG8_SA(0, 1), cA + hstep, voffA);
        if (wr == 1) PG8_BAR;
        PG8_WAIT_V(4); PG8_BAR;
        PG8_STAGE(PG8_SB(1, 0), cB + kstep, voffB); PG8_STAGE(PG8_SA(1, 0), cA + kstep, voffA); PG8_STAGE(PG8_SB(1, 1), cB + hstep + kstep, voffB);
        PG8_WAIT_V(6); PG8_BAR;
    }
    for (;;) {
        const bool has_next = S.next(ui + 1, nxt);
        const char* nA = has_next ? nxt.A : cA; const char* nB = has_next ? nxt.B : cB;
        for (int t = 0; t < nt; t += 2) {
            const bool last = (t == nt - 2);
            const char* a1 = cA + (size_t)(t + 1) * kstep;
            const char* a2 = last ? nA : cA + (size_t)(t + 2) * kstep; const char* b2 = last ? nB : cB + (size_t)(t + 2) * kstep;
            const char* a3 = a2 + kstep; const char* b3 = b2 + kstep;
            if constexpr (SP2) {
            PG8_LDB(B0, 0, 0); PG8_LDB(B1, 0, 1); PG8_SCHED; PG8_LDA(At, 0, 0); PG8_STAGE(PG8_SA(1, 1), a1 + hstep, voffA);
            PG8_WAIT_V(8); PG8_WAIT_L(0); PG8_BAR; PG8_MMA(0, 0, At, B0); PG8_MMA(0, 1, At, B1); PG8_BAR; PG8_SCHED;
            PG8_LDA(At, 0, 1); PG8_STAGE(PG8_SB(0, 0), b2, voffB); PG8_STAGE(PG8_SB(0, 1), b2 + hstep, voffB); PG8_STAGE(PG8_SA(0, 0), a2, voffA);
            PG8_WAIT_V(8); PG8_WAIT_L(0); PG8_BAR; PG8_MMA(1, 0, At, B0); PG8_MMA(1, 1, At, B1); PG8_BAR; PG8_SCHED;
            PG8_LDB(B0, 1, 0); PG8_LDB(B1, 1, 1); PG8_SCHED; PG8_LDA(At, 1, 0); PG8_STAGE(PG8_SA(0, 1), a2 + hstep, voffA);
            PG8_WAIT_V(8); PG8_WAIT_L(0); PG8_BAR; PG8_MMA(0, 0, At, B0); PG8_MMA(0, 1, At, B1); PG8_BAR; PG8_SCHED;
            PG8_LDA(At, 1, 1); PG8_STAGE(PG8_SB(1, 0), b3, voffB); PG8_STAGE(PG8_SB(1, 1), b3 + hstep, voffB); PG8_STAGE(PG8_SA(1, 0), a3, voffA);
            PG8_WAIT_V(8); PG8_WAIT_L(0); PG8_BAR; PG8_MMA(1, 0, At, B0); PG8_MMA(1, 1, At, B1); PG8_BAR; PG8_SCHED;
            } else {
            PG8_LDB(B0, 0, 0); PG8_SCHED; PG8_LDA(At, 0, 0); PG8_STAGE(PG8_SA(1, 1), a1 + hstep, voffA);
            PG8_WAIT_L(8); PG8_BAR; PG8_WAIT_L(0); PG8_MMA(0, 0, At, B0); PG8_BAR; PG8_SCHED;
            PG8_LDB(B1, 0, 1); PG8_STAGE(PG8_SB(0, 0), b2, voffB);
            PG8_BAR; PG8_WAIT_L(0); PG8_MMA(0, 1, At, B1); PG8_BAR;
            PG8_LDA(At, 0, 1); PG8_STAGE(PG8_SA(0, 0), a2, voffA);
            PG8_BAR; PG8_WAIT_L(0); PG8_MMA(1, 0, At, B0); PG8_BAR; PG8_SCHED;
            PG8_STAGE(PG8_SB(0, 1), b2 + hstep, voffB);
            PG8_WAIT_V(6); PG8_BAR; PG8_MMA(1, 1, At, B1); PG8_BAR;
            PG8_LDB(B0, 1, 0); PG8_SCHED; PG8_LDA(At, 1, 0); PG8_STAGE(PG8_SA(0, 1), a2 + hstep, voffA);
            PG8_WAIT_L(8); PG8_BAR; PG8_WAIT_L(0); PG8_MMA(0, 0, At, B0); PG8_BAR; PG8_SCHED;
            PG8_LDB(B1, 1, 1); PG8_STAGE(PG8_SB(1, 0), b3, voffB);
            PG8_BAR; PG8_WAIT_L(0); PG8_MMA(0, 1, At, B1); PG8_BAR;
            PG8_LDA(At, 1, 1); PG8_STAGE(PG8_SA(1, 0), a3, voffA);
            PG8_BAR; PG8_WAIT_L(0); PG8_MMA(1, 0, At, B0); PG8_BAR; PG8_SCHED;
            PG8_STAGE(PG8_SB(1, 1), b3 + hstep, voffB);
            PG8_WAIT_V(6); PG8_BAR; PG8_MMA(1, 1, At, B1); PG8_BAR;
            }
        }
        if constexpr (ALIGN_EPI) { if (wr == 0) PG8_BAR; }
        E(acc, cur, wr, wc, fr, fq);
        if (!has_next) break;
#pragma unroll
        for (int a = 0; a < 2; ++a)
#pragma unroll
            for (int b = 0; b < 2; ++b)
#pragma unroll
                for (int m = 0; m < 4; ++m)
#pragma unroll
                    for (int n = 0; n < 2; ++n) acc[a][b][m][n] = (f32x4){0.f, 0.f, 0.f, 0.f};
        cur = nxt; cA = nA; cB = nB; ++ui;
        if constexpr (ALIGN_EPI) { if (wr == 1) PG8_BAR; }
    }
    PG8_WAIT_V(0);
    if constexpr (!ALIGN_EPI) { if (wr == 0) PG8_BAR; }
    PG8_BAR;
#undef PG8_SA
#undef PG8_SB
#undef PG8_STAGE
#undef PG8_LDA
#undef PG8_LDB
#undef PG8_MMA
#undef PG8_WAIT_V
#undef PG8_WAIT_L
#undef PG8_BAR
#undef PG8_SCHED
}
}

struct Args {
    const float* in[21];
    float* out; unsigned char* ws;
    int ph_lo, ph_hi;
};
enum { I_X = 0, I_MEM, I_N1G, I_WIN, I_CONVW, I_ALOG, I_DTB, I_GDNG, I_SBQG, I_SBKG, I_MEMNG, I_WMKV, I_MQG, I_MKG, I_WBRG, I_WBRS, I_WBRM, I_WO, I_N2G, I_WUP, I_WDN };

struct SchedGrid {
    const char* A; const char* B; int nM, nN, G, c; size_t tstep;
    __device__ __forceinline__ bool next(int i, pg8::Unit& u) const {
        if (!pg8::tile_order(nM, nN, G, c, i, u.pm, u.pn)) return false;
        u.kind = 0; u.A = A + (size_t)u.pm * tstep; u.B = B + (size_t)u.pn * tstep; return true;
    }
};
struct SchedBranch {
    const char* A0; const char* A1; const char* A2; const char* B; int G, c; size_t tstep;
    __device__ __forceinline__ bool next(int i, pg8::Unit& u) const {
        const int t = i / 3, br = i - 3 * t;
        if (!pg8::tile_order(TOK / 256, DM / 256, G, c, t, u.pm, u.pn)) return false;
        u.kind = br; u.A = (br == 0 ? A0 : (br == 1 ? A1 : A2)) + (size_t)u.pm * tstep; u.B = B + (size_t)br * ((size_t)DM * BW * 2) + (size_t)u.pn * tstep; return true;
    }
};

struct EpiP1 {
    static constexpr bool PERM = true;
    bf16_t* gqkv; bf16_t* gz; bf16_t* sqkv; bf16_t* mq; bf16_t* gates; bf16_t* memkv; int is_mem;
    __device__ __forceinline__ void operator()(const f32x4 (&acc)[2][2][4][2], const pg8::Unit& u, int wr, int wc, int fr, int fq) const {
        bf16_t* base; int ldc, c0; bool sig = false; const int pn = u.pn;
        if (is_mem == 1) { base = memkv; ldc = 1024; c0 = pn * 256; }
        else if (is_mem == 2) { base = gates; ldc = 3072; c0 = pn * 256; sig = true; }
        else if (pn < 6) { base = gqkv; ldc = 1536; c0 = pn * 256; }
        else if (pn < 8) { base = gz; ldc = 512; c0 = (pn - 6) * 256; }
        else if (pn < 14) { base = sqkv; ldc = 1536; c0 = (pn - 8) * 256; }
        else { base = mq; ldc = 512; c0 = (pn - 14) * 256; }
        const int row0 = u.pm * 256 + wr * 64 + fr, col0 = c0 + wc * 32 + 8 * fq;
#pragma unroll
        for (int ai = 0; ai < 2; ++ai)
#pragma unroll
            for (int m = 0; m < 4; ++m) { bf16_t* rowp = base + (size_t)(row0 + ai * 128 + m * 16) * ldc + col0;
#pragma unroll
                for (int bj = 0; bj < 2; ++bj) { f32x4 v0 = acc[ai][bj][m][0], v1 = acc[ai][bj][m][1];
                    if (sig) {
#pragma unroll
                        for (int e = 0; e < 4; ++e) { v0[e] = sigmoidf_(v0[e]); v1[e] = sigmoidf_(v1[e]); } }
                    u32x4 w; w.x = cvt_pk_bf16_mfma(v0[0], v0[1]); w.y = cvt_pk_bf16_mfma(v0[2], v0[3]); w.z = cvt_pk_bf16_mfma(v1[0], v1[1]); w.w = cvt_pk_bf16_mfma(v1[2], v1[3]);
                    *(u32x4*)(rowp + bj * 128) = w; } }
    }
};
struct EpiP3 {
    static constexpr bool PERM = true;
    const bf16_t* gates; float* priv; bf16_t* mix;
    __device__ __forceinline__ void operator()(const f32x4 (&acc)[2][2][4][2], const pg8::Unit& u, int wr, int wc, int fr, int fq) const {
        const int br = u.kind; int opq; asm volatile("v_mov_b32 %0, 0" : "=v"(opq));
        const unsigned row0 = (unsigned)(u.pm * 256 + wr * 64 + fr + opq), col0 = (unsigned)(u.pn * 256 + wc * 32 + 8 * fq);
        const unsigned goff0 = row0 * 3072u + (unsigned)br * 1024u + col0, moff0 = row0 * 1024u + col0;
        u32x4* pv = (u32x4*)priv + threadIdx.x + opq;
        if (br > 0) asm volatile("s_waitcnt vmcnt(0)" ::: "memory");
#pragma unroll
        for (int ai = 0; ai < 2; ++ai)
#pragma unroll
            for (int m = 0; m < 4; ++m) {
#pragma unroll
                for (int bj = 0; bj < 2; ++bj) {
                    const u32x4 g = *(const u32x4*)(gates + (goff0 + (unsigned)((ai * 128 + m * 16) * 3072 + bj * 128)));
                    f32x4 v0 = acc[ai][bj][m][0], v1 = acc[ai][bj][m][1];
                    v0[0] *= bflo(g.x); v0[1] *= bfhi(g.x); v0[2] *= bflo(g.y); v0[3] *= bfhi(g.y);
                    v1[0] *= bflo(g.z); v1[1] *= bfhi(g.z); v1[2] *= bflo(g.w); v1[3] *= bfhi(g.w);
                    const int ri = (ai * 2 + bj) * 4 + m;
                    if (br > 0) { const u32x4 p = pv[ri * 512];
                        v0[0] += bflo(p.x); v0[1] += bfhi(p.x); v0[2] += bflo(p.y); v0[3] += bfhi(p.y);
                        v1[0] += bflo(p.z); v1[1] += bfhi(p.z); v1[2] += bflo(p.w); v1[3] += bfhi(p.w); }
                    u32x4 w; w.x = cvt_pk_bf16(v0[0], v0[1]); w.y = cvt_pk_bf16(v0[2], v0[3]); w.z = cvt_pk_bf16(v1[0], v1[1]); w.w = cvt_pk_bf16(v1[2], v1[3]);
                    if (br < 2) pv[ri * 512] = w;
                    else *(u32x4*)(mix + (moff0 + (unsigned)((ai * 128 + m * 16) * 1024 + bj * 128))) = w; }
                asm volatile("" ::: "memory"); }
    }
};
struct EpiP4 {
    static constexpr bool PERM = true;
    const float* x; float* out; bf16_t* x1b; float* ssq;
    __device__ __forceinline__ void operator()(const f32x4 (&acc)[2][2][4][2], const pg8::Unit& u, int wr, int wc, int fr, int fq) const {
        int opq; asm volatile("v_mov_b32 %0, 0" : "=v"(opq));
        const unsigned row0 = (unsigned)(u.pm * 256 + wr * 64 + fr + opq), col0 = (unsigned)(u.pn * 256 + wc * 32 + 8 * fq);
#pragma unroll
        for (int ai = 0; ai < 2; ++ai)
#pragma unroll
            for (int m = 0; m < 4; ++m) { const unsigned row = row0 + ai * 128 + m * 16; float s = 0.f;
#pragma unroll
                for (int bj = 0; bj < 2; ++bj) { const unsigned off = row * 1024u + col0 + bj * 128;
#ifdef P4_MINIMAL
                    const f32x4 o0 = acc[ai][bj][m][0], o1 = acc[ai][bj][m][1];
#else
                    const f32x4 o0 = *(const f32x4*)(x + off) + acc[ai][bj][m][0], o1 = *(const f32x4*)(x + off + 4) + acc[ai][bj][m][1];
#endif
                    s += (o0[0] * o0[0] + o0[1] * o0[1]) + (o0[2] * o0[2] + o0[3] * o0[3]) + (o1[0] * o1[0] + o1[1] * o1[1]) + (o1[2] * o1[2] + o1[3] * o1[3]);
                    u32x4 w; w.x = cvt_pk_bf16(o0[0], o0[1]); w.y = cvt_pk_bf16(o0[2], o0[3]); w.z = cvt_pk_bf16(o1[0], o1[1]); w.w = cvt_pk_bf16(o1[2], o1[3]);
                    *(u32x4*)(x1b + off) = w; }
#ifndef NO_SSQ
                s += __shfl_xor(s, 16); s += __shfl_xor(s, 32);
                if (fq == 0) ssq[(size_t)u.pn * (TOK * 4) + row * 4 + wc] = s;
#endif
                asm volatile("" ::: "memory"); }
    }
};
struct EpiP6 {
    static constexpr bool PERM = true;
    const float* ssq; bf16_t* act;
    __device__ __forceinline__ void operator()(const f32x4 (&acc)[2][2][4][2], const pg8::Unit& u, int wr, int wc, int fr, int fq) const {
        const int row0 = u.pm * 256 + wr * 64 + fr, col0 = u.pn * 256 + wc * 32 + 8 * fq;
#pragma unroll
        for (int ai = 0; ai < 2; ++ai)
#pragma unroll
            for (int m = 0; m < 4; ++m) { const size_t row = (size_t)(row0 + ai * 128 + m * 16);
                const f32x4 p = *(const f32x4*)(ssq + (size_t)fq * (TOK * 4) + row * 4); float s = (p[0] + p[1]) + (p[2] + p[3]);
                s += __shfl_xor(s, 16); s += __shfl_xor(s, 32);
                const float rstd = rsqrtf(s * (1.0f / DM) + EPS);
#pragma unroll
                for (int bj = 0; bj < 2; ++bj) { f32x4 v0 = acc[ai][bj][m][0] * rstd, v1 = acc[ai][bj][m][1] * rstd;
#pragma unroll
                    for (int e = 0; e < 4; ++e) { const float a = fmaxf(v0[e], 0.f), b = fmaxf(v1[e], 0.f); v0[e] = a * a; v1[e] = b * b; }
                    u32x4 w; w.x = cvt_pk_bf16(v0[0], v0[1]); w.y = cvt_pk_bf16(v0[2], v0[3]); w.z = cvt_pk_bf16(v1[0], v1[1]); w.w = cvt_pk_bf16(v1[2], v1[3]);
                    *(u32x4*)(act + row * 4096 + col0 + bj * 128) = w; } }
    }
};
struct EpiP7 {
    static constexpr bool PERM = false;
    const bf16_t* x1b; float* out;
    __device__ __forceinline__ void operator()(const f32x4 (&acc)[2][2][4][2], const pg8::Unit& u, int wr, int wc, int fr, int fq) const {
        int opq; asm volatile("v_mov_b32 %0, 0" : "=v"(opq));
        const unsigned row0 = (unsigned)(u.pm * 256 + wr * 64 + fr + opq), col0 = (unsigned)(u.pn * 256 + wc * 32 + 4 * fq);
#pragma unroll
        for (int ai = 0; ai < 2; ++ai)
#pragma unroll
            for (int m = 0; m < 4; ++m) { const unsigned row = row0 + ai * 128 + m * 16;
#pragma unroll
                for (int bj = 0; bj < 2; ++bj)
#pragma unroll
                    for (int n = 0; n < 2; ++n) { const unsigned off = row * 1024u + col0 + bj * 128 + n * 16;
                        const u32x2 xb = *(const u32x2*)(x1b + off);
                        f32x4 o = acc[ai][bj][m][n];
#ifndef P7_NOX
                        o[0] += bflo(xb.x); o[1] += bfhi(xb.x); o[2] += bflo(xb.y); o[3] += bfhi(xb.y);
#endif
                        *(f32x4*)(out + off) = o; }
                asm volatile("" ::: "memory"); }
    }
};

__device__ __forceinline__ void p0_transpose_item(const float* W, int K, int ldw, int N, bf16_t* WT, const float* kscale, int skip_at, LAS float* scr, int item, int lane) {
    const int nblk = N / 32, kb = item / nblk, nb = item % nblk, k0 = 64 * kb, n0 = 32 * nb;
    const int src0 = n0 + (n0 >= skip_at ? 8 : 0);
#pragma unroll 8
    for (int i = 0; i < 32; ++i) { const int kk = 2 * i + (lane >> 5); float v = W[(size_t)(k0 + kk) * ldw + src0 + (lane & 31)]; if (kscale) v *= kscale[k0 + kk]; scr[kk * 33 + (lane & 31)] = v; }
    LDS_WAIT(); asm volatile("" ::: "memory");
    const int c = lane & 7;
#pragma unroll
    for (int j = 0; j < 4; ++j) { const int n = (lane >> 3) + 8 * j; const LAS float* s = scr + (8 * c) * 33 + n;
        u32x4 o; o.x = cvt_pk_bf16(s[0 * 33], s[1 * 33]); o.y = cvt_pk_bf16(s[2 * 33], s[3 * 33]); o.z = cvt_pk_bf16(s[4 * 33], s[5 * 33]); o.w = cvt_pk_bf16(s[6 * 33], s[7 * 33]);
        *(u32x4*)(WT + (size_t)(n0 + n) * K + k0 + 8 * c) = o; }
    LDS_WAIT(); asm volatile("" ::: "memory");
}

__device__ __forceinline__ void phase0(const Args& a, LAS unsigned char* lds, int vcu, int G) {
    const int tid = threadIdx.x, lane = tid & 63, wave = __builtin_amdgcn_readfirstlane(tid >> 6);
    unsigned char* ws = a.ws;
    LAS float* wab = (LAS float*)(lds + 8 * 8448);
    for (int e = tid; e < 8192; e += 512) wab[e] = a.in[I_WIN][(size_t)(e >> 3) * DIN + 2048 + (e & 7)];
    LAS float* scr = (LAS float*)(lds + wave * 8448);
    const int gw = vcu * 8 + wave, NGW = G * 8;
    constexpr int I_IN = 16 * 224, I_MKV = 16 * 32, I_BR = 8 * 32, I_O = 16 * 32, I_UP = 16 * 128, I_DN = 64 * 32;
    constexpr int NITEMS = I_IN + I_MKV + 3 * I_BR + I_O + I_UP + I_DN;
    for (int it = gw; it < NITEMS; it += NGW) {
        int r = it;
        if (r < I_IN) { p0_transpose_item(a.in[I_WIN], 1024, DIN, NPROJ, (bf16_t*)(ws + WS_WIN), nullptr, 2048, scr, r, lane); continue; } r -= I_IN;
        if (r < I_MKV) { p0_transpose_item(a.in[I_WMKV], 1024, 1024, 1024, (bf16_t*)(ws + WS_WMKV), nullptr, 1 << 30, scr, r, lane); continue; } r -= I_MKV;
        if (r < I_BR) { p0_transpose_item(a.in[I_WBRG], 512, 1024, 1024, (bf16_t*)(ws + WS_WBR), nullptr, 1 << 30, scr, r, lane); continue; } r -= I_BR;
        if (r < I_BR) { p0_transpose_item(a.in[I_WBRS], 512, 1024, 1024, (bf16_t*)(ws + WS_WBR) + (size_t)DM * BW, nullptr, 1 << 30, scr, r, lane); continue; } r -= I_BR;
        if (r < I_BR) { p0_transpose_item(a.in[I_WBRM], 512, 1024, 1024, (bf16_t*)(ws + WS_WBR) + (size_t)2 * DM * BW, nullptr, 1 << 30, scr, r, lane); continue; } r -= I_BR;
        if (r < I_O) { p0_transpose_item(a.in[I_WO], 1024, 1024, 1024, (bf16_t*)(ws + WS_WO), nullptr, 1 << 30, scr, r, lane); continue; } r -= I_O;
        if (r < I_UP) { p0_transpose_item(a.in[I_WUP], 1024, 4096, 4096, (bf16_t*)(ws + WS_WUP), a.in[I_N2G], 1 << 30, scr, r, lane); continue; } r -= I_UP;
        p0_transpose_item(a.in[I_WDN], 4096, 1024, 1024, (bf16_t*)(ws + WS_WDN), nullptr, 1 << 30, scr, r, lane);
    }
    __syncthreads();
    const float* g1 = a.in[I_N1G]; bf16_t* H = (bf16_t*)(ws + WS_H); float* AB = (float*)(ws + WS_AB);
    f32x4 gv[4];
#pragma unroll
    for (int j = 0; j < 4; ++j) gv[j] = *(const f32x4*)(g1 + 256 * j + 4 * lane);
    for (int m = gw; m < TOK; m += NGW) {
        const f32x4* xr = (const f32x4*)(a.in[I_X] + (size_t)m * DM) + lane;
        f32x4 v[4]; float s = 0.f;
#pragma unroll
        for (int j = 0; j < 4; ++j) { v[j] = xr[64 * j]; s += (v[j].x * v[j].x + v[j].y * v[j].y) + (v[j].z * v[j].z + v[j].w * v[j].w); }
        const float rstd = rsqrtf(wave_sum(s) * (1.f / DM) + EPS);
        float p[8];
#pragma unroll
        for (int c = 0; c < 8; ++c) p[c] = 0.f;
        u32x2* o8 = (u32x2*)(H + (size_t)m * DM) + lane;
#pragma unroll
        for (int j = 0; j < 4; ++j) { v[j] = v[j] * rstd * gv[j];
            u32x2 w; w.x = cvt_pk_bf16(v[j].x, v[j].y); w.y = cvt_pk_bf16(v[j].z, v[j].w); o8[64 * j] = w;
#pragma unroll
            for (int e = 0; e < 4; ++e) { const LAS f32x4* wp = (const LAS f32x4*)(wab + (256 * j + 4 * lane + e) * 8); const f32x4 w0 = wp[0], w1 = wp[1]; const float hv = v[j][e];
                p[0] += hv * w0.x; p[1] += hv * w0.y; p[2] += hv * w0.z; p[3] += hv * w0.w; p[4] += hv * w1.x; p[5] += hv * w1.y; p[6] += hv * w1.z; p[7] += hv * w1.w; } }
#pragma unroll
        for (int c = 0; c < 8; ++c) p[c] = wave_sum(p[c]);
        if (lane == 0) { f32x4* ab = (f32x4*)(AB + (size_t)m * 8); ab[0] = (f32x4){p[0], p[1], p[2], p[3]}; ab[1] = (f32x4){p[4], p[5], p[6], p[7]}; }
    }
    const float* gm = a.in[I_MEMNG]; bf16_t* MN = (bf16_t*)(ws + WS_MEMN);
#pragma unroll
    for (int j = 0; j < 4; ++j) gv[j] = *(const f32x4*)(gm + 256 * j + 4 * lane);
    for (int m = gw; m < NB * NMEM; m += NGW) {
        const f32x4* xr = (const f32x4*)(a.in[I_MEM] + (size_t)m * DM) + lane;
        f32x4 v[4]; float s = 0.f;
#pragma unroll
        for (int j = 0; j < 4; ++j) { v[j] = xr[64 * j]; s += (v[j].x * v[j].x + v[j].y * v[j].y) + (v[j].z * v[j].z + v[j].w * v[j].w); }
        const float rstd = rsqrtf(wave_sum(s) * (1.f / DM) + EPS);
        u32x2* o8 = (u32x2*)(MN + (size_t)m * DM) + lane;
#pragma unroll
        for (int j = 0; j < 4; ++j) { v[j] = v[j] * rstd * gv[j]; u32x2 w; w.x = cvt_pk_bf16(v[j].x, v[j].y); w.y = cvt_pk_bf16(v[j].z, v[j].w); o8[64 * j] = w; }
    }
}

constexpr int PQ_LD = 136;
__device__ __forceinline__ void gdn_prep_unit(const Args& a, LAS unsigned char* lds, int cid) {
    const int tid = threadIdx.x, lane = tid & 63, wave = __builtin_amdgcn_readfirstlane(tid >> 6), fr = lane & 15, fq = lane >> 4;
    unsigned char* ws = a.ws;
    const int n = cid & (NCH - 1), bh = cid >> 7, h = bh & 3, b = bh >> 2;
    const size_t row0 = (size_t)b * SEQ + (size_t)n * CHUNK;
    LAS bf16_t* Qb = (LAS bf16_t*)lds;
    LAS bf16_t* Kb = (LAS bf16_t*)(lds + 17408);
    LAS float* Kf = (LAS float*)(lds + 34816);
    LAS float* Vf = (LAS float*)(lds + 34816 + 32768);
    LAS float* Lm = (LAS float*)(lds + 34816 + 65536);
    LAS float* gcs = (LAS float*)(lds + 34816 + 65536 + 16384);
    LAS float* bet = gcs + 64;
    LAS float* bge = gcs + 128;
    const bf16_t* GQ = (const bf16_t*)a.out;
    if (wave == 0) {
        const float* AB = (const float*)(ws + WS_AB) + (row0 + lane) * 8;
        const float al = AB[h], bl = AB[4 + h];
        float g = -__expf(a.in[I_ALOG][h]) * softplusf_(al + a.in[I_DTB][h]);
#pragma unroll
        for (int o = 1; o < 64; o <<= 1) { const float t = __shfl_up(g, o); if (lane >= o) g += t; }
        const float be = sigmoidf_(bl);
        gcs[lane] = g; bet[lane] = be; bge[lane] = be * __expf(g);
        { const float gle = __expf(__shfl(g, 63)); if (lane < 32) ((float*)(ws + WS_GL))[cid * 32 + lane] = gle; }
    }
    {
        const float* cw = a.in[I_CONVW];
        float wq[4][2], wk[4][2], wv[4][2];
#pragma unroll
        for (int j = 0; j < 4; ++j) { const float* p = cw + j * 1536 + h * 128 + 2 * lane; wq[j][0] = p[0]; wq[j][1] = p[1]; wk[j][0] = p[512]; wk[j][1] = p[513]; wv[j][0] = p[1024]; wv[j][1] = p[1025]; }
        unsigned rq[11], rk[11], rv[11];
#pragma unroll
        for (int i = 0; i < 11; ++i) { const int rr = wave * 8 + i - 3; const bool ok = (n > 0) || (rr >= 0);
            const bf16_t* p = GQ + (row0 + rr) * 1536 + h * 128 + 2 * lane;
            rq[i] = ok ? *(const unsigned*)p : 0u; rk[i] = ok ? *(const unsigned*)(p + 512) : 0u; rv[i] = ok ? *(const unsigned*)(p + 1024) : 0u; }
#pragma unroll
        for (int i = 0; i < 8; ++i) { const int r = wave * 8 + i;
            float q0 = 0.f, q1 = 0.f, k0 = 0.f, k1 = 0.f, v0 = 0.f, v1 = 0.f;
#pragma unroll
            for (int j = 0; j < 4; ++j) { q0 += wq[j][0] * bflo(rq[i + j]); q1 += wq[j][1] * bfhi(rq[i + j]); k0 += wk[j][0] * bflo(rk[i + j]); k1 += wk[j][1] * bfhi(rk[i + j]);
                v0 += wv[j][0] * bflo(rv[i + j]); v1 += wv[j][1] * bfhi(rv[i + j]); }
            q0 *= sigmoidf_(q0); q1 *= sigmoidf_(q1); k0 *= sigmoidf_(k0); k1 *= sigmoidf_(k1); v0 *= sigmoidf_(v0); v1 *= sigmoidf_(v1);
            const float qn = rsqrtf(wave_sum(q0 * q0 + q1 * q1) + EPS) * 0.08838834764831845f, kn = rsqrtf(wave_sum(k0 * k0 + k1 * k1) + EPS);
            q0 *= qn; q1 *= qn; k0 *= kn; k1 *= kn;
            *(LAS unsigned*)(Qb + r * PQ_LD + 2 * lane) = cvt_pk_bf16(q0, q1);
            *(LAS unsigned*)(Kb + r * PQ_LD + 2 * lane) = cvt_pk_bf16(k0, k1);
            *(LAS f32x2*)(Kf + r * 128 + 2 * lane) = (f32x2){k0, k1};
            *(LAS f32x2*)(Vf + r * 128 + 2 * lane) = (f32x2){v0, v1}; }
    }
    __syncthreads();
    {
        const int mat = wave >> 2, ct = wave & 3;
        const LAS bf16_t* Xb = mat ? Qb : Kb;
        bf16x8 xf[4];
#pragma unroll
        for (int ks = 0; ks < 4; ++ks) xf[ks] = *(const LAS bf16x8*)(Xb + (ct * 16 + fr) * PQ_LD + ks * 32 + 8 * fq);
        bf16_t* Ag = (bf16_t*)(ws + WS_GDNI + GI_A) + (size_t)cid * 4096;
#pragma unroll
        for (int st = 0; st < 4; ++st) {
            f32x4 d = (f32x4){0.f, 0.f, 0.f, 0.f};
#pragma unroll
            for (int ks = 0; ks < 4; ++ks) { const bf16x8 yf = *(const LAS bf16x8*)(Kb + (st * 16 + fr) * PQ_LD + ks * 32 + 8 * fq); d = MFMA16(xf[ks], yf, d); }
            const int s = st * 16 + fr; const float gs = gcs[s];
#pragma unroll
            for (int i = 0; i < 4; ++i) { const int c = ct * 16 + 4 * fq + i; const float dec = __expf(fminf(gcs[c] - gs, 0.f));
                if (mat == 0) Lm[c * 64 + s] = (c > s) ? bet[c] * d[i] * dec : 0.f;
                else Ag[c * 64 + s] = (bf16_t)(cvt_pk_bf16((c >= s) ? d[i] * dec : 0.f, 0.f) & 0xffffu); }
        }
    }
    __syncthreads();
    const size_t gbase = (size_t)cid * 8192;
    if (wave < 4) {
        const int col = (wave & 1) * 64 + lane; const bool isw = wave >= 2;
        const LAS float* src = isw ? Kf : Vf; const LAS float* scl = isw ? bge : bet;
        float xv[64]; int opq; asm volatile("v_mov_b32 %0, 0" : "=v"(opq));
        const LAS float* Lmv = Lm + opq;
#pragma unroll
        for (int i = 0; i < 64; ++i) xv[i] = 0.f;
#pragma unroll
        for (int i = 0; i < 64; ++i) {
            float r0 = src[i * 128 + col] * scl[i], r1 = 0.f, r2 = 0.f, r3 = 0.f;
#pragma unroll
            for (int j4 = 0; j4 < (i + 3) / 4; ++j4) { const f32x4 lv = *(const LAS f32x4*)(Lmv + i * 64 + 4 * j4);
                r0 -= lv.x * xv[4 * j4]; r1 -= lv.y * xv[4 * j4 + 1]; r2 -= lv.z * xv[4 * j4 + 2]; r3 -= lv.w * xv[4 * j4 + 3]; }
            xv[i] = (r0 + r1) + (r2 + r3);
        }
        if (!isw) {
            u32x4* up = (u32x4*)((bf16_t*)(ws + WS_GDNI + GI_UT) + gbase + (size_t)col * 64);
#pragma unroll
            for (int j = 0; j < 8; ++j) { u32x4 w; w.x = cvt_pk_bf16(xv[8 * j], xv[8 * j + 1]); w.y = cvt_pk_bf16(xv[8 * j + 2], xv[8 * j + 3]); w.z = cvt_pk_bf16(xv[8 * j + 4], xv[8 * j + 5]); w.w = cvt_pk_bf16(xv[8 * j + 6], xv[8 * j + 7]); up[j] = w; }
        } else {
            bf16_t* wp = (bf16_t*)(ws + WS_GDNI + GI_W) + gbase + col;
#pragma unroll
            for (int i = 0; i < 64; ++i) wp[i * 128] = (bf16_t)(cvt_pk_bf16(xv[i], 0.f) & 0xffffu);
        }
    } else {
        const int t = tid - 256; const float gl = gcs[63];
        bf16_t* qd = (bf16_t*)(ws + WS_GDNI + GI_QD) + gbase; bf16_t* kdt = (bf16_t*)(ws + WS_GDNI + GI_KDT) + gbase;
#pragma unroll
        for (int j = 0; j < 4; ++j) { const int task = t + 256 * j, c = task >> 4, seg = task & 15; const float e = __expf(gcs[c]);
            const u32x4 qv = *(const LAS u32x4*)(Qb + c * PQ_LD + seg * 8);
            u32x4 w; w.x = cvt_pk_bf16(bflo(qv.x) * e, bfhi(qv.x) * e); w.y = cvt_pk_bf16(bflo(qv.y) * e, bfhi(qv.y) * e); w.z = cvt_pk_bf16(bflo(qv.z) * e, bfhi(qv.z) * e); w.w = cvt_pk_bf16(bflo(qv.w) * e, bfhi(qv.w) * e);
            *(u32x4*)(qd + c * 128 + seg * 8) = w; }
#pragma unroll
        for (int j = 0; j < 4; ++j) { const int task = t + 256 * j, dk = task & 127, c8 = task >> 7; float v[8];
#pragma unroll
            for (int e = 0; e < 8; ++e) { const int c = c8 * 8 + e; v[e] = Kf[c * 128 + dk] * __expf(gl - gcs[c]); }
            u32x4 w; w.x = cvt_pk_bf16(v[0], v[1]); w.y = cvt_pk_bf16(v[2], v[3]); w.z = cvt_pk_bf16(v[4], v[5]); w.w = cvt_pk_bf16(v[6], v[7]);
            *(u32x4*)(kdt + dk * 64 + c8 * 8) = w; }
    }
    asm volatile("s_waitcnt vmcnt(0)" ::: "memory"); __syncthreads();
}

constexpr int ST_LD = 136, VN_LD = 72;
__device__ __forceinline__ void gdn_scan_unit(const Args& a, LAS unsigned char* lds, int unit) {
    const int tid = threadIdx.x, lane = tid & 63, wave = __builtin_amdgcn_readfirstlane(tid >> 6), fr = lane & 15, fq = lane >> 4;
    unsigned char* ws = a.ws;
    const int bh = unit >> 2, sl = unit & 3, h = bh & 3, b = bh >> 2;
    LAS bf16_t* St = (LAS bf16_t*)lds;
    LAS bf16_t* VNt = (LAS bf16_t*)(lds + 2 * 32 * ST_LD * 2);
    LAS float* red = (LAS float*)(lds + 2 * 32 * ST_LD * 2 + 32 * VN_LD * 2);
    for (int e = tid; e < 32 * ST_LD / 2; e += 512) ((LAS unsigned*)St)[e] = 0u;
    f32x4 sacc[2];
    sacc[0] = (f32x4){0.f, 0.f, 0.f, 0.f}; sacc[1] = sacc[0];
    const int ct = wave >> 1, tt = wave & 1;
    const int dvg = sl * 32 + tt * 16;
    const bf16_t* Wg = (const bf16_t*)(ws + WS_GDNI + GI_W); const bf16_t* QDg = (const bf16_t*)(ws + WS_GDNI + GI_QD);
    const bf16_t* KDTg = (const bf16_t*)(ws + WS_GDNI + GI_KDT); const bf16_t* UTg = (const bf16_t*)(ws + WS_GDNI + GI_UT); const bf16_t* Ag = (const bf16_t*)(ws + WS_GDNI + GI_A);
    const bf16_t* GZ = (const bf16_t*)(ws + WS_GZ); bf16_t* OG = (bf16_t*)(ws + WS_OG); float* PART = (float*)(ws + WS_SSQ);
    const f32x4 gnj = *(const f32x4*)(a.in[I_GDNG] + dvg + 4 * fq);
    const float ealog = __expf(a.in[I_ALOG][h]), dtb = a.in[I_DTB][h];
    __syncthreads();
#define SCAN_LOAD(nn, WF, UV, AL, QF, AF, KF, ZV) do { const int cid_ = bh * NCH + (nn); const size_t gb_ = (size_t)cid_ * 8192; \
        _Pragma("unroll") for (int ks = 0; ks < 4; ++ks) { WF[ks] = *(const bf16x8*)(Wg + gb_ + (ct * 16 + fr) * 128 + ks * 32 + 8 * fq); QF[ks] = *(const bf16x8*)(QDg + gb_ + (ct * 16 + fr) * 128 + ks * 32 + 8 * fq); } \
        _Pragma("unroll") for (int ks = 0; ks < 2; ++ks) { AF[ks] = *(const bf16x8*)(Ag + (size_t)cid_ * 4096 + (ct * 16 + fr) * 64 + ks * 32 + 8 * fq); KF[ks] = *(const bf16x8*)(KDTg + gb_ + (wave * 16 + fr) * 64 + ks * 32 + 8 * fq); } \
        UV = *(const u32x2*)(UTg + gb_ + (dvg + fr) * 64 + ct * 16 + 4 * fq); \
        ZV = *(const u32x2*)(GZ + ((size_t)b * SEQ + (size_t)(nn) * CHUNK + ct * 16 + fr) * 512 + h * 128 + dvg + 4 * fq); \
        AL = ((const float*)(ws + WS_AB))[((size_t)b * SEQ + (size_t)(nn) * CHUNK + lane) * 8 + h]; } while (0)
#define SCAN_STEP(n, WF, UV, AL, QF, AF, KF, zv) do { \
        const LAS bf16_t* Sc = St + ((n) & 1) * 32 * ST_LD; LAS bf16_t* Sn = St + (((n) + 1) & 1) * 32 * ST_LD; \
        const size_t trow = (size_t)b * SEQ + (size_t)(n) * CHUNK + ct * 16 + fr; \
        const float gl = __expf(wave_sum(-ealog * softplusf_(AL + dtb))); \
          \
        { bf16x8 yb[4]; \
          _Pragma("unroll") for (int ks = 0; ks < 4; ++ks) yb[ks] = *(const LAS bf16x8*)(Sc + (tt * 16 + fr) * ST_LD + ks * 32 + 8 * fq); \
          __builtin_amdgcn_sched_barrier(0); \
          f32x4 d = (f32x4){0.f, 0.f, 0.f, 0.f}; \
          _Pragma("unroll") for (int ks = 0; ks < 4; ++ks) d = MFMA16(WF[ks], yb[ks], d); \
          __builtin_amdgcn_sched_barrier(0); \
          const float v0 = bflo(UV.x) - d[0], v1 = bfhi(UV.x) - d[1], v2 = bflo(UV.y) - d[2], v3 = bfhi(UV.y) - d[3]; \
          u32x2 w; w.x = cvt_pk_bf16(v0, v1); w.y = cvt_pk_bf16(v2, v3); \
          *(LAS u32x2*)(VNt + (tt * 16 + fr) * VN_LD + ct * 16 + 4 * fq) = w; } \
        LDS_BARRIER(); \
          \
        f32x4 od; float ss; \
        { bf16x8 xb[4], vb[2], yb3[2][2]; \
          _Pragma("unroll") for (int ks = 0; ks < 4; ++ks) xb[ks] = *(const LAS bf16x8*)(Sc + (tt * 16 + fr) * ST_LD + ks * 32 + 8 * fq); \
          _Pragma("unroll") for (int ks = 0; ks < 2; ++ks) vb[ks] = *(const LAS bf16x8*)(VNt + (tt * 16 + fr) * VN_LD + ks * 32 + 8 * fq); \
          _Pragma("unroll") for (int t = 0; t < 2; ++t) _Pragma("unroll") for (int ks = 0; ks < 2; ++ks) yb3[t][ks] = *(const LAS bf16x8*)(VNt + (t * 16 + fr) * VN_LD + ks * 32 + 8 * fq); \
          f32x4 dd[2]; dd[0] = sacc[0] * gl; dd[1] = sacc[1] * gl; \
          __builtin_amdgcn_sched_barrier(0); \
          f32x4 d = (f32x4){0.f, 0.f, 0.f, 0.f}; \
            \
          _Pragma("unroll") for (int ks = 0; ks < 4; ++ks) { d = MFMA16(xb[ks], QF[ks], d); if (ks < 2) { dd[0] = MFMA16(KF[ks], yb3[0][ks], dd[0]); dd[1] = MFMA16(KF[ks], yb3[1][ks], dd[1]); } } \
          _Pragma("unroll") for (int ks = 0; ks < 2; ++ks) d = MFMA16(vb[ks], AF[ks], d); \
          __builtin_amdgcn_sched_barrier(0); \
          od = d; ss = (d[0] * d[0] + d[1] * d[1]) + (d[2] * d[2] + d[3] * d[3]); \
          _Pragma("unroll") for (int t = 0; t < 2; ++t) { sacc[t] = dd[t]; \
              u32x2 w; w.x = cvt_pk_bf16_mfma(dd[t][0], dd[t][1]); w.y = cvt_pk_bf16_mfma(dd[t][2], dd[t][3]); \
              *(LAS u32x2*)(Sn + (t * 16 + fr) * ST_LD + wave * 16 + 4 * fq) = w; } } \
        ss += __shfl_xor(ss, 16); ss += __shfl_xor(ss, 32); \
        if (fq == 0) red[(ct * 2 + tt) * 16 + fr] = ss; \
        LDS_BARRIER(); \
          \
        if (tt == 0 && fq == 0) PART[(trow * 4 + h) * 4 + sl] = red[(ct * 2) * 16 + fr] + red[(ct * 2 + 1) * 16 + fr]; \
        { const float z0 = bflo(zv.x), z1 = bfhi(zv.x), z2 = bflo(zv.y), z3 = bfhi(zv.y); \
          const float o0 = od[0] * gnj[0] * (z0 * sigmoidf_(z0)), o1 = od[1] * gnj[1] * (z1 * sigmoidf_(z1)); \
          const float o2 = od[2] * gnj[2] * (z2 * sigmoidf_(z2)), o3 = od[3] * gnj[3] * (z3 * sigmoidf_(z3)); \
          u32x2 w; w.x = cvt_pk_bf16(o0, o1); w.y = cvt_pk_bf16(o2, o3); \
          *(u32x2*)(OG + trow * 512 + h * 128 + dvg + 4 * fq) = w; } } while (0)
#define SCAN_WAIT(nn) do { if (((nn) & 7) == 0) { const unsigned* fp_ = flags + bh * NCH + (nn) + (lane & 7); \
        while (!__all(__hip_atomic_load(fp_, __ATOMIC_RELAXED, __HIP_MEMORY_SCOPE_AGENT) != 0u)) __builtin_amdgcn_s_sleep(2); \
        __builtin_amdgcn_fence(__ATOMIC_ACQUIRE, "agent"); asm volatile("s_waitcnt vmcnt(0)" ::: "memory"); } } while (0)
    const unsigned* flags = (const unsigned*)(ws + WS_CTL) + 1024;
    bf16x8 wfA[4], wfB[4], qfA[4], afA[2], qfB[4], afB[2], kfA[2], kfB[2]; u32x2 uvA, uvB, zvA, zvB; float alA, alB;
    SCAN_WAIT(0);
    SCAN_LOAD(0, wfA, uvA, alA, qfA, afA, kfA, zvA);
    for (int n = 0; n < NCH; n += 2) {
        SCAN_LOAD(n + 1, wfB, uvB, alB, qfB, afB, kfB, zvB);
        SCAN_STEP(n, wfA, uvA, alA, qfA, afA, kfA, zvA);
        const int n2 = (n + 2 < NCH) ? n + 2 : NCH - 1;
        SCAN_WAIT(n2); SCAN_LOAD(n2, wfA, uvA, alA, qfA, afA, kfA, zvA);
        SCAN_STEP(n + 1, wfB, uvB, alB, qfB, afB, kfB, zvB);
    }
#undef SCAN_LOAD
#undef SCAN_STEP
#undef SCAN_WAIT
    __syncthreads();
}
__device__ __forceinline__ void gdn_norm_pass(const Args& a, int bx, int G) {
    bf16_t* OG = (bf16_t*)(a.ws + WS_OG); const float* PART = (const float*)(a.ws + WS_SSQ);
    for (size_t g = (size_t)bx * 512 + threadIdx.x; g < (size_t)TOK * 4 * 16; g += (size_t)G * 512) {
        const size_t pair = g >> 4; const int seg = (int)(g & 15);
        const f32x4 p = *(const f32x4*)(PART + pair * 4);
        const float rstd = rsqrtf(((p[0] + p[1]) + (p[2] + p[3])) * (1.f / HD) + EPS);
        u32x4* ptr = (u32x4*)(OG + pair * 128 + seg * 8); const u32x4 v = *ptr; u32x4 w;
#pragma unroll
        for (int e = 0; e < 4; ++e) w[e] = cvt_pk_bf16(bflo(v[e]) * rstd, bfhi(v[e]) * rstd);
        *ptr = w;
    }
}

constexpr int KS_LD = 136, VT_LD = 72;
__device__ __forceinline__ void sb_unit(const Args& a, LAS unsigned char* lds, int uid) {
    const int tid = threadIdx.x, lane = tid & 63, wave = __builtin_amdgcn_readfirstlane(tid >> 6), fr = lane & 15, fq = lane >> 4;
    const int qb = uid & 63, bh = uid >> 6, h = bh & 3, b = bh >> 2;
    const bf16_t* SQ = (const bf16_t*)(a.ws + WS_SQKV); bf16_t* OS = (bf16_t*)(a.ws + WS_OS);
    LAS bf16_t* Ks = (LAS bf16_t*)lds;
    LAS bf16_t* Vt = (LAS bf16_t*)(lds + 64 * KS_LD * 2);
    LAS int* flags = (LAS int*)(lds + 64 * KS_LD * 2 + 128 * VT_LD * 2);
    const int q0 = qb * 128, tq = q0 + wave * 16 + fr;
    const size_t brow = (size_t)b * SEQ;
    bf16x8 qf[4];
    {
        u32x4 raw[4]; float s = 0.f;
#pragma unroll
        for (int ks = 0; ks < 4; ++ks) { raw[ks] = *(const u32x4*)(SQ + (brow + tq) * 1536 + h * 128 + ks * 32 + 8 * fq);
#pragma unroll
            for (int e = 0; e < 4; ++e) { const float lo = bflo(raw[ks][e]), hi = bfhi(raw[ks][e]); s += lo * lo + hi * hi; } }
        s += __shfl_xor(s, 16); s += __shfl_xor(s, 32);
        const float rs = rsqrtf(s * (1.f / HD) + EPS) * 0.08838834764831845f;
#pragma unroll
        for (int ks = 0; ks < 4; ++ks) { const float* gp = a.in[I_SBQG] + ks * 32 + 8 * fq; u32x4 w;
#pragma unroll
            for (int e = 0; e < 4; ++e) w[e] = cvt_pk_bf16(bflo(raw[ks][e]) * rs * gp[2 * e], bfhi(raw[ks][e]) * rs * gp[2 * e + 1]);
            qf[ks] = __builtin_bit_cast(bf16x8, w); }
    }
    f32x4 oacc[8];
#pragma unroll
    for (int j = 0; j < 8; ++j) oacc[j] = (f32x4){0.f, 0.f, 0.f, 0.f};
    float carry = 0.f;
    for (int kt = qb * 2 + 1; kt >= 0; --kt) {
#pragma unroll
        for (int j = 0; j < 2; ++j) { const int task = tid + 512 * j, r = task >> 4, seg = task & 15;
            const bf16_t* kp = SQ + (brow + kt * 64 + r) * 1536 + 512 + h * 128 + seg * 8;
            const u32x4 kr = *(const u32x4*)kp;
            float s = 0.f;
#pragma unroll
            for (int e = 0; e < 4; ++e) { const float lo = bflo(kr[e]), hi = bfhi(kr[e]); s += lo * lo + hi * hi; }
            s += __shfl_xor(s, 1); s += __shfl_xor(s, 2); s += __shfl_xor(s, 4); s += __shfl_xor(s, 8);
            const float rs = rsqrtf(s * (1.f / HD) + EPS); const float* gp = a.in[I_SBKG] + seg * 8; u32x4 w;
#pragma unroll
            for (int e = 0; e < 4; ++e) w[e] = cvt_pk_bf16(bflo(kr[e]) * rs * gp[2 * e], bfhi(kr[e]) * rs * gp[2 * e + 1]);
            *(LAS u32x4*)(Ks + r * KS_LD + seg * 8) = w; }
#pragma unroll
        for (int j = 0; j < 2; ++j) { const int task = tid + 512 * j, r = task & 63, seg = task >> 6;
            const u32x4 vr = *(const u32x4*)(SQ + (brow + kt * 64 + r) * 1536 + 1024 + h * 128 + seg * 8);
            const int xt = r >> 4, kfq = (r & 15) >> 2, ii = r & 3, slot = (xt >> 1) * 32 + kfq * 8 + (xt & 1) * 4 + ii;
#pragma unroll
            for (int e = 0; e < 4; ++e) { Vt[(seg * 8 + 2 * e) * VT_LD + slot] = (bf16_t)(vr[e] & 0xffffu); Vt[(seg * 8 + 2 * e + 1) * VT_LD + slot] = (bf16_t)(vr[e] >> 16); } }
        __syncthreads();
        f32x4 z[4];
#pragma unroll
        for (int xt = 0; xt < 4; ++xt) { f32x4 d = (f32x4){0.f, 0.f, 0.f, 0.f};
#pragma unroll
            for (int ks = 0; ks < 4; ++ks) { const bf16x8 xf = *(const LAS bf16x8*)(Ks + (xt * 16 + fr) * KS_LD + ks * 32 + 8 * fq); d = MFMA16(xf, qf[ks], d); }
            z[xt] = d; }
        float s4[4], lsg[4][4]; bool val[4][4];
#pragma unroll
        for (int xt = 0; xt < 4; ++xt) { s4[xt] = 0.f;
#pragma unroll
            for (int i = 0; i < 4; ++i) { const int key = kt * 64 + xt * 16 + 4 * fq + i; val[xt][i] = key < tq;
                const float sp = softplusf_(z[xt][i]); const float l = val[xt][i] ? -sp : 0.f; lsg[xt][i] = z[xt][i] - sp; z[xt][i] = l; s4[xt] += l; } }
        float R[4], Hh[4];
#pragma unroll
        for (int xt = 0; xt < 4; ++xt) { const float v1 = __shfl_xor(s4[xt], 16), v2 = __shfl_xor(s4[xt], 32), v3 = __shfl_xor(s4[xt], 48);
            R[xt] = s4[xt] + v1 + v2 + v3;
            Hh[xt] = (((fq ^ 1) > fq) ? v1 : 0.f) + (((fq ^ 2) > fq) ? v2 : 0.f) + (((fq ^ 3) > fq) ? v3 : 0.f); }
        float above = carry;
        u32x4 pw[2];
#pragma unroll
        for (int xt = 3; xt >= 0; --xt) { const float base = above + Hh[xt];
            const float b3 = base, b2 = b3 + z[xt][3], b1 = b2 + z[xt][2], b0 = b1 + z[xt][1];
            const float p0 = val[xt][0] ? __expf(lsg[xt][0] + b0) : 0.f, p1 = val[xt][1] ? __expf(lsg[xt][1] + b1) : 0.f;
            const float p2 = val[xt][2] ? __expf(lsg[xt][2] + b2) : 0.f, p3 = val[xt][3] ? __expf(lsg[xt][3] + b3) : 0.f;
            pw[xt >> 1][(xt & 1) * 2] = cvt_pk_bf16(p0, p1); pw[xt >> 1][(xt & 1) * 2 + 1] = cvt_pk_bf16(p2, p3);
            above += R[xt]; }
        carry = above;
#pragma unroll
        for (int ks = 0; ks < 2; ++ks) { const bf16x8 pf = __builtin_bit_cast(bf16x8, pw[ks]);
#pragma unroll
            for (int dt = 0; dt < 8; ++dt) { const bf16x8 xf = *(const LAS bf16x8*)(Vt + (dt * 16 + fr) * VT_LD + ks * 32 + 8 * fq); oacc[dt] = MFMA16(xf, pf, oacc[dt]); } }
        const bool done = __all(carry < -110.0f);
        if (lane == 0) flags[wave] = done ? 1 : 0;
        __syncthreads();
        int alld = 1;
#pragma unroll
        for (int w = 0; w < 8; ++w) alld &= flags[w];
        if (alld) break;
        __syncthreads();
    }
#pragma unroll
    for (int dt = 0; dt < 8; ++dt) { u32x2 w; w.x = cvt_pk_bf16_mfma(oacc[dt][0], oacc[dt][1]); w.y = cvt_pk_bf16_mfma(oacc[dt][2], oacc[dt][3]);
        *(u32x2*)(OS + (brow + tq) * 512 + h * 128 + dt * 16 + 4 * fq) = w; }
    __syncthreads();
}

constexpr int MK_LD = 136, MV_LD = 264;
__device__ __forceinline__ void mem_unit(const Args& a, LAS unsigned char* lds, int uid) {
    const int tid = threadIdx.x, lane = tid & 63, wave = __builtin_amdgcn_readfirstlane(tid >> 6), fr = lane & 15, fq = lane >> 4;
    const int qb = uid & 31, bh = uid >> 5, h = bh & 3, b = bh >> 2;
    bf16_t* MQ = (bf16_t*)(a.ws + WS_MQ); const bf16_t* KV = (const bf16_t*)(a.ws + WS_MEMKV);
    {
        const unsigned* cnt = (const unsigned*)(a.ws + WS_CTL) + 128;
        while (__hip_atomic_load(cnt, __ATOMIC_RELAXED, __HIP_MEMORY_SCOPE_AGENT) < 16u) __builtin_amdgcn_s_sleep(8);
        __builtin_amdgcn_fence(__ATOMIC_ACQUIRE, "agent"); asm volatile("s_waitcnt vmcnt(0)" ::: "memory");
    }
    LAS bf16_t* Km = (LAS bf16_t*)lds;
    LAS bf16_t* Vt = (LAS bf16_t*)(lds + 256 * MK_LD * 2);
#pragma unroll
    for (int j = 0; j < 8; ++j) { const int task = tid + 512 * j, r = task >> 4, seg = task & 15;
        const bf16_t* kp = KV + (size_t)(b * NMEM + r) * 1024 + h * 128 + seg * 8;
        const u32x4 kr = *(const u32x4*)kp; const u32x4 vr = *(const u32x4*)(kp + 512);
        float s = 0.f;
#pragma unroll
        for (int e = 0; e < 4; ++e) { const float lo = bflo(kr[e]), hi = bfhi(kr[e]); s += lo * lo + hi * hi; }
        s += __shfl_xor(s, 1); s += __shfl_xor(s, 2); s += __shfl_xor(s, 4); s += __shfl_xor(s, 8);
        const float rs = rsqrtf(s * (1.f / HD) + EPS); const float* gp = a.in[I_MKG] + seg * 8; u32x4 w;
#pragma unroll
        for (int e = 0; e < 4; ++e) w[e] = cvt_pk_bf16(bflo(kr[e]) * rs * gp[2 * e], bfhi(kr[e]) * rs * gp[2 * e + 1]);
        *(LAS u32x4*)(Km + r * MK_LD + seg * 8) = w;
        const int xt = r >> 4, kfq = (r & 15) >> 2, ii = r & 3, slot = (xt >> 1) * 32 + kfq * 8 + (xt & 1) * 4 + ii;
#pragma unroll
        for (int e = 0; e < 4; ++e) { Vt[(seg * 8 + 2 * e) * MV_LD + slot] = (bf16_t)(vr[e] & 0xffffu); Vt[(seg * 8 + 2 * e + 1) * MV_LD + slot] = (bf16_t)(vr[e] >> 16); } }
    __syncthreads();
    for (int pass = 0; pass < 2; ++pass) {
        const size_t trow = (size_t)b * SEQ + qb * 256 + pass * 128 + wave * 16 + fr;
        bf16x8 qf[4];
        {
            u32x4 raw[4]; float s = 0.f;
#pragma unroll
            for (int ks = 0; ks < 4; ++ks) { raw[ks] = *(const u32x4*)(MQ + trow * 512 + h * 128 + ks * 32 + 8 * fq);
#pragma unroll
                for (int e = 0; e < 4; ++e) { const float lo = bflo(raw[ks][e]), hi = bfhi(raw[ks][e]); s += lo * lo + hi * hi; } }
            s += __shfl_xor(s, 16); s += __shfl_xor(s, 32);
            const float rs = rsqrtf(s * (1.f / HD) + EPS) * 0.08838834764831845f;
#pragma unroll
            for (int ks = 0; ks < 4; ++ks) { const float* gp = a.in[I_MQG] + ks * 32 + 8 * fq; u32x4 w;
#pragma unroll
                for (int e = 0; e < 4; ++e) w[e] = cvt_pk_bf16(bflo(raw[ks][e]) * rs * gp[2 * e], bfhi(raw[ks][e]) * rs * gp[2 * e + 1]);
                qf[ks] = __builtin_bit_cast(bf16x8, w); }
        }
        f32x4 z[16]; float mx = -3.0e38f;
#pragma unroll
        for (int xt = 0; xt < 16; ++xt) { f32x4 d = (f32x4){0.f, 0.f, 0.f, 0.f};
#pragma unroll
            for (int ks = 0; ks < 4; ++ks) { const bf16x8 xf = *(const LAS bf16x8*)(Km + (xt * 16 + fr) * MK_LD + ks * 32 + 8 * fq); d = MFMA16(xf, qf[ks], d); }
            z[xt] = d; mx = fmaxf(mx, fmaxf(fmaxf(d[0], d[1]), fmaxf(d[2], d[3]))); }
        mx = fmaxf(mx, __shfl_xor(mx, 16)); mx = fmaxf(mx, __shfl_xor(mx, 32));
        float sum = 0.f;
#pragma unroll
        for (int xt = 0; xt < 16; ++xt) {
#pragma unroll
            for (int i = 0; i < 4; ++i) { const float p = __expf(z[xt][i] - mx); z[xt][i] = p; sum += p; } }
        sum += __shfl_xor(sum, 16); sum += __shfl_xor(sum, 32);
        const float inv = 1.0f / sum;
        f32x4 oacc[8];
#pragma unroll
        for (int j = 0; j < 8; ++j) oacc[j] = (f32x4){0.f, 0.f, 0.f, 0.f};
#pragma unroll
        for (int ks = 0; ks < 8; ++ks) { u32x4 pw; pw.x = cvt_pk_bf16(z[2 * ks][0], z[2 * ks][1]); pw.y = cvt_pk_bf16(z[2 * ks][2], z[2 * ks][3]); pw.z = cvt_pk_bf16(z[2 * ks + 1][0], z[2 * ks + 1][1]); pw.w = cvt_pk_bf16(z[2 * ks + 1][2], z[2 * ks + 1][3]);
            const bf16x8 pf = __builtin_bit_cast(bf16x8, pw);
#pragma unroll
            for (int dt = 0; dt < 8; ++dt) { const bf16x8 xf = *(const LAS bf16x8*)(Vt + (dt * 16 + fr) * MV_LD + ks * 32 + 8 * fq); oacc[dt] = MFMA16(xf, pf, oacc[dt]); } }
#pragma unroll
        for (int dt = 0; dt < 8; ++dt) { u32x2 w; w.x = cvt_pk_bf16(oacc[dt][0] * inv, oacc[dt][1] * inv); w.y = cvt_pk_bf16(oacc[dt][2] * inv, oacc[dt][3] * inv);
            *(u32x2*)(MQ + trow * 512 + h * 128 + dt * 16 + 4 * fq) = w; }
    }
    __syncthreads();
}

__device__ __forceinline__ void l2_flush(const float* x, int bx, int tid, float* sink) {
    const f32x4* p = (const f32x4*)x + (size_t)bx * 32768 + tid;
    f32x4 a = (f32x4){0.f, 0.f, 0.f, 0.f};
#pragma unroll 8
    for (int i = 0; i < 64; ++i) a += p[(size_t)i * 512];
    if (a[0] + a[1] + a[2] + a[3] == 1.2345e38f) *sink = a[0];
}

#define XB_TMO      128
#define XB_XCNT(j)  (256  + 64 * (j))
#define XB_XSUB(j)  (1280 + 64 * (j))
#define XB_XGEN(j)  (2304 + 64 * (j))
#define XB_TOP      3328
#define XB_TOPGEN   3392
#define XCD_BAR_WORDS 3456
#define XB_SPIN_CAP (1u << 22)
__device__ __forceinline__ unsigned xb_ld(unsigned* p)              { return __hip_atomic_load(p, __ATOMIC_RELAXED, __HIP_MEMORY_SCOPE_AGENT); }
__device__ __forceinline__ unsigned xb_add(unsigned* p, unsigned v) { return __hip_atomic_fetch_add(p, v, __ATOMIC_RELAXED, __HIP_MEMORY_SCOPE_AGENT); }
__device__ __forceinline__ unsigned xb_xcc_id() { return (unsigned)__builtin_amdgcn_s_getreg((3 << 11) | 20) & 0xFu; }
#define XB_SPIN(cond, bar) do { unsigned _sp = 0; while (cond) { __builtin_amdgcn_s_sleep(1); \
    if ((++_sp & 255u) == 0u) { if (xb_ld(&(bar)[XB_TMO])) break; if (_sp > XB_SPIN_CAP) { atomicAdd(&(bar)[XB_TMO], 1u); break; } } } } while (0)
struct XcdBarrier { unsigned* bar; unsigned x; volatile LAS unsigned* st; };
__device__ __forceinline__ XcdBarrier xcd_barrier_post(unsigned* bar, volatile LAS unsigned* st) {
    XcdBarrier b; b.bar = bar; b.x = xb_xcc_id(); b.st = st;
    if (threadIdx.x == 0) (void)xb_add(&bar[XB_XCNT(b.x)], 1u);
    return b;
}
__device__ __forceinline__ void xcd_barrier_complete(unsigned* bar, unsigned x, unsigned& nloc, unsigned& nx) {
    const unsigned G = gridDim.x * gridDim.y * gridDim.z;
    unsigned sum, cnt, mine, sp = 0u;
    for (;;) {
        sum = 0u; cnt = 0u; mine = 0u;
#pragma unroll
        for (unsigned j = 0; j < 16; ++j) { const unsigned c = xb_ld(&bar[XB_XCNT(j)]); sum += c; cnt += (c > 0u) ? 1u : 0u; mine = (j == x) ? c : mine; }
        if (sum == G) break;
        __builtin_amdgcn_s_sleep(1);
        if ((++sp & 255u) == 0u) { if (xb_ld(&bar[XB_TMO])) break; if (sp > XB_SPIN_CAP) { atomicAdd(&bar[XB_TMO], 1u); break; } }
    }
    nloc = mine > 0u ? mine : 1u; nx = cnt > 0u ? cnt : 1u;
}
__device__ __forceinline__ void xcd_barrier(const XcdBarrier& b) {
    asm volatile("s_waitcnt vmcnt(0)" ::: "memory");
    __syncthreads();
    if (threadIdx.x == 0) {
        unsigned* bar = b.bar;
        __builtin_amdgcn_s_waitcnt(0);
        unsigned nloc = b.st[0], nx = b.st[1];
        if (nloc == 0u) { xcd_barrier_complete(bar, b.x, nloc, nx); b.st[0] = nloc; b.st[1] = nx; }
        const unsigned old = xb_add(&bar[XB_XSUB(b.x)], 1u);
        const unsigned gen = old / nloc;
        if (old + 1u == (gen + 1u) * nloc) {
            __builtin_amdgcn_fence(__ATOMIC_RELEASE, "agent");
            asm volatile("s_waitcnt vmcnt(0)" ::: "memory");
            const unsigned og = xb_add(&bar[XB_TOP], 1u);
            const unsigned tg = og / nx;
            if (og + 1u == (tg + 1u) * nx) xb_add(&bar[XB_TOPGEN], 1u);
            else XB_SPIN(xb_ld(&bar[XB_TOPGEN]) == tg, bar);
            __builtin_amdgcn_fence(__ATOMIC_ACQUIRE, "agent");
            xb_add(&bar[XB_XGEN(b.x)], 1u);
            asm volatile("s_waitcnt vmcnt(0)" ::: "memory");
        } else {
            XB_SPIN(xb_ld(&bar[XB_XGEN(b.x)]) == gen, bar);
            __builtin_amdgcn_fence(__ATOMIC_ACQUIRE, "agent");
            asm volatile("s_waitcnt vmcnt(0)" ::: "memory");
        }
    }
    __syncthreads();
}

__global__ void __launch_bounds__(512) fwd_megakernel(Args args) {
    extern __shared__ __attribute__((aligned(16))) unsigned char lds_raw[];
    LAS unsigned char* lds = (LAS unsigned char*)lds_raw;
    cg::grid_group grid = cg::this_grid();
    const int G = gridDim.x, bx = blockIdx.x, tid = threadIdx.x;
    const int vcu = (G % 8 == 0) ? (bx % 8) * (G / 8) + bx / 8 : bx;
    unsigned char* ws = args.ws;
    unsigned* ctl = (unsigned*)(ws + WS_CTL);
    LAS int* qslot = (LAS int*)(lds + LDS_BYTES - 64);
    volatile LAS unsigned* xbst = (volatile LAS unsigned*)(lds + LDS_BYTES - 32);
    if (tid < 2) xbst[tid] = 0u;
    __syncthreads();
    const XcdBarrier xbar = xcd_barrier_post(ctl + 4096, xbst);
    const int lo = args.ph_lo, hi = args.ph_hi;
#ifndef PH_MASK
#define PH_MASK 0x1ff
#endif
#ifdef TIME_MASK
    unsigned long long t_ph0 = 0;
#define PH_T0(k) do { if ((TIME_MASK >> (k)) & 1) t_ph0 = __builtin_amdgcn_s_memrealtime(); } while (0)
#define PH_T1(k) do { if ((TIME_MASK >> (k)) & 1) { const unsigned long long t1_ = __builtin_amdgcn_s_memrealtime(); const unsigned long long d_ = t1_ - t_ph0; while (__builtin_amdgcn_s_memrealtime() - t1_ < d_) __builtin_amdgcn_s_sleep(8); } } while (0)
#else
#define PH_T0(k) do { } while (0)
#define PH_T1(k) do { } while (0)
#endif
#define INR(k) (lo <= (k) && (k) < hi)
#define IN(k) (((PH_MASK >> (k)) & 1) && INR(k))
#define SEAM(k) do { if (INR(k) && INR((k) + 1)) { if ((k) == 0) { asm volatile("s_waitcnt vmcnt(0)" ::: "memory"); grid.sync(); \
        __builtin_amdgcn_fence(__ATOMIC_ACQUIRE, "agent"); asm volatile("s_waitcnt vmcnt(0)" ::: "memory"); } else xcd_barrier(xbar); } } while (0)

    PH_T0(0); if (IN(0)) phase0(args, lds, vcu, G);
    SEAM(0); PH_T1(0);
#ifdef TEST_GEMM
    if (IN(1)) {
        EpiP7 E{(const bf16_t*)(ws + WS_H), args.out};
        SchedGrid S{(const char*)(ws + WS_H), (const char*)(ws + WS_WO), TOK / 256, DM / 256, G, bx, (size_t)256 * 1024 * 2};
        pg8::gemm_phase<EpiP7, SchedGrid, true, true>(lds, 1024, S, E);
    }
#endif
#ifdef TEST_GEMM
    if (false) {
#else
    PH_T0(1); if (IN(1)) {
#endif
        EpiP1 E{(bf16_t*)args.out, (bf16_t*)(ws + WS_GZ), (bf16_t*)(ws + WS_SQKV), (bf16_t*)(ws + WS_MQ), (bf16_t*)(ws + WS_GATES), (bf16_t*)(ws + WS_MEMKV), 0};
        SchedGrid S{(const char*)(ws + WS_H), (const char*)(ws + WS_WIN), TOK / 256, 16, G, bx, (size_t)256 * 1024 * 2};
        pg8::gemm_phase<EpiP1, SchedGrid, true, true>(lds, 1024, S, E);
    }
    SEAM(1); PH_T1(1);
    PH_T0(3); if (IN(3)) {
#ifdef TIME_SCAN
        if (bx < NB * NH * 4) { const unsigned long long t0_ = __builtin_amdgcn_s_memrealtime(); gdn_scan_unit(args, lds, bx); const unsigned long long t1_ = __builtin_amdgcn_s_memrealtime(); while (__builtin_amdgcn_s_memrealtime() - t1_ < (t1_ - t0_)) __builtin_amdgcn_s_sleep(8); }
#else
        if (bx < NB * NH * 4) gdn_scan_unit(args, lds, bx);
        else { const int nprep = G - NB * NH * 4;
            int pend = -1;
            for (int u = bx - NB * NH * 4; u < NB * NH * NCH; u += nprep) { const int cid = (u & 15) * NCH + (u >> 4);
                gdn_prep_unit(args, lds, cid);
                const bool flush = (pend >= 0) || (u + nprep >= NB * NH * NCH) || (u < 2 * nprep);
                if (flush) { if (tid == 0) { __builtin_amdgcn_fence(__ATOMIC_RELEASE, "agent"); asm volatile("s_waitcnt vmcnt(0)" ::: "memory");
                        if (pend >= 0) __hip_atomic_store(ctl + 1024 + pend, 1u, __ATOMIC_RELAXED, __HIP_MEMORY_SCOPE_AGENT);
                        __hip_atomic_store(ctl + 1024 + cid, 1u, __ATOMIC_RELAXED, __HIP_MEMORY_SCOPE_AGENT); } pend = -1; }
                else pend = cid; }
            if (bx - NB * NH * 4 < 16) {
                EpiP1 E2{(bf16_t*)args.out, (bf16_t*)(ws + WS_GZ), (bf16_t*)(ws + WS_SQKV), (bf16_t*)(ws + WS_MQ), (bf16_t*)(ws + WS_GATES), (bf16_t*)(ws + WS_MEMKV), 1};
                SchedGrid S2{(const char*)(ws + WS_MEMN), (const char*)(ws + WS_WMKV), 4, 4, G, bx - NB * NH * 4, (size_t)256 * 1024 * 2};
                pg8::gemm_phase<EpiP1, SchedGrid, true, true>(lds, 1024, S2, E2);
                asm volatile("s_waitcnt vmcnt(0)" ::: "memory"); __syncthreads();
                if (tid == 0) { __builtin_amdgcn_fence(__ATOMIC_RELEASE, "agent"); asm volatile("s_waitcnt vmcnt(0)" ::: "memory");
                    __hip_atomic_fetch_add(ctl + 128, 1u, __ATOMIC_RELAXED, __HIP_MEMORY_SCOPE_AGENT); }
            }
        }
#endif
        for (;;) {
            if (tid == 0) *qslot = (int)atomicAdd(ctl + 64, 1u);
            __syncthreads();
            const int it = *qslot;
            __syncthreads();
            if (it >= 1024 + 512) break;
            if (it < 1024) sb_unit(args, lds, it); else mem_unit(args, lds, it - 1024);
        }
    }
    SEAM(3); PH_T1(3);
    PH_T0(4); if (IN(4)) {
        gdn_norm_pass(args, bx, G);
        EpiP1 E{(bf16_t*)args.out, (bf16_t*)(ws + WS_GZ), (bf16_t*)(ws + WS_SQKV), (bf16_t*)(ws + WS_MQ), (bf16_t*)(ws + WS_GATES), (bf16_t*)(ws + WS_MEMKV), 2};
        SchedGrid S{(const char*)(ws + WS_H), (const char*)(ws + WS_WIN) + (size_t)4096 * 1024 * 2, TOK / 256, 12, G, bx, (size_t)256 * 1024 * 2};
        pg8::gemm_phase<EpiP1, SchedGrid, true, true>(lds, 1024, S, E);
    }
    SEAM(4); PH_T1(4);
    PH_T0(5); if (IN(5)) {
        EpiP3 E{(const bf16_t*)(ws + WS_GATES), (float*)(ws + WS_MIXF + (size_t)bx * 262144), (bf16_t*)(ws + WS_MIX)};
        SchedBranch S{(const char*)(ws + WS_OG), (const char*)(ws + WS_OS), (const char*)(ws + WS_MQ), (const char*)(ws + WS_WBR), G, bx, (size_t)256 * 512 * 2};
        pg8::gemm_phase<EpiP3, SchedBranch, true, true>(lds, 512, S, E);
    }
    SEAM(5); PH_T1(5);
    PH_T0(6); if (IN(6)) {
        EpiP4 E{args.in[I_X], args.out, (bf16_t*)(ws + WS_X1B), (float*)(ws + WS_SSQ)};
        SchedGrid S{(const char*)(ws + WS_MIX), (const char*)(ws + WS_WO), TOK / 256, DM / 256, G, bx, (size_t)256 * 1024 * 2};
        pg8::gemm_phase<EpiP4, SchedGrid, true, true>(lds, 1024, S, E);
    }
    SEAM(6); PH_T1(6);
    PH_T0(7); if (IN(7)) {
        EpiP6 E{(const float*)(ws + WS_SSQ), (bf16_t*)(ws + WS_ACT)};
        SchedGrid S{(const char*)(ws + WS_X1B), (const char*)(ws + WS_WUP), TOK / 256, DFF / 256, G, bx, (size_t)256 * 1024 * 2};
        pg8::gemm_phase<EpiP6, SchedGrid, true, true>(lds, 1024, S, E);
    }
    SEAM(7); PH_T1(7);
    PH_T0(8); if (IN(8)) {
#ifdef P7_VIA_WS
        EpiP7 E{(const bf16_t*)(ws + WS_X1B), (float*)(ws + 46 * MiB)};
#else
        EpiP7 E{(const bf16_t*)(ws + WS_X1B), args.out};
#endif
#ifdef TEST_P7
        E.x1b = (const bf16_t*)(ws + TEST_A);
        SchedGrid S{(const char*)(ws + TEST_A), (const char*)(ws + WS_WO), TOK / 256, DM / 256, G, bx, (size_t)256 * 1024 * 2};
        pg8::gemm_phase<EpiP7, SchedGrid, true, true>(lds, 1024, S, E);
#else
        SchedGrid S{(const char*)(ws + WS_ACT), (const char*)(ws + WS_WDN), TOK / 256, DM / 256, G, bx, (size_t)256 * 4096 * 2};
        pg8::gemm_phase<EpiP7, SchedGrid, true, true>(lds, 4096, S, E);
#endif
    }
#ifdef P7_VIA_WS
    { asm volatile("s_waitcnt vmcnt(0)" ::: "memory"); grid.sync(); __builtin_amdgcn_fence(__ATOMIC_ACQUIRE, "agent"); asm volatile("s_waitcnt vmcnt(0)" ::: "memory");
      const f32x4* src = (const f32x4*)(ws + 46 * MiB); f32x4* dst = (f32x4*)args.out;
      for (size_t i = (size_t)bx * 512 + tid; i < (size_t)TOK * DM / 4; i += (size_t)G * 512) dst[i] = src[i]; }
#endif
    asm volatile("s_waitcnt vmcnt(0)" ::: "memory"); __syncthreads();
    if (tid == 0) { __builtin_amdgcn_fence(__ATOMIC_RELEASE, "agent"); asm volatile("s_waitcnt vmcnt(0)" ::: "memory"); }
#ifdef DUMP_OFF
    if (lo == 0) { asm volatile("s_waitcnt vmcnt(0)" ::: "memory"); grid.sync(); __builtin_amdgcn_fence(__ATOMIC_ACQUIRE, "agent"); asm volatile("s_waitcnt vmcnt(0)" ::: "memory"); }
    if (lo == 100 || lo == 0) {
        const unsigned* src = (const unsigned*)(ws + (size_t)DUMP_OFF);
        { const int xcd = bx & 7, k = bx >> 3, pmt = xcd * 16 + (k >> 1), half = k & 1;
          const size_t base = ((size_t)pmt * 256 + (size_t)half * 128) * 512;
          for (int j = tid; j < 128 * 512; j += 512) { const size_t i = base + j; const unsigned u = src[i]; args.out[2 * i] = bflo(u); args.out[2 * i + 1] = bfhi(u); } }
    }
    asm volatile("s_waitcnt vmcnt(0)" ::: "memory"); __syncthreads();
    if (tid == 0) { __builtin_amdgcn_fence(__ATOMIC_RELEASE, "agent"); asm volatile("s_waitcnt vmcnt(0)" ::: "memory"); }
#endif
#undef IN
#undef SEAM
}

#ifndef MK_N_LAUNCHES
#define MK_N_LAUNCHES 1
#endif
extern "C" void kernel_launch(void* const* d_in, const int* in_sizes, int n_in, void* d_out, int out_size, void* d_ws, size_t ws_size, hipStream_t stream) {
    static int grid = 0;
    if (grid == 0) {
        if (n_in != 21 || out_size != TOK * DM || ws_size < WS_END) { fprintf(stderr, "kernel_launch: unexpected shapes (n_in %d, out %d, ws %zu)\n", n_in, out_size, ws_size); grid = -1; return; }
        int dev = 0, cus = 0, per_cu = 0;
        hipGetDevice(&dev); hipDeviceGetAttribute(&cus, hipDeviceAttributeMultiprocessorCount, dev);
        hipFuncSetAttribute((const void*)fwd_megakernel, hipFuncAttributeMaxDynamicSharedMemorySize, LDS_BYTES);
        hipOccupancyMaxActiveBlocksPerMultiprocessor(&per_cu, (const void*)fwd_megakernel, 512, LDS_BYTES);
        (void)hipGetLastError();
        if (per_cu < 1) { fprintf(stderr, "kernel_launch: occupancy query says %d workgroups per CU\n", per_cu); per_cu = 1; }
        grid = cus;
    }
    if (grid < 0) return;
    hipMemsetAsync((char*)d_ws + WS_CTL, 0, 32768, stream);
    Args a{};
    for (int i = 0; i < 21; ++i) a.in[i] = (const float*)d_in[i];
    a.out = (float*)d_out; a.ws = (unsigned char*)d_ws;
#if MK_N_LAUNCHES == 1
#ifdef DUMP_OFF
    a.ph_lo = 0; a.ph_hi = DUMP_AFTER + 1;
#elif defined(TEST_GEMM)
    a.ph_lo = 0; a.ph_hi = 2;
#else
    a.ph_lo = 0; a.ph_hi = 9;
#endif
    void* kargs[] = {&a};
    hipError_t e = hipLaunchCooperativeKernel((const void*)fwd_megakernel, dim3(grid), dim3(512), kargs, LDS_BYTES, stream);
    if (e != hipSuccess) fprintf(stderr, "cooperative launch failed: %s (grid %d)\n", hipGetErrorString(e), grid);
#else
#ifdef DUMP_OFF
    for (int p = 0; p <= DUMP_AFTER; ++p) { a.ph_lo = p; a.ph_hi = p + 1; hipLaunchKernelGGL(fwd_megakernel, dim3(grid), dim3(512), LDS_BYTES, stream, a); }
    a.ph_lo = 100; a.ph_hi = 101; hipLaunchKernelGGL(fwd_megakernel, dim3(grid), dim3(512), LDS_BYTES, stream, a);
#else
    for (int p = 0; p < 9; ++p) { a.ph_lo = p; a.ph_hi = p + 1; hipLaunchKernelGGL(fwd_megakernel, dim3(grid), dim3(512), LDS_BYTES, stream, a); }
#endif
#endif
}
```

```cpp
#include <hip/hip_runtime.h>
#include <hip/hip_cooperative_groups.h>
#include <cstdio>
#include <cstdint>
namespace cg = cooperative_groups;

#define LAS __attribute__((address_space(3)))
typedef unsigned short bf16_t;
typedef short bf16x8 __attribute__((ext_vector_type(8)));
typedef float f32x4 __attribute__((ext_vector_type(4)));
typedef float f32x2 __attribute__((ext_vector_type(2)));
typedef unsigned u32x4 __attribute__((ext_vector_type(4)));
typedef unsigned u32x2 __attribute__((ext_vector_type(2)));

constexpr int DM = 1024, NB = 4, SEQ = 8192, TOK = NB * SEQ;
constexpr int NH = 4, HD = 128, BW = 512;
constexpr int CHUNK = 64, NCH = SEQ / CHUNK;
constexpr int NMEM = 256, DFF = 4096, DIN = 7176, NPROJ = 7168;
constexpr float EPS = 1e-6f;

constexpr size_t MiB = 1u << 20;
constexpr size_t WS_CTL = 0;
constexpr size_t WS_WIN = 1 * MiB;
constexpr size_t WS_WMKV = 15 * MiB;
constexpr size_t WS_WBR = 17 * MiB;
constexpr size_t WS_WO = 20 * MiB;
constexpr size_t WS_WUP = 22 * MiB;
constexpr size_t WS_WDN = 30 * MiB;
constexpr size_t WS_MEMN = 38 * MiB;
constexpr size_t WS_MEMKV = 40 * MiB;
constexpr size_t WS_AB = 42 * MiB;
constexpr size_t WS_SSQ = 43 * MiB;
constexpr size_t WS_GL = 45 * MiB;
constexpr size_t WS_H = 46 * MiB;
constexpr size_t WS_GDNI = 110 * MiB;
constexpr size_t GI_W = 0, GI_QD = 32 * MiB, GI_KDT = 64 * MiB, GI_UT = 96 * MiB, GI_A = 128 * MiB;
constexpr size_t WS_GZ = 254 * MiB;
constexpr size_t WS_GQKV = 286 * MiB;
constexpr size_t WS_OG = 318 * MiB;
constexpr size_t WS_OS = 350 * MiB;
constexpr size_t WS_SQKV = 382 * MiB;
constexpr size_t WS_MQ = 478 * MiB;
constexpr size_t WS_GATES = 110 * MiB;
constexpr size_t WS_MIXF = 382 * MiB;
constexpr size_t WS_MIX = 46 * MiB;
constexpr size_t WS_X1B = 110 * MiB;
constexpr size_t WS_ACT = 174 * MiB;
constexpr size_t WS_END = 510 * MiB;

constexpr int LDS_BYTES = 147456;

typedef __bf16 bf16x2_t __attribute__((ext_vector_type(2)));
__device__ __forceinline__ unsigned cvt_pk_bf16_mfma(float lo, float hi) { f32x2 v = {lo, hi}; bf16x2_t b = __builtin_convertvector(v, bf16x2_t); return __builtin_bit_cast(unsigned, b); }
__device__ __forceinline__ unsigned cvt_pk_bf16(float lo, float hi) { unsigned r; asm volatile("v_cvt_pk_bf16_f32 %0, %1, %2" : "=v"(r) : "v"(lo), "v"(hi)); return r; }
__device__ __forceinline__ float bflo(unsigned u) { return __uint_as_float(u << 16); }
__device__ __forceinline__ float bfhi(unsigned u) { return __uint_as_float(u & 0xffff0000u); }
__device__ __forceinline__ float wave_sum(float v) {
#pragma unroll
    for (int o = 1; o < 64; o <<= 1) v += __shfl_xor(v, o);
    return v;
}
__device__ __forceinline__ float sigmoidf_(float x) { return 1.0f / (1.0f + __expf(-x)); }
__device__ __forceinline__ float softplusf_(float x) { return fmaxf(x, 0.f) + __logf(1.0f + __expf(-fabsf(x))); }
__device__ __forceinline__ u32x2 ld8_agent(const void* p) { const unsigned long long v = __hip_atomic_load((const unsigned long long*)p, __ATOMIC_RELAXED, __HIP_MEMORY_SCOPE_AGENT); u32x2 r; r.x = (unsigned)v; r.y = (unsigned)(v >> 32); return r; }
#define MFMA16(x, y, c) __builtin_amdgcn_mfma_f32_16x16x32_bf16((x), (y), (c), 0, 0, 0)
#define LDS_WAIT() asm volatile("s_waitcnt lgkmcnt(0)" ::: "memory")
#define LDS_BARRIER() do { asm volatile("s_waitcnt lgkmcnt(0)" ::: "memory"); __builtin_amdgcn_s_barrier(); asm volatile("" ::: "memory"); } while (0)

namespace pg8 {
constexpr int BM = 256, BK = 64, HALF = 128, HTB = HALF * BK * 2, STAGE_BYTES = 8 * HTB, NXCD = 8, WGM = 8;
__host__ __device__ __forceinline__ int lds_byte(int r, int c) { const int st = (r >> 4) * 2 + (c >> 5), rr = r & 15, cc = c & 31, ob = rr * 64 + cc * 2; return st * 1024 + (ob ^ (((ob >> 9) & 1) << 5)); }
__host__ __device__ __forceinline__ void stage_rc(int b, int& R, int& C) { const int st = b / 1024, sb = b % 1024, swz = sb ^ (((sb >> 9) & 1) << 5); R = (st >> 1) * 16 + swz / 64; C = (st & 1) * 32 + (swz % 64) / 2; }
__host__ __device__ __forceinline__ int perm32(int rho) { const int n = rho >> 4, i = rho & 15; return 8 * (i >> 2) + 4 * n + (i & 3); }

struct Unit { int pm, pn, kind; const char* A; const char* B; };

__device__ __forceinline__ bool tile_order(int nM, int nN, int G, int c, int i, int& pm, int& pn) {
    const int nwg = nM * nN; const long L = (long)i * G + c; if (L >= nwg) return false;
    int wgid = (int)L; { const int q = nwg / NXCD, r = nwg % NXCD, xcd = wgid % NXCD, off = wgid / NXCD; wgid = (xcd < r ? xcd * (q + 1) : r * (q + 1) + (xcd - r) * q) + off; }
    const int nig = WGM * nN, gid = wgid / nig, fm = gid * WGM, gsz = (nM - fm) < WGM ? (nM - fm) : WGM;
    pm = fm + ((wgid % nig) % gsz); pn = (wgid % nig) / gsz; return true;
}

template <class Epi, class Sched, bool ALIGN_EPI, bool SP2>
__device__ __forceinline__ void gemm_phase(LAS unsigned char* lds, const int K, const Sched& S, const Epi& E) {
    const int tid = threadIdx.x, wid = __builtin_amdgcn_readfirstlane(tid >> 6), lane = tid & 63, wr = wid >> 2, wc = wid & 3, fr = lane & 15, fq = lane >> 4;
    const int nt = K / BK;
    unsigned voffA[2], voffB[2];
#pragma unroll
    for (int i = 0; i < 2; ++i) { int R, C; stage_rc(tid * 16 + i * 8192, R, C); const int Rb = Epi::PERM ? ((R & ~31) + perm32(R & 31)) : R;
        voffA[i] = (unsigned)(R * K + C) * 2u; voffB[i] = (unsigned)(Rb * K + C) * 2u; }
    const size_t kstep = (size_t)(BK * 2);
    const size_t hstep = (size_t)HALF * K * 2;
    const unsigned ldsw = (unsigned)wid * 1024u;
    const int aoff = lds_byte(wr * 64 + fr, fq * 8), boff = lds_byte(wc * 32 + fr, fq * 8);
#define PG8_SA(b, h) (((b) * 2 + (h)) * HTB)
#define PG8_SB(b, h) ((4 + (b) * 2 + (h)) * HTB)
#define PG8_STAGE(bufoff, gbase, voff) do { _Pragma("unroll") for (int _i = 0; _i < 2; ++_i) \
        __builtin_amdgcn_global_load_lds((const unsigned*)((const char*)(gbase) + (voff)[_i]), (LAS unsigned*)(lds + (bufoff) + ldsw + _i * 8192), 16, 0, 0); } while (0)
#define PG8_LDA(dst, b, h) do { _Pragma("unroll") for (int m = 0; m < 4; ++m) _Pragma("unroll") for (int k = 0; k < 2; ++k) dst[m][k] = *(const LAS bf16x8*)(lds + PG8_SA(b, h) + aoff + m * 2048 + k * 1024); } while (0)
#define PG8_LDB(dst, b, h) do { _Pragma("unroll") for (int n = 0; n < 2; ++n) _Pragma("unroll") for (int k = 0; k < 2; ++k) dst[n][k] = *(const LAS bf16x8*)(lds + PG8_SB(b, h) + boff + n * 2048 + k * 1024); } while (0)
#define PG8_MMA(ai, bj, At, Bt) do { __builtin_amdgcn_s_setprio(1); _Pragma("unroll") for (int m = 0; m < 4; ++m) _Pragma("unroll") for (int n = 0; n < 2; ++n) _Pragma("unroll") for (int k = 0; k < 2; ++k) \
        acc[ai][bj][m][n] = __builtin_amdgcn_mfma_f32_16x16x32_bf16(Bt[n][k], At[m][k], acc[ai][bj][m][n], 0, 0, 0); __builtin_amdgcn_s_setprio(0); } while (0)
#define PG8_WAIT_V(n) asm volatile("s_waitcnt vmcnt(" #n ")" ::: "memory")
#define PG8_WAIT_L(n) asm volatile("s_waitcnt lgkmcnt(" #n ")" ::: "memory")
#define PG8_BAR __builtin_amdgcn_s_barrier()
#define PG8_SCHED __builtin_amdgcn_sched_barrier(0)
    Unit cur, nxt; int ui = 0;
    if (!S.next(0, cur)) return;
    f32x4 acc[2][2][4][2];
#pragma unroll
    for (int a = 0; a < 2; ++a)
#pragma unroll
        for (int b = 0; b < 2; ++b)
#pragma unroll
            for (int m = 0; m < 4; ++m)
#pragma unroll
                for (int n = 0; n < 2; ++n) acc[a][b][m][n] = (f32x4){0.f, 0.f, 0.f, 0.f};
    bf16x8 At[4][2], B0[2][2], B1[2][2];
    const char* cA = cur.A; const char* cB = cur.B;
    if constexpr (SP2) {
        PG8_STAGE(PG8_SB(0, 0), cB, voffB); PG8_STAGE(PG8_SB(0, 1), cB + hstep, voffB); PG8_STAGE(PG8_SA(0, 0), cA, voffA); PG8_STAGE(PG8_SA(0, 1), cA + hstep, voffA);
        if (wr == 1) PG8_BAR;
        PG8_WAIT_V(2); PG8_BAR;
        PG8_STAGE(PG8_SB(1, 0), cB + kstep, voffB); PG8_STAGE(PG8_SA(1, 0), cA + kstep, voffA); PG8_STAGE(PG8_SB(1, 1), cB + hstep + kstep, voffB);
        PG8_WAIT_V(6); PG8_BAR;
    } else {
        PG8_STAGE(PG8_SB(0, 0), cB, voffB); PG8_STAGE(PG8_SA(0, 0), cA, voffA); PG8_STAGE(PG8_SB(0, 1), cB + hstep, voffB); PG8_STAGE(PG8_SA(0, 1), cA + hstep, voffA);
        if (wr == 1) PG8_BAR;
        PG8_WAIT_V(4); PG8_BAR;
        PG8_STAGE(PG8_SB(1, 0), cB + kstep, voffB); PG8_STAGE(PG8_SA(1, 0), cA + kstep, voffA); PG8_STAGE(PG8_SB(1, 1), cB + hstep + kstep, voffB);
        PG8_WAIT_V(6); PG8_BAR;
    }
    for (;;) {
        const bool has_next = S.next(ui + 1, nxt);
        const char* nA = has_next ? nxt.A : cA; const char* nB = has_next ? nxt.B : cB;
        for (int t = 0; t < nt; t += 2) {
            const bool last = (t == nt - 2);
            const char* a1 = cA + (size_t)(t + 1) * kstep;
            const char* a2 = last ? nA : cA + (size_t)(t + 2) * kstep; const char* b2 = last ? nB : cB + (size_t)(t + 2) * kstep;
            const char* a3 = a2 + kstep; const char* b3 = b2 + kstep;
            if constexpr (SP2) {
            PG8_LDB(B0, 0, 0); PG8_LDB(B1, 0, 1); PG8_SCHED; PG8_LDA(At, 0, 0); PG8_STAGE(PG8_SA(1, 1), a1 + hstep, voffA);
            PG8_WAIT_V(8); PG8_WAIT_L(0); PG8_BAR; PG8_MMA(0, 0, At, B0); PG8_MMA(0, 1, At, B1); PG8_BAR; PG8_SCHED;
            PG8_LDA(At, 0, 1); PG8_STAGE(PG8_SB(0, 0), b2, voffB); PG8_STAGE(PG8_SB(0, 1), b2 + hstep, voffB); PG8_STAGE(PG8_SA(0, 0), a2, voffA);
            PG8_WAIT_V(8); PG8_WAIT_L(0); PG8_BAR; PG8_MMA(1, 0, At, B0); PG8_MMA(1, 1, At, B1); PG8_BAR; PG8_SCHED;
            PG8_LDB(B0, 1, 0); PG8_LDB(B1, 1, 1); PG8_SCHED; PG8_LDA(At, 1, 0); PG8_STAGE(PG8_SA(0, 1), a2 + hstep, voffA);
            PG8_WAIT_V(8); PG8_WAIT_L(0); PG8_BAR; PG8_MMA(0, 0, At, B0); PG8_MMA(0, 1, At, B1); PG8_BAR; PG8_SCHED;
            PG8_LDA(At, 1, 1); PG8_STAGE(PG8_SB(1, 0), b3, voffB); PG8_STAGE(PG8_SB(1, 1), b3 + hstep, voffB); PG8_STAGE(PG8_SA(1, 0), a3, voffA);
            PG8_WAIT_V(8); PG8_WAIT_L(0); PG8_BAR; PG8_MMA(1, 0, At, B0); PG8_MMA(1, 1, At, B1); PG8_BAR; PG8_SCHED;
            } else {
            PG8_LDB(B0, 0, 0); PG8_SCHED; PG8_LDA(At, 0, 0); PG8_STAGE(PG8_SA(1, 1), a1 + hstep, voffA);
            PG8_WAIT_L(8); PG8_BAR; PG8_WAIT_L(0); PG8_MMA(0, 0, At, B0); PG8_BAR; PG8_SCHED;
            PG8_LDB(B1, 0, 1); PG8_STAGE(PG8_SB(0, 0), b2, voffB);
            PG8_BAR; PG8_WAIT_L(0); PG8_MMA(0, 1, At, B1); PG8_BAR;
            PG8_LDA(At, 0, 1); PG8_STAGE(PG8_SA(0, 0), a2, voffA);
            PG8_BAR; PG8_WAIT_L(0); PG8_MMA(1, 0, At, B0); PG8_BAR; PG8_SCHED;
            PG8_STAGE(PG8_SB(0, 1), b2 + hstep, voffB);
            PG8_WAIT_V(6); PG8_BAR; PG8_MMA(1, 1, At, B1); PG8_BAR;
            PG8_LDB(B0, 1, 0); PG8_SCHED; PG8_LDA(At, 1, 0); PG8_STAGE(PG8_SA(0, 1), a2 + hstep, voffA);
            PG8_WAIT_L(8); PG8_BAR; PG8_WAIT_L(0); PG8_MMA(0, 0, At, B0); PG8_BAR; PG8_SCHED;
            PG8_LDB(B1, 1, 1); PG8_STAGE(PG8_SB(1, 0), b3, voffB);
            PG8_BAR; PG8_WAIT_L(0); PG8_MMA(0, 1, At, B1); PG8_BAR;
            PG8_LDA(At, 1, 1); PG8_STAGE(PG8_SA(1, 0), a3, voffA);
            PG8_BAR; PG8_WAIT_L(0); PG8_MMA(1, 0, At, B0); PG8_BAR; PG8_SCHED;
            PG8_STAGE(PG8_SB(1, 1), b3 + hstep, voffB);
            PG8_WAIT_V(6); PG8_BAR; PG8_MMA(1, 1, At, B1); PG8_BAR;
            }
        }
        if constexpr (ALIGN_EPI) { if (wr == 0) PG8_BAR; }
        E(acc, cur, wr, wc, fr, fq);
        if (!has_next) break;
#pragma unroll
        for (int a = 0; a < 2; ++a)
#pragma unroll
            for (int b = 0; b < 2; ++b)
#pragma unroll
                for (int m = 0; m < 4; ++m)
#pragma unroll
                    for (int n = 0; n < 2; ++n) acc[a][b][m][n] = (f32x4){0.f, 0.f, 0.f, 0.f};
        cur = nxt; cA = nA; cB = nB; ++ui;
        if constexpr (ALIGN_EPI) { if (wr == 1) PG8_BAR; }
    }
    PG8_WAIT_V(0);
    if constexpr (!ALIGN_EPI) { if (wr == 0) PG8_BAR; }
    PG8_BAR;
#undef PG8_SA
#undef PG8_SB
#undef PG8_STAGE
#undef PG8_LDA
#undef PG8_LDB
#undef PG8_MMA
#undef PG8_WAIT_V
#undef PG8_WAIT_L
#undef PG8_BAR
#undef PG8_SCHED
}
}

struct Args {
    const float* in[21];
    float* out; unsigned char* ws;
    int ph_lo, ph_hi;
};
enum { I_X = 0, I_MEM, I_N1G, I_WIN, I_CONVW, I_ALOG, I_DTB, I_GDNG, I_SBQG, I_SBKG, I_MEMNG, I_WMKV, I_MQG, I_MKG, I_WBRG, I_WBRS, I_WBRM, I_WO, I_N2G, I_WUP, I_WDN };

struct SchedGrid {
    const char* A; const char* B; int nM, nN, G, c; size_t tstep;
    __device__ __forceinline__ bool next(int i, pg8::Unit& u) const {
        if (!pg8::tile_order(nM, nN, G, c, i, u.pm, u.pn)) return false;
        u.kind = 0; u.A = A + (size_t)u.pm * tstep; u.B = B + (size_t)u.pn * tstep; return true;
    }
};
struct SchedBranch {
    const char* A0; const char* A1; const char* A2; const char* B; int G, c; size_t tstep;
    __device__ __forceinline__ bool next(int i, pg8::Unit& u) const {
        const int t = i / 3, br = i - 3 * t;
        if (!pg8::tile_order(TOK / 256, DM / 256, G, c, t, u.pm, u.pn)) return false;
        u.kind = br; u.A = (br == 0 ? A0 : (br == 1 ? A1 : A2)) + (size_t)u.pm * tstep; u.B = B + (size_t)br * ((size_t)DM * BW * 2) + (size_t)u.pn * tstep; return true;
    }
};

struct EpiP1 {
    static constexpr bool PERM = true;
    bf16_t* gqkv; bf16_t* gz; bf16_t* sqkv; bf16_t* mq; bf16_t* gates; bf16_t* memkv; int is_mem;
    __device__ __forceinline__ void operator()(const f32x4 (&acc)[2][2][4][2], const pg8::Unit& u, int wr, int wc, int fr, int fq) const {
        bf16_t* base; int ldc, c0; bool sig = false; const int pn = u.pn;
        if (is_mem == 1) { base = memkv; ldc = 1024; c0 = pn * 256; }
        else if (is_mem == 2) { base = gates; ldc = 3072; c0 = pn * 256; sig = true; }
        else if (pn < 6) { base = gqkv; ldc = 1536; c0 = pn * 256; }
        else if (pn < 8) { base = gz; ldc = 512; c0 = (pn - 6) * 256; }
        else if (pn < 14) { base = sqkv; ldc = 1536; c0 = (pn - 8) * 256; }
        else { base = mq; ldc = 512; c0 = (pn - 14) * 256; }
        const int row0 = u.pm * 256 + wr * 64 + fr, col0 = c0 + wc * 32 + 8 * fq;
#pragma unroll
        for (int ai = 0; ai < 2; ++ai)
#pragma unroll
            for (int m = 0; m < 4; ++m) { bf16_t* rowp = base + (size_t)(row0 + ai * 128 + m * 16) * ldc + col0;
#pragma unroll
                for (int bj = 0; bj < 2; ++bj) { f32x4 v0 = acc[ai][bj][m][0], v1 = acc[ai][bj][m][1];
                    if (sig) {
#pragma unroll
                        for (int e = 0; e < 4; ++e) { v0[e] = sigmoidf_(v0[e]); v1[e] = sigmoidf_(v1[e]); } }
                    u32x4 w; w.x = cvt_pk_bf16_mfma(v0[0], v0[1]); w.y = cvt_pk_bf16_mfma(v0[2], v0[3]); w.z = cvt_pk_bf16_mfma(v1[0], v1[1]); w.w = cvt_pk_bf16_mfma(v1[2], v1[3]);
                    *(u32x4*)(rowp + bj * 128) = w; } }
    }
};
struct EpiP3 {
    static constexpr bool PERM = true;
    const bf16_t* gates; float* priv; bf16_t* mix;
    __device__ __forceinline__ void operator()(const f32x4 (&acc)[2][2][4][2], const pg8::Unit& u, int wr, int wc, int fr, int fq) const {
        const int br = u.kind; int opq; asm volatile("v_mov_b32 %0, 0" : "=v"(opq));
        const unsigned row0 = (unsigned)(u.pm * 256 + wr * 64 + fr + opq), col0 = (unsigned)(u.pn * 256 + wc * 32 + 8 * fq);
        const unsigned goff0 = row0 * 3072u + (unsigned)br * 1024u + col0, moff0 = row0 * 1024u + col0;
        u32x4* pv = (u32x4*)priv + threadIdx.x + opq;
        if (br > 0) asm volatile("s_waitcnt vmcnt(0)" ::: "memory");
#pragma unroll
        for (int ai = 0; ai < 2; ++ai)
#pragma unroll
            for (int m = 0; m < 4; ++m) {
#pragma unroll
                for (int bj = 0; bj < 2; ++bj) {
                    const u32x4 g = *(const u32x4*)(gates + (goff0 + (unsigned)((ai * 128 + m * 16) * 3072 + bj * 128)));
                    f32x4 v0 = acc[ai][bj][m][0], v1 = acc[ai][bj][m][1];
                    v0[0] *= bflo(g.x); v0[1] *= bfhi(g.x); v0[2] *= bflo(g.y); v0[3] *= bfhi(g.y);
                    v1[0] *= bflo(g.z); v1[1] *= bfhi(g.z); v1[2] *= bflo(g.w); v1[3] *= bfhi(g.w);
                    const int ri = (ai * 2 + bj) * 4 + m;
                    if (br > 0) { const u32x4 p = pv[ri * 512];
                        v0[0] += bflo(p.x); v0[1] += bfhi(p.x); v0[2] += bflo(p.y); v0[3] += bfhi(p.y);
                        v1[0] += bflo(p.z); v1[1] += bfhi(p.z); v1[2] += bflo(p.w); v1[3] += bfhi(p.w); }
                    u32x4 w; w.x = cvt_pk_bf16(v0[0], v0[1]); w.y = cvt_pk_bf16(v0[2], v0[3]); w.z = cvt_pk_bf16(v1[0], v1[1]); w.w = cvt_pk_bf16(v1[2], v1[3]);
                    if (br < 2) pv[ri * 512] = w;
                    else *(u32x4*)(mix + (moff0 + (unsigned)((ai * 128 + m * 16) * 1024 + bj * 128))) = w; }
                asm volatile("" ::: "memory"); }
    }
};
struct EpiP4 {
    static constexpr bool PERM = true;
    const float* x; float* out; bf16_t* x1b; float* ssq;
    __device__ __forceinline__ void operator()(const f32x4 (&acc)[2][2][4][2], const pg8::Unit& u, int wr, int wc, int fr, int fq) const {
        int opq; asm volatile("v_mov_b32 %0, 0" : "=v"(opq));
        const unsigned row0 = (unsigned)(u.pm * 256 + wr * 64 + fr + opq), col0 = (unsigned)(u.pn * 256 + wc * 32 + 8 * fq);
#pragma unroll
        for (int ai = 0; ai < 2; ++ai)
#pragma unroll
            for (int m = 0; m < 4; ++m) { const unsigned row = row0 + ai * 128 + m * 16; float s = 0.f;
#pragma unroll
                for (int bj = 0; bj < 2; ++bj) { const unsigned off = row * 1024u + col0 + bj * 128;
#ifdef P4_MINIMAL
                    const f32x4 o0 = acc[ai][bj][m][0], o1 = acc[ai][bj][m][1];
#else
                    const f32x4 o0 = *(const f32x4*)(x + off) + acc[ai][bj][m][0], o1 = *(const f32x4*)(x + off + 4) + acc[ai][bj][m][1];
#endif
                    s += (o0[0] * o0[0] + o0[1] * o0[1]) + (o0[2] * o0[2] + o0[3] * o0[3]) + (o1[0] * o1[0] + o1[1] * o1[1]) + (o1[2] * o1[2] + o1[3] * o1[3]);
                    u32x4 w; w.x = cvt_pk_bf16(o0[0], o0[1]); w.y = cvt_pk_bf16(o0[2], o0[3]); w.z = cvt_pk_bf16(o1[0], o1[1]); w.w = cvt_pk_bf16(o1[2], o1[3]);
                    *(u32x4*)(x1b + off) = w; }
#ifndef NO_SSQ
                s += __shfl_xor(s, 16); s += __shfl_xor(s, 32);
                if (fq == 0) ssq[(size_t)u.pn * (TOK * 4) + row * 4 + wc] = s;
#endif
                asm volatile("" ::: "memory"); }
    }
};
struct EpiP6 {
    static constexpr bool PERM = true;
    const float* ssq; bf16_t* act;
    __device__ __forceinline__ void operator()(const f32x4 (&acc)[2][2][4][2], const pg8::Unit& u, int wr, int wc, int fr, int fq) const {
        const int row0 = u.pm * 256 + wr * 64 + fr, col0 = u.pn * 256 + wc * 32 + 8 * fq;
#pragma unroll
        for (int ai = 0; ai < 2; ++ai)
#pragma unroll
            for (int m = 0; m < 4; ++m) { const size_t row = (size_t)(row0 + ai * 128 + m * 16);
                const f32x4 p = *(const f32x4*)(ssq + (size_t)fq * (TOK * 4) + row * 4); float s = (p[0] + p[1]) + (p[2] + p[3]);
                s += __shfl_xor(s, 16); s += __shfl_xor(s, 32);
                const float rstd = rsqrtf(s * (1.0f / DM) + EPS);
#pragma unroll
                for (int bj = 0; bj < 2; ++bj) { f32x4 v0 = acc[ai][bj][m][0] * rstd, v1 = acc[ai][bj][m][1] * rstd;
#pragma unroll
                    for (int e = 0; e < 4; ++e) { const float a = fmaxf(v0[e], 0.f), b = fmaxf(v1[e], 0.f); v0[e] = a * a; v1[e] = b * b; }
                    u32x4 w; w.x = cvt_pk_bf16(v0[0], v0[1]); w.y = cvt_pk_bf16(v0[2], v0[3]); w.z = cvt_pk_bf16(v1[0], v1[1]); w.w = cvt_pk_bf16(v1[2], v1[3]);
                    *(u32x4*)(act + row * 4096 + col0 + bj * 128) = w; } }
    }
};
struct EpiP7 {
    static constexpr bool PERM = false;
    const bf16_t* x1b; float* out;
    __device__ __forceinline__ void operator()(const f32x4 (&acc)[2][2][4][2], const pg8::Unit& u, int wr, int wc, int fr, int fq) const {
        int opq; asm volatile("v_mov_b32 %0, 0" : "=v"(opq));
        const unsigned row0 = (unsigned)(u.pm * 256 + wr * 64 + fr + opq), col0 = (unsigned)(u.pn * 256 + wc * 32 + 4 * fq);
#pragma unroll
        for (int ai = 0; ai < 2; ++ai)
#pragma unroll
            for (int m = 0; m < 4; ++m) { const unsigned row = row0 + ai * 128 + m * 16;
#pragma unroll
                for (int bj = 0; bj < 2; ++bj)
#pragma unroll
                    for (int n = 0; n < 2; ++n) { const unsigned off = row * 1024u + col0 + bj * 128 + n * 16;
                        const u32x2 xb = *(const u32x2*)(x1b + off);
                        f32x4 o = acc[ai][bj][m][n];
#ifndef P7_NOX
                        o[0] += bflo(xb.x); o[1] += bfhi(xb.x); o[2] += bflo(xb.y); o[3] += bfhi(xb.y);
#endif
                        *(f32x4*)(out + off) = o; }
                asm volatile("" ::: "memory"); }
    }
};

__device__ __forceinline__ void p0_transpose_item(const float* W, int K, int ldw, int N, bf16_t* WT, const float* kscale, int skip_at, LAS float* scr, int item, int lane) {
    const int nblk = N / 32, kb = item / nblk, nb = item % nblk, k0 = 64 * kb, n0 = 32 * nb;
    const int src0 = n0 + (n0 >= skip_at ? 8 : 0);
#pragma unroll 8
    for (int i = 0; i < 32; ++i) { const int kk = 2 * i + (lane >> 5); float v = W[(size_t)(k0 + kk) * ldw + src0 + (lane & 31)]; if (kscale) v *= kscale[k0 + kk]; scr[kk * 33 + (lane & 31)] = v; }
    LDS_WAIT(); asm volatile("" ::: "memory");
    const int c = lane & 7;
#pragma unroll
    for (int j = 0; j < 4; ++j) { const int n = (lane >> 3) + 8 * j; const LAS float* s = scr + (8 * c) * 33 + n;
        u32x4 o; o.x = cvt_pk_bf16(s[0 * 33], s[1 * 33]); o.y = cvt_pk_bf16(s[2 * 33], s[3 * 33]); o.z = cvt_pk_bf16(s[4 * 33], s[5 * 33]); o.w = cvt_pk_bf16(s[6 * 33], s[7 * 33]);
        *(u32x4*)(WT + (size_t)(n0 + n) * K + k0 + 8 * c) = o; }
    LDS_WAIT(); asm volatile("" ::: "memory");
}

__device__ __forceinline__ void phase0(const Args& a, LAS unsigned char* lds, int vcu, int G) {
    const int tid = threadIdx.x, lane = tid & 63, wave = __builtin_amdgcn_readfirstlane(tid >> 6);
    unsigned char* ws = a.ws;
    LAS float* wab = (LAS float*)(lds + 8 * 8448);
    for (int e = tid; e < 8192; e += 512) wab[e] = a.in[I_WIN][(size_t)(e >> 3) * DIN + 2048 + (e & 7)];
    LAS float* scr = (LAS float*)(lds + wave * 8448);
    const int gw = vcu * 8 + wave, NGW = G * 8;
    constexpr int I_IN = 16 * 224, I_MKV = 16 * 32, I_BR = 8 * 32, I_O = 16 * 32, I_UP = 16 * 128, I_DN = 64 * 32;
    constexpr int NITEMS = I_IN + I_MKV + 3 * I_BR + I_O + I_UP + I_DN;
    for (int it = gw; it < NITEMS; it += NGW) {
        int r = it;
        if (r < I_IN) { p0_transpose_item(a.in[I_WIN], 1024, DIN, NPROJ, (bf16_t*)(ws + WS_WIN), nullptr, 2048, scr, r, lane); continue; } r -= I_IN;
        if (r < I_MKV) { p0_transpose_item(a.in[I_WMKV], 1024, 1024, 1024, (bf16_t*)(ws + WS_WMKV), nullptr, 1 << 30, scr, r, lane); continue; } r -= I_MKV;
        if (r < I_BR) { p0_transpose_item(a.in[I_WBRG], 512, 1024, 1024, (bf16_t*)(ws + WS_WBR), nullptr, 1 << 30, scr, r, lane); continue; } r -= I_BR;
        if (r < I_BR) { p0_transpose_item(a.in[I_WBRS], 512, 1024, 1024, (bf16_t*)(ws + WS_WBR) + (size_t)DM * BW, nullptr, 1 << 30, scr, r, lane); continue; } r -= I_BR;
        if (r < I_BR) { p0_transpose_item(a.in[I_WBRM], 512, 1024, 1024, (bf16_t*)(ws + WS_WBR) + (size_t)2 * DM * BW, nullptr, 1 << 30, scr, r, lane); continue; } r -= I_BR;
        if (r < I_O) { p0_transpose_item(a.in[I_WO], 1024, 1024, 1024, (bf16_t*)(ws + WS_WO), nullptr, 1 << 30, scr, r, lane); continue; } r -= I_O;
        if (r < I_UP) { p0_transpose_item(a.in[I_WUP], 1024, 4096, 4096, (bf16_t*)(ws + WS_WUP), a.in[I_N2G], 1 << 30, scr, r, lane); continue; } r -= I_UP;
        p0_transpose_item(a.in[I_WDN], 4096, 1024, 1024, (bf16_t*)(ws + WS_WDN), nullptr, 1 << 30, scr, r, lane);
    }
    __syncthreads();
    const float* g1 = a.in[I_N1G]; bf16_t* H = (bf16_t*)(ws + WS_H); float* AB = (float*)(ws + WS_AB);
    f32x4 gv[4];
#pragma unroll
    for (int j = 0; j < 4; ++j) gv[j] = *(const f32x4*)(g1 + 256 * j + 4 * lane);
    for (int m = gw; m < TOK; m += NGW) {
        const f32x4* xr = (const f32x4*)(a.in[I_X] + (size_t)m * DM) + lane;
        f32x4 v[4]; float s = 0.f;
#pragma unroll
        for (int j = 0; j < 4; ++j) { v[j] = xr[64 * j]; s += (v[j].x * v[j].x + v[j].y * v[j].y) + (v[j].z * v[j].z + v[j].w * v[j].w); }
        const float rstd = rsqrtf(wave_sum(s) * (1.f / DM) + EPS);
        float p[8];
#pragma unroll
        for (int c = 0; c < 8; ++c) p[c] = 0.f;
        u32x2* o8 = (u32x2*)(H + (size_t)m * DM) + lane;
#pragma unroll
        for (int j = 0; j < 4; ++j) { v[j] = v[j] * rstd * gv[j];
            u32x2 w; w.x = cvt_pk_bf16(v[j].x, v[j].y); w.y = cvt_pk_bf16(v[j].z, v[j].w); o8[64 * j] = w;
#pragma unroll
            for (int e = 0; e < 4; ++e) { const LAS f32x4* wp = (const LAS f32x4*)(wab + (256 * j + 4 * lane + e) * 8); const f32x4 w0 = wp[0], w1 = wp[1]; const float hv = v[j][e];
                p[0] += hv * w0.x; p[1] += hv * w0.y; p[2] += hv * w0.z; p[3] += hv * w0.w; p[4] += hv * w1.x; p[5] += hv * w1.y; p[6] += hv * w1.z; p[7] += hv * w1.w; } }
#pragma unroll
        for (int c = 0; c < 8; ++c) p[c] = wave_sum(p[c]);
        if (lane == 0) { f32x4* ab = (f32x4*)(AB + (size_t)m * 8); ab[0] = (f32x4){p[0], p[1], p[2], p[3]}; ab[1] = (f32x4){p[4], p[5], p[6], p[7]}; }
    }
    const float* gm = a.in[I_MEMNG]; bf16_t* MN = (bf16_t*)(ws + WS_MEMN);
#pragma unroll
    for (int j = 0; j < 4; ++j) gv[j] = *(const f32x4*)(gm + 256 * j + 4 * lane);
    for (int m = gw; m < NB * NMEM; m += NGW) {
        const f32x4* xr = (const f32x4*)(a.in[I_MEM] + (size_t)m * DM) + lane;
        f32x4 v[4]; float s = 0.f;
#pragma unroll
        for (int j = 0; j < 4; ++j) { v[j] = xr[64 * j]; s += (v[j].x * v[j].x + v[j].y * v[j].y) + (v[j].z * v[j].z + v[j].w * v[j].w); }
        const float rstd = rsqrtf(wave_sum(s) * (1.f / DM) + EPS);
        u32x2* o8 = (u32x2*)(MN + (size_t)m * DM) + lane;
#pragma unroll
        for (int j = 0; j < 4; ++j) { v[j] = v[j] * rstd * gv[j]; u32x2 w; w.x = cvt_pk_bf16(v[j].x, v[j].y); w.y = cvt_pk_bf16(v[j].z, v[j].w); o8[64 * j] = w; }
    }
}

constexpr int PQ_LD = 136;
__device__ __forceinline__ void gdn_prep_unit(const Args& a, LAS unsigned char* lds, int cid) {
    const int tid = threadIdx.x, lane = tid & 63, wave = __builtin_amdgcn_readfirstlane(tid >> 6), fr = lane & 15, fq = lane >> 4;
    unsigned char* ws = a.ws;
    const int n = cid & (NCH - 1), bh = cid >> 7, h = bh & 3, b = bh >> 2;
    const size_t row0 = (size_t)b * SEQ + (size_t)n * CHUNK;
    LAS bf16_t* Qb = (LAS bf16_t*)lds;
    LAS bf16_t* Kb = (LAS bf16_t*)(lds + 17408);
    LAS float* Kf = (LAS float*)(lds + 34816);
    LAS float* Vf = (LAS float*)(lds + 34816 + 32768);
    LAS float* Lm = (LAS float*)(lds + 34816 + 65536);
    LAS float* gcs = (LAS float*)(lds + 34816 + 65536 + 16384);
    LAS float* bet = gcs + 64;
    LAS float* bge = gcs + 128;
    const bf16_t* GQ = (const bf16_t*)a.out;
    if (wave == 0) {
        const float* AB = (const float*)(ws + WS_AB) + (row0 + lane) * 8;
        const float al = AB[h], bl = AB[4 + h];
        float g = -__expf(a.in[I_ALOG][h]) * softplusf_(al + a.in[I_DTB][h]);
#pragma unroll
        for (int o = 1; o < 64; o <<= 1) { const float t = __shfl_up(g, o); if (lane >= o) g += t; }
        const float be = sigmoidf_(bl);
        gcs[lane] = g; bet[lane] = be; bge[lane] = be * __expf(g);
        { const float gle = __expf(__shfl(g, 63)); if (lane < 32) ((float*)(ws + WS_GL))[cid * 32 + lane] = gle; }
    }
    {
        const float* cw = a.in[I_CONVW];
        float wq[4][2], wk[4][2], wv[4][2];
#pragma unroll
        for (int j = 0; j < 4; ++j) { const float* p = cw + j * 1536 + h * 128 + 2 * lane; wq[j][0] = p[0]; wq[j][1] = p[1]; wk[j][0] = p[512]; wk[j][1] = p[513]; wv[j][0] = p[1024]; wv[j][1] = p[1025]; }
        unsigned rq[11], rk[11], rv[11];
#pragma unroll
        for (int i = 0; i < 11; ++i) { const int rr = wave * 8 + i - 3; const bool ok = (n > 0) || (rr >= 0);
            const bf16_t* p = GQ + (row0 + rr) * 1536 + h * 128 + 2 * lane;
            rq[i] = ok ? *(const unsigned*)p : 0u; rk[i] = ok ? *(const unsigned*)(p + 512) : 0u; rv[i] = ok ? *(const unsigned*)(p + 1024) : 0u; }
#pragma unroll
        for (int i = 0; i < 8; ++i) { const int r = wave * 8 + i;
            float q0 = 0.f, q1 = 0.f, k0 = 0.f, k1 = 0.f, v0 = 0.f, v1 = 0.f;
#pragma unroll
            for (int j = 0; j < 4; ++j) { q0 += wq[j][0] * bflo(rq[i + j]); q1 += wq[j][1] * bfhi(rq[i + j]); k0 += wk[j][0] * bflo(rk[i + j]); k1 += wk[j][1] * bfhi(rk[i + j]);
                v0 += wv[j][0] * bflo(rv[i + j]); v1 += wv[j][1] * bfhi(rv[i + j]); }
            q0 *= sigmoidf_(q0); q1 *= sigmoidf_(q1); k0 *= sigmoidf_(k0); k1 *= sigmoidf_(k1); v0 *= sigmoidf_(v0); v1 *= sigmoidf_(v1);
            const float qn = rsqrtf(wave_sum(q0 * q0 + q1 * q1) + EPS) * 0.08838834764831845f, kn = rsqrtf(wave_sum(k0 * k0 + k1 * k1) + EPS);
            q0 *= qn; q1 *= qn; k0 *= kn; k1 *= kn;
            *(LAS unsigned*)(Qb + r * PQ_LD + 2 * lane) = cvt_pk_bf16(q0, q1);
            *(LAS unsigned*)(Kb + r * PQ_LD + 2 * lane) = cvt_pk_bf16(k0, k1);
            *(LAS f32x2*)(Kf + r * 128 + 2 * lane) = (f32x2){k0, k1};
            *(LAS f32x2*)(Vf + r * 128 + 2 * lane) = (f32x2){v0, v1}; }
    }
    __syncthreads();
    {
        const int mat = wave >> 2, ct = wave & 3;
        const LAS bf16_t* Xb = mat ? Qb : Kb;
        bf16x8 xf[4];
#pragma unroll
        for (int ks = 0; ks < 4; ++ks) xf[ks] = *(const LAS bf16x8*)(Xb + (ct * 16 + fr) * PQ_LD + ks * 32 + 8 * fq);
        bf16_t* Ag = (bf16_t*)(ws + WS_GDNI + GI_A) + (size_t)cid * 4096;
#pragma unroll
        for (int st = 0; st < 4; ++st) {
            f32x4 d = (f32x4){0.f, 0.f, 0.f, 0.f};
#pragma unroll
            for (int ks = 0; ks < 4; ++ks) { const bf16x8 yf = *(const LAS bf16x8*)(Kb + (st * 16 + fr) * PQ_LD + ks * 32 + 8 * fq); d = MFMA16(xf[ks], yf, d); }
            const int s = st * 16 + fr; const float gs = gcs[s];
#pragma unroll
            for (int i = 0; i < 4; ++i) { const int c = ct * 16 + 4 * fq + i; const float dec = __expf(fminf(gcs[c] - gs, 0.f));
                if (mat == 0) Lm[c * 64 + s] = (c > s) ? bet[c] * d[i] * dec : 0.f;
                else Ag[c * 64 + s] = (bf16_t)(cvt_pk_bf16((c >= s) ? d[i] * dec : 0.f, 0.f) & 0xffffu); }
        }
    }
    __syncthreads();
    const size_t gbase = (size_t)cid * 8192;
    if (wave < 4) {
        const int col = (wave & 1) * 64 + lane; const bool isw = wave >= 2;
        const LAS float* src = isw ? Kf : Vf; const LAS float* scl = isw ? bge : bet;
        float xv[64]; int opq; asm volatile("v_mov_b32 %0, 0" : "=v"(opq));
        const LAS float* Lmv = Lm + opq;
#pragma unroll
        for (int i = 0; i < 64; ++i) xv[i] = 0.f;
#pragma unroll
        for (int i = 0; i < 64; ++i) {
            float r0 = src[i * 128 + col] * scl[i], r1 = 0.f, r2 = 0.f, r3 = 0.f;
#pragma unroll
            for (int j4 = 0; j4 < (i + 3) / 4; ++j4) { const f32x4 lv = *(const LAS f32x4*)(Lmv + i * 64 + 4 * j4);
                r0 -= lv.x * xv[4 * j4]; r1 -= lv.y * xv[4 * j4 + 1]; r2 -= lv.z * xv[4 * j4 + 2]; r3 -= lv.w * xv[4 * j4 + 3]; }
            xv[i] = (r0 + r1) + (r2 + r3);
        }
        if (!isw) {
            u32x4* up = (u32x4*)((bf16_t*)(ws + WS_GDNI + GI_UT) + gbase + (size_t)col * 64);
#pragma unroll
            for (int j = 0; j < 8; ++j) { u32x4 w; w.x = cvt_pk_bf16(xv[8 * j], xv[8 * j + 1]); w.y = cvt_pk_bf16(xv[8 * j + 2], xv[8 * j + 3]); w.z = cvt_pk_bf16(xv[8 * j + 4], xv[8 * j + 5]); w.w = cvt_pk_bf16(xv[8 * j + 6], xv[8 * j + 7]); up[j] = w; }
        } else {
            bf16_t* wp = (bf16_t*)(ws + WS_GDNI + GI_W) + gbase + col;
#pragma unroll
            for (int i = 0; i < 64; ++i) wp[i * 128] = (bf16_t)(cvt_pk_bf16(xv[i], 0.f) & 0xffffu);
        }
    } else {
        const int t = tid - 256; const float gl = gcs[63];
        bf16_t* qd = (bf16_t*)(ws + WS_GDNI + GI_QD) + gbase; bf16_t* kdt = (bf16_t*)(ws + WS_GDNI + GI_KDT) + gbase;
#pragma unroll
        for (int j = 0; j < 4; ++j) { const int task = t + 256 * j, c = task >> 4, seg = task & 15; const float e = __expf(gcs[c]);
            const u32x4 qv = *(const LAS u32x4*)(Qb + c * PQ_LD + seg * 8);
            u32x4 w; w.x = cvt_pk_bf16(bflo(qv.x) * e, bfhi(qv.x) * e); w.y = cvt_pk_bf16(bflo(qv.y) * e, bfhi(qv.y) * e); w.z = cvt_pk_bf16(bflo(qv.z) * e, bfhi(qv.z) * e); w.w = cvt_pk_bf16(bflo(qv.w) * e, bfhi(qv.w) * e);
            *(u32x4*)(qd + c * 128 + seg * 8) = w; }
#pragma unroll
        for (int j = 0; j < 4; ++j) { const int task = t + 256 * j, dk = task & 127, c8 = task >> 7; float v[8];
#pragma unroll
            for (int e = 0; e < 8; ++e) { const int c = c8 * 8 + e; v[e] = Kf[c * 128 + dk] * __expf(gl - gcs[c]); }
            u32x4 w; w.x = cvt_pk_bf16(v[0], v[1]); w.y = cvt_pk_bf16(v[2], v[3]); w.z = cvt_pk_bf16(v[4], v[5]); w.w = cvt_pk_bf16(v[6], v[7]);
            *(u32x4*)(kdt + dk * 64 + c8 * 8) = w; }
    }
    asm volatile("s_waitcnt vmcnt(0)" ::: "memory"); __syncthreads();
}

constexpr int ST_LD = 136, VN_LD = 72;
__device__ __forceinline__ void gdn_scan_unit(const Args& a, LAS unsigned char* lds, int unit) {
    const int tid = threadIdx.x, lane = tid & 63, wave = __builtin_amdgcn_readfirstlane(tid >> 6), fr = lane & 15, fq = lane >> 4;
    unsigned char* ws = a.ws;
    const int bh = unit >> 2, sl = unit & 3, h = bh & 3, b = bh >> 2;
    LAS bf16_t* St = (LAS bf16_t*)lds;
    LAS bf16_t* VNt = (LAS bf16_t*)(lds + 2 * 32 * ST_LD * 2);
    LAS float* red = (LAS float*)(lds + 2 * 32 * ST_LD * 2 + 32 * VN_LD * 2);
    for (int e = tid; e < 32 * ST_LD / 2; e += 512) ((LAS unsigned*)St)[e] = 0u;
    f32x4 sacc[2];
    sacc[0] = (f32x4){0.f, 0.f, 0.f, 0.f}; sacc[1] = sacc[0];
    const int ct = wave >> 1, tt = wave & 1;
    const int dvg = sl * 32 + tt * 16;
    const bf16_t* Wg = (const bf16_t*)(ws + WS_GDNI + GI_W); const bf16_t* QDg = (const bf16_t*)(ws + WS_GDNI + GI_QD);
    const bf16_t* KDTg = (const bf16_t*)(ws + WS_GDNI + GI_KDT); const bf16_t* UTg = (const bf16_t*)(ws + WS_GDNI + GI_UT); const bf16_t* Ag = (const bf16_t*)(ws + WS_GDNI + GI_A);
    const bf16_t* GZ = (const bf16_t*)(ws + WS_GZ); bf16_t* OG = (bf16_t*)(ws + WS_OG); float* PART = (float*)(ws + WS_SSQ);
    const f32x4 gnj = *(const f32x4*)(a.in[I_GDNG] + dvg + 4 * fq);
    const float ealog = __expf(a.in[I_ALOG][h]), dtb = a.in[I_DTB][h];
    __syncthreads();
#define SCAN_LOAD(nn, WF, UV, AL, QF, AF, KF, ZV) do { const int cid_ = bh * NCH + (nn); const size_t gb_ = (size_t)cid_ * 8192; \
        _Pragma("unroll") for (int ks = 0; ks < 4; ++ks) { WF[ks] = *(const bf16x8*)(Wg + gb_ + (ct * 16 + fr) * 128 + ks * 32 + 8 * fq); QF[ks] = *(const bf16x8*)(QDg + gb_ + (ct * 16 + fr) * 128 + ks * 32 + 8 * fq); } \
        _Pragma("unroll") for (int ks = 0; ks < 2; ++ks) { AF[ks] = *(const bf16x8*)(Ag + (size_t)cid_ * 4096 + (ct * 16 + fr) * 64 + ks * 32 + 8 * fq); KF[ks] = *(const bf16x8*)(KDTg + gb_ + (wave * 16 + fr) * 64 + ks * 32 + 8 * fq); } \
        UV = *(const u32x2*)(UTg + gb_ + (dvg + fr) * 64 + ct * 16 + 4 * fq); \
        ZV = *(const u32x2*)(GZ + ((size_t)b * SEQ + (size_t)(nn) * CHUNK + ct * 16 + fr) * 512 + h * 128 + dvg + 4 * fq); \
        AL = ((const float*)(ws + WS_AB))[((size_t)b * SEQ + (size_t)(nn) * CHUNK + lane) * 8 + h]; } while (0)
#define SCAN_STEP(n, WF, UV, AL, QF, AF, KF, zv) do { \
        const LAS bf16_t* Sc = St + ((n) & 1) * 32 * ST_LD; LAS bf16_t* Sn = St + (((n) + 1) & 1) * 32 * ST_LD; \
        const size_t trow = (size_t)b * SEQ + (size_t)(n) * CHUNK + ct * 16 + fr; \
        const float gl = __expf(wave_sum(-ealog * softplusf_(AL + dtb))); \
          \
        { bf16x8 yb[4]; \
          _Pragma("unroll") for (int ks = 0; ks < 4; ++ks) yb[ks] = *(const LAS bf16x8*)(Sc + (tt * 16 + fr) * ST_LD + ks * 32 + 8 * fq); \
          __builtin_amdgcn_sched_barrier(0); \
          f32x4 d = (f32x4){0.f, 0.f, 0.f, 0.f}; \
          _Pragma("unroll") for (int ks = 0; ks < 4; ++ks) d = MFMA16(WF[ks], yb[ks], d); \
          __builtin_amdgcn_sched_barrier(0); \
          const float v0 = bflo(UV.x) - d[0], v1 = bfhi(UV.x) - d[1], v2 = bflo(UV.y) - d[2], v3 = bfhi(UV.y) - d[3]; \
          u32x2 w; w.x = cvt_pk_bf16(v0, v1); w.y = cvt_pk_bf16(v2, v3); \
          *(LAS u32x2*)(VNt + (tt * 16 + fr) * VN_LD + ct * 16 + 4 * fq) = w; } \
        LDS_BARRIER(); \
          \
        f32x4 od; float ss; \
        { bf16x8 xb[4], vb[2], yb3[2][2]; \
          _Pragma("unroll") for (int ks = 0; ks < 4; ++ks) xb[ks] = *(const LAS bf16x8*)(Sc + (tt * 16 + fr) * ST_LD + ks * 32 + 8 * fq); \
          _Pragma("unroll") for (int ks = 0; ks < 2; ++ks) vb[ks] = *(const LAS bf16x8*)(VNt + (tt * 16 + fr) * VN_LD + ks * 32 + 8 * fq); \
          _Pragma("unroll") for (int t = 0; t < 2; ++t) _Pragma("unroll") for (int ks = 0; ks < 2; ++ks) yb3[t][ks] = *(const LAS bf16x8*)(VNt + (t * 16 + fr) * VN_LD + ks * 32 + 8 * fq); \
          f32x4 dd[2]; dd[0] = sacc[0] * gl; dd[1] = sacc[1] * gl; \
          __builtin_amdgcn_sched_barrier(0); \
          f32x4 d = (f32x4){0.f, 0.f, 0.f, 0.f}; \
            \
          _Pragma("unroll") for (int ks = 0; ks < 4; ++ks) { d = MFMA16(xb[ks], QF[ks], d); if (ks < 2) { dd[0] = MFMA16(KF[ks], yb3[0][ks], dd[0]); dd[1] = MFMA16(KF[ks], yb3[1][ks], dd[1]); } } \
          _Pragma("unroll") for (int ks = 0; ks < 2; ++ks) d = MFMA16(vb[ks], AF[ks], d); \
          __builtin_amdgcn_sched_barrier(0); \
          od = d; ss = (d[0] * d[0] + d[1] * d[1]) + (d[2] * d[2] + d[3] * d[3]); \
          _Pragma("unroll") for (int t = 0; t < 2; ++t) { sacc[t] = dd[t]; \
              u32x2 w; w.x = cvt_pk_bf16_mfma(dd[t][0], dd[t][1]); w.y = cvt_pk_bf16_mfma(dd[t][2], dd[t][3]); \
              *(LAS u32x2*)(Sn + (t * 16 + fr) * ST_LD + wave * 16 + 4 * fq) = w; } } \
        ss += __shfl_xor(ss, 16); ss += __shfl_xor(ss, 32); \
        if (fq == 0) red[(ct * 2 + tt) * 16 + fr] = ss; \
        LDS_BARRIER(); \
          \
        if (tt == 0 && fq == 0) PART[(trow * 4 + h) * 4 + sl] = red[(ct * 2) * 16 + fr] + red[(ct * 2 + 1) * 16 + fr]; \
        { const float z0 = bflo(zv.x), z1 = bfhi(zv.x), z2 = bflo(zv.y), z3 = bfhi(zv.y); \
          const float o0 = od[0] * gnj[0] * (z0 * sigmoidf_(z0)), o1 = od[1] * gnj[1] * (z1 * sigmoidf_(z1)); \
          const float o2 = od[2] * gnj[2] * (z2 * sigmoidf_(z2)), o3 = od[3] * gnj[3] * (z3 * sigmoidf_(z3)); \
          u32x2 w; w.x = cvt_pk_bf16(o0, o1); w.y = cvt_pk_bf16(o2, o3); \
          *(u32x2*)(OG + trow * 512 + h * 128 + dvg + 4 * fq) = w; } } while (0)
#define SCAN_WAIT(nn) do { if (((nn) & 7) == 0) { const unsigned* fp_ = flags + bh * NCH + (nn) + (lane & 7); \
        while (!__all(__hip_atomic_load(fp_, __ATOMIC_RELAXED, __HIP_MEMORY_SCOPE_AGENT) != 0u)) __builtin_amdgcn_s_sleep(2); \
        __builtin_amdgcn_fence(__ATOMIC_ACQUIRE, "agent"); asm volatile("s_waitcnt vmcnt(0)" ::: "memory"); } } while (0)
    const unsigned* flags = (const unsigned*)(ws + WS_CTL) + 1024;
    bf16x8 wfA[4], wfB[4], qfA[4], afA[2], qfB[4], afB[2], kfA[2], kfB[2]; u32x2 uvA, uvB, zvA, zvB; float alA, alB;
    SCAN_WAIT(0);
    SCAN_LOAD(0, wfA, uvA, alA, qfA, afA, kfA, zvA);
    for (int n = 0; n < NCH; n += 2) {
        SCAN_LOAD(n + 1, wfB, uvB, alB, qfB, afB, kfB, zvB);
        SCAN_STEP(n, wfA, uvA, alA, qfA, afA, kfA, zvA);
        const int n2 = (n + 2 < NCH) ? n + 2 : NCH - 1;
        SCAN_WAIT(n2); SCAN_LOAD(n2, wfA, uvA, alA, qfA, afA, kfA, zvA);
        SCAN_STEP(n + 1, wfB, uvB, alB, qfB, afB, kfB, zvB);
    }
#undef SCAN_LOAD
#undef SCAN_STEP
#undef SCAN_WAIT
    __syncthreads();
}
__device__ __forceinline__ void gdn_norm_pass(const Args& a, int bx, int G) {
    bf16_t* OG = (bf16_t*)(a.ws + WS_OG); const float* PART = (const float*)(a.ws + WS_SSQ);
    for (size_t g = (size_t)bx * 512 + threadIdx.x; g < (size_t)TOK * 4 * 16; g += (size_t)G * 512) {
        const size_t pair = g >> 4; const int seg = (int)(g & 15);
        const f32x4 p = *(const f32x4*)(PART + pair * 4);
        const float rstd = rsqrtf(((p[0] + p[1]) + (p[2] + p[3])) * (1.f / HD) + EPS);
        u32x4* ptr = (u32x4*)(OG + pair * 128 + seg * 8); const u32x4 v = *ptr; u32x4 w;
#pragma unroll
        for (int e = 0; e < 4; ++e) w[e] = cvt_pk_bf16(bflo(v[e]) * rstd, bfhi(v[e]) * rstd);
        *ptr = w;
    }
}

constexpr int KS_LD = 136, VT_LD = 72;
__device__ __forceinline__ void sb_unit(const Args& a, LAS unsigned char* lds, int uid) {
    const int tid = threadIdx.x, lane = tid & 63, wave = __builtin_amdgcn_readfirstlane(tid >> 6), fr = lane & 15, fq = lane >> 4;
    const int qb = uid & 63, bh = uid >> 6, h = bh & 3, b = bh >> 2;
    const bf16_t* SQ = (const bf16_t*)(a.ws + WS_SQKV); bf16_t* OS = (bf16_t*)(a.ws + WS_OS);
    LAS bf16_t* Ks = (LAS bf16_t*)lds;
    LAS bf16_t* Vt = (LAS bf16_t*)(lds + 64 * KS_LD * 2);
    LAS int* flags = (LAS int*)(lds + 64 * KS_LD * 2 + 128 * VT_LD * 2);
    const int q0 = qb * 128, tq = q0 + wave * 16 + fr;
    const size_t brow = (size_t)b * SEQ;
    bf16x8 qf[4];
    {
        u32x4 raw[4]; float s = 0.f;
#pragma unroll
        for (int ks = 0; ks < 4; ++ks) { raw[ks] = *(const u32x4*)(SQ + (brow + tq) * 1536 + h * 128 + ks * 32 + 8 * fq);
#pragma unroll
            for (int e = 0; e < 4; ++e) { const float lo = bflo(raw[ks][e]), hi = bfhi(raw[ks][e]); s += lo * lo + hi * hi; } }
        s += __shfl_xor(s, 16); s += __shfl_xor(s, 32);
        const float rs = rsqrtf(s * (1.f / HD) + EPS) * 0.08838834764831845f;
#pragma unroll
        for (int ks = 0; ks < 4; ++ks) { const float* gp = a.in[I_SBQG] + ks * 32 + 8 * fq; u32x4 w;
#pragma unroll
            for (int e = 0; e < 4; ++e) w[e] = cvt_pk_bf16(bflo(raw[ks][e]) * rs * gp[2 * e], bfhi(raw[ks][e]) * rs * gp[2 * e + 1]);
            qf[ks] = __builtin_bit_cast(bf16x8, w); }
    }
    f32x4 oacc[8];
#pragma unroll
    for (int j = 0; j < 8; ++j) oacc[j] = (f32x4){0.f, 0.f, 0.f, 0.f};
    float carry = 0.f;
    for (int kt = qb * 2 + 1; kt >= 0; --kt) {
#pragma unroll
        for (int j = 0; j < 2; ++j) { const int task = tid + 512 * j, r = task >> 4, seg = task & 15;
            const bf16_t* kp = SQ + (brow + kt * 64 + r) * 1536 + 512 + h * 128 + seg * 8;
            const u32x4 kr = *(const u32x4*)kp;
            float s = 0.f;
#pragma unroll
            for (int e = 0; e < 4; ++e) { const float lo = bflo(kr[e]), hi = bfhi(kr[e]); s += lo * lo + hi * hi; }
            s += __shfl_xor(s, 1); s += __shfl_xor(s, 2); s += __shfl_xor(s, 4); s += __shfl_xor(s, 8);
            const float rs = rsqrtf(s * (1.f / HD) + EPS); const float* gp = a.in[I_SBKG] + seg * 8; u32x4 w;
#pragma unroll
            for (int e = 0; e < 4; ++e) w[e] = cvt_pk_bf16(bflo(kr[e]) * rs * gp[2 * e], bfhi(kr[e]) * rs * gp[2 * e + 1]);
            *(LAS u32x4*)(Ks + r * KS_LD + seg * 8) = w; }
#pragma unroll
        for (int j = 0; j < 2; ++j) { const int task = tid + 512 * j, r = task & 63, seg = task >> 6;
            const u32x4 vr = *(const u32x4*)(SQ + (brow + kt * 64 + r) * 1536 + 1024 + h * 128 + seg * 8);
            const int xt = r >> 4, kfq = (r & 15) >> 2, ii = r & 3, slot = (xt >> 1) * 32 + kfq * 8 + (xt & 1) * 4 + ii;
#pragma unroll
            for (int e = 0; e < 4; ++e) { Vt[(seg * 8 + 2 * e) * VT_LD + slot] = (bf16_t)(vr[e] & 0xffffu); Vt[(seg * 8 + 2 * e + 1) * VT_LD + slot] = (bf16_t)(vr[e] >> 16); } }
        __syncthreads();
        f32x4 z[4];
#pragma unroll
        for (int xt = 0; xt < 4; ++xt) { f32x4 d = (f32x4){0.f, 0.f, 0.f, 0.f};
#pragma unroll
            for (int ks = 0; ks < 4; ++ks) { const bf16x8 xf = *(const LAS bf16x8*)(Ks + (xt * 16 + fr) * KS_LD + ks * 32 + 8 * fq); d = MFMA16(xf, qf[ks], d); }
            z[xt] = d; }
        float s4[4], lsg[4][4]; bool val[4][4];
#pragma unroll
        for (int xt = 0; xt < 4; ++xt) { s4[xt] = 0.f;
#pragma unroll
            for (int i = 0; i < 4; ++i) { const int key = kt * 64 + xt * 16 + 4 * fq + i; val[xt][i] = key < tq;
                const float sp = softplusf_(z[xt][i]); const float l = val[xt][i] ? -sp : 0.f; lsg[xt][i] = z[xt][i] - sp; z[xt][i] = l; s4[xt] += l; } }
        float R[4], Hh[4];
#pragma unroll
        for (int xt = 0; xt < 4; ++xt) { const float v1 = __shfl_xor(s4[xt], 16), v2 = __shfl_xor(s4[xt], 32), v3 = __shfl_xor(s4[xt], 48);
            R[xt] = s4[xt] + v1 + v2 + v3;
            Hh[xt] = (((fq ^ 1) > fq) ? v1 : 0.f) + (((fq ^ 2) > fq) ? v2 : 0.f) + (((fq ^ 3) > fq) ? v3 : 0.f); }
        float above = carry;
        u32x4 pw[2];
#pragma unroll
        for (int xt = 3; xt >= 0; --xt) { const float base = above + Hh[xt];
            const float b3 = base, b2 = b3 + z[xt][3], b1 = b2 + z[xt][2], b0 = b1 + z[xt][1];
            const float p0 = val[xt][0] ? __expf(lsg[xt][0] + b0) : 0.f, p1 = val[xt][1] ? __expf(lsg[xt][1] + b1) : 0.f;
            const float p2 = val[xt][2] ? __expf(lsg[xt][2] + b2) : 0.f, p3 = val[xt][3] ? __expf(lsg[xt][3] + b3) : 0.f;
            pw[xt >> 1][(xt & 1) * 2] = cvt_pk_bf16(p0, p1); pw[xt >> 1][(xt & 1) * 2 + 1] = cvt_pk_bf16(p2, p3);
            above += R[xt]; }
        carry = above;
#pragma unroll
        for (int ks = 0; ks < 2; ++ks) { const bf16x8 pf = __builtin_bit_cast(bf16x8, pw[ks]);
#pragma unroll
            for (int dt = 0; dt < 8; ++dt) { const bf16x8 xf = *(const LAS bf16x8*)(Vt + (dt * 16 + fr) * VT_LD + ks * 32 + 8 * fq); oacc[dt] = MFMA16(xf, pf, oacc[dt]); } }
        const bool done = __all(carry < -110.0f);
        if (lane == 0) flags[wave] = done ? 1 : 0;
        __syncthreads();
        int alld = 1;
#pragma unroll
        for (int w = 0; w < 8; ++w) alld &= flags[w];
        if (alld) break;
        __syncthreads();
    }
#pragma unroll
    for (int dt = 0; dt < 8; ++dt) { u32x2 w; w.x = cvt_pk_bf16_mfma(oacc[dt][0], oacc[dt][1]); w.y = cvt_pk_bf16_mfma(oacc[dt][2], oacc[dt][3]);
        *(u32x2*)(OS + (brow + tq) * 512 + h * 128 + dt * 16 + 4 * fq) = w; }
    __syncthreads();
}

constexpr int MK_LD = 136, MV_LD = 264;
__device__ __forceinline__ void mem_unit(const Args& a, LAS unsigned char* lds, int uid) {
    const int tid = threadIdx.x, lane = tid & 63, wave = __builtin_amdgcn_readfirstlane(tid >> 6), fr = lane & 15, fq = lane >> 4;
    const int qb = uid & 31, bh = uid >> 5, h = bh & 3, b = bh >> 2;
    bf16_t* MQ = (bf16_t*)(a.ws + WS_MQ); const bf16_t* KV = (const bf16_t*)(a.ws + WS_MEMKV);
    {
        const unsigned* cnt = (const unsigned*)(a.ws + WS_CTL) + 128;
        while (__hip_atomic_load(cnt, __ATOMIC_RELAXED, __HIP_MEMORY_SCOPE_AGENT) < 16u) __builtin_amdgcn_s_sleep(8);
        __builtin_amdgcn_fence(__ATOMIC_ACQUIRE, "agent"); asm volatile("s_waitcnt vmcnt(0)" ::: "memory");
    }
    LAS bf16_t* Km = (LAS bf16_t*)lds;
    LAS bf16_t* Vt = (LAS bf16_t*)(lds + 256 * MK_LD * 2);
#pragma unroll
    for (int j = 0; j < 8; ++j) { const int task = tid + 512 * j, r = task >> 4, seg = task & 15;
        const bf16_t* kp = KV + (size_t)(b * NMEM + r) * 1024 + h * 128 + seg * 8;
        const u32x4 kr = *(const u32x4*)kp; const u32x4 vr = *(const u32x4*)(kp + 512);
        float s = 0.f;
#pragma unroll
        for (int e = 0; e < 4; ++e) { const float lo = bflo(kr[e]), hi = bfhi(kr[e]); s += lo * lo + hi * hi; }
        s += __shfl_xor(s, 1); s += __shfl_xor(s, 2); s += __shfl_xor(s, 4); s += __shfl_xor(s, 8);
        const float rs = rsqrtf(s * (1.f / HD) + EPS); const float* gp = a.in[I_MKG] + seg * 8; u32x4 w;
#pragma unroll
        for (int e = 0; e < 4; ++e) w[e] = cvt_pk_bf16(bflo(kr[e]) * rs * gp[2 * e], bfhi(kr[e]) * rs * gp[2 * e + 1]);
        *(LAS u32x4*)(Km + r * MK_LD + seg * 8) = w;
        const int xt = r >> 4, kfq = (r & 15) >> 2, ii = r & 3, slot = (xt >> 1) * 32 + kfq * 8 + (xt & 1) * 4 + ii;
#pragma unroll
        for (int e = 0; e < 4; ++e) { Vt[(seg * 8 + 2 * e) * MV_LD + slot] = (bf16_t)(vr[e] & 0xffffu); Vt[(seg * 8 + 2 * e + 1) * MV_LD + slot] = (bf16_t)(vr[e] >> 16); } }
    __syncthreads();
    for (int pass = 0; pass < 2; ++pass) {
        const size_t trow = (size_t)b * SEQ + qb * 256 + pass * 128 + wave * 16 + fr;
        bf16x8 qf[4];
        {
            u32x4 raw[4]; float s = 0.f;
#pragma unroll
            for (int ks = 0; ks < 4; ++ks) { raw[ks] = *(const u32x4*)(MQ + trow * 512 + h * 128 + ks * 32 + 8 * fq);
#pragma unroll
                for (int e = 0; e < 4; ++e) { const float lo = bflo(raw[ks][e]), hi = bfhi(raw[ks][e]); s += lo * lo + hi * hi; } }
            s += __shfl_xor(s, 16); s += __shfl_xor(s, 32);
            const float rs = rsqrtf(s * (1.f / HD) + EPS) * 0.08838834764831845f;
#pragma unroll
            for (int ks = 0; ks < 4; ++ks) { const float* gp = a.in[I_MQG] + ks * 32 + 8 * fq; u32x4 w;
#pragma unroll
                for (int e = 0; e < 4; ++e) w[e] = cvt_pk_bf16(bflo(raw[ks][e]) * rs * gp[2 * e], bfhi(raw[ks][e]) * rs * gp[2 * e + 1]);
                qf[ks] = __builtin_bit_cast(bf16x8, w); }
        }
        f32x4 z[16]; float mx = -3.0e38f;
#pragma unroll
        for (int xt = 0; xt < 16; ++xt) { f32x4 d = (f32x4){0.f, 0.f, 0.f, 0.f};
#pragma unroll
            for (int ks = 0; ks < 4; ++ks) { const bf16x8 xf = *(const LAS bf16x8*)(Km + (xt * 16 + fr) * MK_LD + ks * 32 + 8 * fq); d = MFMA16(xf, qf[ks], d); }
            z[xt] = d; mx = fmaxf(mx, fmaxf(fmaxf(d[0], d[1]), fmaxf(d[2], d[3]))); }
        mx = fmaxf(mx, __shfl_xor(mx, 16)); mx = fmaxf(mx, __shfl_xor(mx, 32));
        float sum = 0.f;
#pragma unroll
        for (int xt = 0; xt < 16; ++xt) {
#pragma unroll
            for (int i = 0; i < 4; ++i) { const float p = __expf(z[xt][i] - mx); z[xt][i] = p; sum += p; } }
        sum += __shfl_xor(sum, 16); sum += __shfl_xor(sum, 32);
        const float inv = 1.0f / sum;
        f32x4 oacc[8];
#pragma unroll
        for (int j = 0; j < 8; ++j) oacc[j] = (f32x4){0.f, 0.f, 0.f, 0.f};
#pragma unroll
        for (int ks = 0; ks < 8; ++ks) { u32x4 pw; pw.x = cvt_pk_bf16(z[2 * ks][0], z[2 * ks][1]); pw.y = cvt_pk_bf16(z[2 * ks][2], z[2 * ks][3]); pw.z = cvt_pk_bf16(z[2 * ks + 1][0], z[2 * ks + 1][1]); pw.w = cvt_pk_bf16(z[2 * ks + 1][2], z[2 * ks + 1][3]);
            const bf16x8 pf = __builtin_bit_cast(bf16x8, pw);
#pragma unroll
            for (int dt = 0; dt < 8; ++dt) { const bf16x8 xf = *(const LAS bf16x8*)(Vt + (dt * 16 + fr) * MV_LD + ks * 32 + 8 * fq); oacc[dt] = MFMA16(xf, pf, oacc[dt]); } }
#pragma unroll
        for (int dt = 0; dt < 8; ++dt) { u32x2 w; w.x = cvt_pk_bf16(oacc[dt][0] * inv, oacc[dt][1] * inv); w.y = cvt_pk_bf16(oacc[dt][2] * inv, oacc[dt][3] * inv);
            *(u32x2*)(MQ + trow * 512 + h * 128 + dt * 16 + 4 * fq) = w; }
    }
    __syncthreads();
}

__device__ __forceinline__ void l2_flush(const float* x, int bx, int tid, float* sink) {
    const f32x4* p = (const f32x4*)x + (size_t)bx * 32768 + tid;
    f32x4 a = (f32x4){0.f, 0.f, 0.f, 0.f};
#pragma unroll 8
    for (int i = 0; i < 64; ++i) a += p[(size_t)i * 512];
    if (a[0] + a[1] + a[2] + a[3] == 1.2345e38f) *sink = a[0];
}

#define XB_TMO      128
#define XB_XCNT(j)  (256  + 64 * (j))
#define XB_XSUB(j)  (1280 + 64 * (j))
#define XB_XGEN(j)  (2304 + 64 * (j))
#define XB_TOP      3328
#define XB_TOPGEN   3392
#define XCD_BAR_WORDS 3456
#define XB_SPIN_CAP (1u << 22)
__device__ __forceinline__ unsigned xb_ld(unsigned* p)              { return __hip_atomic_load(p, __ATOMIC_RELAXED, __HIP_MEMORY_SCOPE_AGENT); }
__device__ __forceinline__ unsigned xb_add(unsigned* p, unsigned v) { return __hip_atomic_fetch_add(p, v, __ATOMIC_RELAXED, __HIP_MEMORY_SCOPE_AGENT); }
__device__ __forceinline__ unsigned xb_xcc_id() { return (unsigned)__builtin_amdgcn_s_getreg((3 << 11) | 20) & 0xFu; }
#define XB_SPIN(cond, bar) do { unsigned _sp = 0; while (cond) { __builtin_amdgcn_s_sleep(1); \
    if ((++_sp & 255u) == 0u) { if (xb_ld(&(bar)[XB_TMO])) break; if (_sp > XB_SPIN_CAP) { atomicAdd(&(bar)[XB_TMO], 1u); break; } } } } while (0)
struct XcdBarrier { unsigned* bar; unsigned x; volatile LAS unsigned* st; };
__device__ __forceinline__ XcdBarrier xcd_barrier_post(unsigned* bar, volatile LAS unsigned* st) {
    XcdBarrier b; b.bar = bar; b.x = xb_xcc_id(); b.st = st;
    if (threadIdx.x == 0) (void)xb_add(&bar[XB_XCNT(b.x)], 1u);
    return b;
}
__device__ __forceinline__ void xcd_barrier_complete(unsigned* bar, unsigned x, unsigned& nloc, unsigned& nx) {
    const unsigned G = gridDim.x * gridDim.y * gridDim.z;
    unsigned sum, cnt, mine, sp = 0u;
    for (;;) {
        sum = 0u; cnt = 0u; mine = 0u;
#pragma unroll
        for (unsigned j = 0; j < 16; ++j) { const unsigned c = xb_ld(&bar[XB_XCNT(j)]); sum += c; cnt += (c > 0u) ? 1u : 0u; mine = (j == x) ? c : mine; }
        if (sum == G) break;
        __builtin_amdgcn_s_sleep(1);
        if ((++sp & 255u) == 0u) { if (xb_ld(&bar[XB_TMO])) break; if (sp > XB_SPIN_CAP) { atomicAdd(&bar[XB_TMO], 1u); break; } }
    }
    nloc = mine > 0u ? mine : 1u; nx = cnt > 0u ? cnt : 1u;
}
__device__ __forceinline__ void xcd_barrier(const XcdBarrier& b) {
    asm volatile("s_waitcnt vmcnt(0)" ::: "memory");
    __syncthreads();
    if (threadIdx.x == 0) {
        unsigned* bar = b.bar;
        __builtin_amdgcn_s_waitcnt(0);
        unsigned nloc = b.st[0], nx = b.st[1];
        if (nloc == 0u) { xcd_barrier_complete(bar, b.x, nloc, nx); b.st[0] = nloc; b.st[1] = nx; }
        const unsigned old = xb_add(&bar[XB_XSUB(b.x)], 1u);
        const unsigned gen = old / nloc;
        if (old + 1u == (gen + 1u) * nloc) {
            __builtin_amdgcn_fence(__ATOMIC_RELEASE, "agent");
            asm volatile("s_waitcnt vmcnt(0)" ::: "memory");
            const unsigned og = xb_add(&bar[XB_TOP], 1u);
            const unsigned tg = og / nx;
            if (og + 1u == (tg + 1u) * nx) xb_add(&bar[XB_TOPGEN], 1u);
            else XB_SPIN(xb_ld(&bar[XB_TOPGEN]) == tg, bar);
            __builtin_amdgcn_fence(__ATOMIC_ACQUIRE, "agent");
            xb_add(&bar[XB_XGEN(b.x)], 1u);
            asm volatile("s_waitcnt vmcnt(0)" ::: "memory");
        } else {
            XB_SPIN(xb_ld(&bar[XB_XGEN(b.x)]) == gen, bar);
            __builtin_amdgcn_fence(__ATOMIC_ACQUIRE, "agent");
            asm volatile("s_waitcnt vmcnt(0)" ::: "memory");
        }
    }
    __syncthreads();
}

__global__ void __launch_bounds__(512) fwd_megakernel(Args args) {
    extern __shared__ __attribute__((aligned(16))) unsigned char lds_raw[];
    LAS unsigned char* lds = (LAS unsigned char*)lds_raw;
    cg::grid_group grid = cg::this_grid();
    const int G = gridDim.x, bx = blockIdx.x, tid = threadIdx.x;
    const int vcu = (G % 8 == 0) ? (bx % 8) * (G / 8) + bx / 8 : bx;
    unsigned char* ws = args.ws;
    unsigned* ctl = (unsigned*)(ws + WS_CTL);
    LAS int* qslot = (LAS int*)(lds + LDS_BYTES - 64);
    volatile LAS unsigned* xbst = (volatile LAS unsigned*)(lds + LDS_BYTES - 32);
    if (tid < 2) xbst[tid] = 0u;
    __syncthreads();
    const XcdBarrier xbar = xcd_barrier_post(ctl + 4096, xbst);
    const int lo = args.ph_lo, hi = args.ph_hi;
#ifndef PH_MASK
#define PH_MASK 0x1ff
#endif
#ifdef TIME_MASK
    unsigned long long t_ph0 = 0;
#define PH_T0(k) do { if ((TIME_MASK >> (k)) & 1) t_ph0 = __builtin_amdgcn_s_memrealtime(); } while (0)
#define PH_T1(k) do { if ((TIME_MASK >> (k)) & 1) { const unsigned long long t1_ = __builtin_amdgcn_s_memrealtime(); const unsigned long long d_ = t1_ - t_ph0; while (__builtin_amdgcn_s_memrealtime() - t1_ < d_) __builtin_amdgcn_s_sleep(8); } } while (0)
#else
#define PH_T0(k) do { } while (0)
#define PH_T1(k) do { } while (0)
#endif
#define INR(k) (lo <= (k) && (k) < hi)
#define IN(k) (((PH_MASK >> (k)) & 1) && INR(k))
#define SEAM(k) do { if (INR(k) && INR((k) + 1)) xcd_barrier(xbar); } while (0)
    if (lo < 0) {
        asm volatile("s_waitcnt vmcnt(0)" ::: "memory"); grid.sync(); __builtin_amdgcn_fence(__ATOMIC_ACQUIRE, "agent"); asm volatile("s_waitcnt vmcnt(0)" ::: "memory"); }

    PH_T0(0); if (IN(0)) phase0(args, lds, vcu, G);
    SEAM(0); PH_T1(0);
#ifdef TEST_GEMM
    if (IN(1)) {
        EpiP7 E{(const bf16_t*)(ws + WS_H), args.out};
        SchedGrid S{(const char*)(ws + WS_H), (const char*)(ws + WS_WO), TOK / 256, DM / 256, G, bx, (size_t)256 * 1024 * 2};
        pg8::gemm_phase<EpiP7, SchedGrid, true, true>(lds, 1024, S, E);
    }
#endif
#ifdef TEST_GEMM
    if (false) {
#else
    PH_T0(1); if (IN(1)) {
#endif
        EpiP1 E{(bf16_t*)args.out, (bf16_t*)(ws + WS_GZ), (bf16_t*)(ws + WS_SQKV), (bf16_t*)(ws + WS_MQ), (bf16_t*)(ws + WS_GATES), (bf16_t*)(ws + WS_MEMKV), 0};
        SchedGrid S{(const char*)(ws + WS_H), (const char*)(ws + WS_WIN), TOK / 256, 16, G, bx, (size_t)256 * 1024 * 2};
        pg8::gemm_phase<EpiP1, SchedGrid, true, true>(lds, 1024, S, E);
    }
    SEAM(1); PH_T1(1);
    PH_T0(3); if (IN(3)) {
#ifdef TIME_SCAN
        if (bx < NB * NH * 4) { const unsigned long long t0_ = __builtin_amdgcn_s_memrealtime(); gdn_scan_unit(args, lds, bx); const unsigned long long t1_ = __builtin_amdgcn_s_memrealtime(); while (__builtin_amdgcn_s_memrealtime() - t1_ < (t1_ - t0_)) __builtin_amdgcn_s_sleep(8); }
#else
        if (bx < NB * NH * 4) gdn_scan_unit(args, lds, bx);
        else { const int nprep = G - NB * NH * 4;
            int pend = -1;
            for (int u = bx - NB * NH * 4; u < NB * NH * NCH; u += nprep) { const int cid = (u & 15) * NCH + (u >> 4);
                gdn_prep_unit(args, lds, cid);
                const bool flush = (pend >= 0) || (u + nprep >= NB * NH * NCH) || (u < 2 * nprep);
                if (flush) { if (tid == 0) { __builtin_amdgcn_fence(__ATOMIC_RELEASE, "agent"); asm volatile("s_waitcnt vmcnt(0)" ::: "memory");
                        if (pend >= 0) __hip_atomic_store(ctl + 1024 + pend, 1u, __ATOMIC_RELAXED, __HIP_MEMORY_SCOPE_AGENT);
                        __hip_atomic_store(ctl + 1024 + cid, 1u, __ATOMIC_RELAXED, __HIP_MEMORY_SCOPE_AGENT); } pend = -1; }
                else pend = cid; }
            if (bx - NB * NH * 4 < 16) {
                EpiP1 E2{(bf16_t*)args.out, (bf16_t*)(ws + WS_GZ), (bf16_t*)(ws + WS_SQKV), (bf16_t*)(ws + WS_MQ), (bf16_t*)(ws + WS_GATES), (bf16_t*)(ws + WS_MEMKV), 1};
                SchedGrid S2{(const char*)(ws + WS_MEMN), (const char*)(ws + WS_WMKV), 4, 4, G, bx - NB * NH * 4, (size_t)256 * 1024 * 2};
                pg8::gemm_phase<EpiP1, SchedGrid, true, true>(lds, 1024, S2, E2);
                asm volatile("s_waitcnt vmcnt(0)" ::: "memory"); __syncthreads();
                if (tid == 0) { __builtin_amdgcn_fence(__ATOMIC_RELEASE, "agent"); asm volatile("s_waitcnt vmcnt(0)" ::: "memory");
                    __hip_atomic_fetch_add(ctl + 128, 1u, __ATOMIC_RELAXED, __HIP_MEMORY_SCOPE_AGENT); }
            }
        }
#endif
        for (;;) {
            if (tid == 0) *qslot = (int)atomicAdd(ctl + 64, 1u);
            __syncthreads();
            const int it = *qslot;
            __syncthreads();
            if (it >= 1024 + 512) break;
            if (it < 1024) sb_unit(args, lds, it); else mem_unit(args, lds, it - 1024);
        }
    }
    SEAM(3); PH_T1(3);
    PH_T0(4); if (IN(4)) {
        gdn_norm_pass(args, bx, G);
        EpiP1 E{(bf16_t*)args.out, (bf16_t*)(ws + WS_GZ), (bf16_t*)(ws + WS_SQKV), (bf16_t*)(ws + WS_MQ), (bf16_t*)(ws + WS_GATES), (bf16_t*)(ws + WS_MEMKV), 2};
        SchedGrid S{(const char*)(ws + WS_H), (const char*)(ws + WS_WIN) + (size_t)4096 * 1024 * 2, TOK / 256, 12, G, bx, (size_t)256 * 1024 * 2};
        pg8::gemm_phase<EpiP1, SchedGrid, true, true>(lds, 1024, S, E);
    }
    SEAM(4); PH_T1(4);
    PH_T0(5); if (IN(5)) {
        EpiP3 E{(const bf16_t*)(ws + WS_GATES), (float*)(ws + WS_MIXF + (size_t)bx * 262144), (bf16_t*)(ws + WS_MIX)};
        SchedBranch S{(const char*)(ws + WS_OG), (const char*)(ws + WS_OS), (const char*)(ws + WS_MQ), (const char*)(ws + WS_WBR), G, bx, (size_t)256 * 512 * 2};
        pg8::gemm_phase<EpiP3, SchedBranch, true, true>(lds, 512, S, E);
    }
    SEAM(5); PH_T1(5);
    PH_T0(6); if (IN(6)) {
        EpiP4 E{args.in[I_X], args.out, (bf16_t*)(ws + WS_X1B), (float*)(ws + WS_SSQ)};
        SchedGrid S{(const char*)(ws + WS_MIX), (const char*)(ws + WS_WO), TOK / 256, DM / 256, G, bx, (size_t)256 * 1024 * 2};
        pg8::gemm_phase<EpiP4, SchedGrid, true, true>(lds, 1024, S, E);
    }
    SEAM(6); PH_T1(6);
    PH_T0(7); if (IN(7)) {
        EpiP6 E{(const float*)(ws + WS_SSQ), (bf16_t*)(ws + WS_ACT)};
        SchedGrid S{(const char*)(ws + WS_X1B), (const char*)(ws + WS_WUP), TOK / 256, DFF / 256, G, bx, (size_t)256 * 1024 * 2};
        pg8::gemm_phase<EpiP6, SchedGrid, true, true>(lds, 1024, S, E);
    }
    SEAM(7); PH_T1(7);
    PH_T0(8); if (IN(8)) {
#ifdef P7_VIA_WS
        EpiP7 E{(const bf16_t*)(ws + WS_X1B), (float*)(ws + 46 * MiB)};
#else
        EpiP7 E{(const bf16_t*)(ws + WS_X1B), args.out};
#endif
#ifdef TEST_P7
        E.x1b = (const bf16_t*)(ws + TEST_A);
        SchedGrid S{(const char*)(ws + TEST_A), (const char*)(ws + WS_WO), TOK / 256, DM / 256, G, bx, (size_t)256 * 1024 * 2};
        pg8::gemm_phase<EpiP7, SchedGrid, true, true>(lds, 1024, S, E);
#else
        SchedGrid S{(const char*)(ws + WS_ACT), (const char*)(ws + WS_WDN), TOK / 256, DM / 256, G, bx, (size_t)256 * 4096 * 2};
        pg8::gemm_phase<EpiP7, SchedGrid, true, true>(lds, 4096, S, E);
#endif
    }
#ifdef P7_VIA_WS
    { asm volatile("s_waitcnt vmcnt(0)" ::: "memory"); grid.sync(); __builtin_amdgcn_fence(__ATOMIC_ACQUIRE, "agent"); asm volatile("s_waitcnt vmcnt(0)" ::: "memory");
      const f32x4* src = (const f32x4*)(ws + 46 * MiB); f32x4* dst = (f32x4*)args.out;
      for (size_t i = (size_t)bx * 512 + tid; i < (size_t)TOK * DM / 4; i += (size_t)G * 512) dst[i] = src[i]; }
#endif
    asm volatile("s_waitcnt vmcnt(0)" ::: "memory"); __syncthreads();
    if (tid == 0) { __builtin_amdgcn_fence(__ATOMIC_RELEASE, "agent"); asm volatile("s_waitcnt vmcnt(0)" ::: "memory"); }
#ifdef DUMP_OFF
    if (lo == 0) { asm volatile("s_waitcnt vmcnt(0)" ::: "memory"); grid.sync(); __builtin_amdgcn_fence(__ATOMIC_ACQUIRE, "agent"); asm volatile("s_waitcnt vmcnt(0)" ::: "memory"); }
    if (lo == 100 || lo == 0) {
        const unsigned* src = (const unsigned*)(ws + (size_t)DUMP_OFF);
        { const int xcd = bx & 7, k = bx >> 3, pmt = xcd * 16 + (k >> 1), half = k & 1;
          const size_t base = ((size_t)pmt * 256 + (size_t)half * 128) * 512;
          for (int j = tid; j < 128 * 512; j += 512) { const size_t i = base + j; const unsigned u = src[i]; args.out[2 * i] = bflo(u); args.out[2 * i + 1] = bfhi(u); } }
    }
    asm volatile("s_waitcnt vmcnt(0)" ::: "memory"); __syncthreads();
    if (tid == 0) { __builtin_amdgcn_fence(__ATOMIC_RELEASE, "agent"); asm volatile("s_waitcnt vmcnt(0)" ::: "memory"); }
#endif
#undef IN
#undef SEAM
}

#ifndef MK_N_LAUNCHES
#define MK_N_LAUNCHES 1
#endif
extern "C" void kernel_launch(void* const* d_in, const int* in_sizes, int n_in, void* d_out, int out_size, void* d_ws, size_t ws_size, hipStream_t stream) {
    static int grid = 0;
    if (grid == 0) {
        if (n_in != 21 || out_size != TOK * DM || ws_size < WS_END) { fprintf(stderr, "kernel_launch: unexpected shapes (n_in %d, out %d, ws %zu)\n", n_in, out_size, ws_size); grid = -1; return; }
        int dev = 0, cus = 0, per_cu = 0;
        hipGetDevice(&dev); hipDeviceGetAttribute(&cus, hipDeviceAttributeMultiprocessorCount, dev);
        hipFuncSetAttribute((const void*)fwd_megakernel, hipFuncAttributeMaxDynamicSharedMemorySize, LDS_BYTES);
        hipOccupancyMaxActiveBlocksPerMultiprocessor(&per_cu, (const void*)fwd_megakernel, 512, LDS_BYTES);
        (void)hipGetLastError();
        if (per_cu < 1) { fprintf(stderr, "kernel_launch: occupancy query says %d workgroups per CU\n", per_cu); per_cu = 1; }
        grid = cus;
    }
    if (grid < 0) return;
    hipMemsetAsync((char*)d_ws + WS_CTL, 0, 32768, stream);
    Args a{};
    for (int i = 0; i < 21; ++i) a.in[i] = (const float*)d_in[i];
    a.out = (float*)d_out; a.ws = (unsigned char*)d_ws;
#if MK_N_LAUNCHES == 1
#ifdef DUMP_OFF
    a.ph_lo = 0; a.ph_hi = DUMP_AFTER + 1;
#elif defined(TEST_GEMM)
    a.ph_lo = 0; a.ph_hi = 2;
#else
    a.ph_lo = 0; a.ph_hi = 9;
#endif
    void* kargs[] = {&a};
    hipError_t e = hipLaunchCooperativeKernel((const void*)fwd_megakernel, dim3(grid), dim3(512), kargs, LDS_BYTES, stream);
    if (e != hipSuccess) fprintf(stderr, "cooperative launch failed: %s (grid %d)\n", hipGetErrorString(e), grid);
#else
#ifdef DUMP_OFF
    for (int p = 0; p <= DUMP_AFTER; ++p) { a.ph_lo = p; a.ph_hi = p + 1; hipLaunchKernelGGL(fwd_megakernel, dim3(grid), dim3(512), LDS_BYTES, stream, a); }
    a.ph_lo = 100; a.ph_hi = 101; hipLaunchKernelGGL(fwd_megakernel, dim3(grid), dim3(512), LDS_BYTES, stream, a);
#else
    for (int p = 0; p < 9; ++p) { a.ph_lo = p; a.ph_hi = p + 1; hipLaunchKernelGGL(fwd_megakernel, dim3(grid), dim3(512), LDS_BYTES, stream, a); }
#endif
#endif
}
```

```cpp
#include <hip/hip_runtime.h>
#include <hip/hip_cooperative_groups.h>
#include <cstdio>
#include <cstdint>
namespace cg = cooperative_groups;

#define LAS __attribute__((address_space(3)))
typedef unsigned short bf16_t;
typedef short bf16x8 __attribute__((ext_vector_type(8)));
typedef float f32x4 __attribute__((ext_vector_type(4)));
typedef float f32x2 __attribute__((ext_vector_type(2)));
typedef unsigned u32x4 __attribute__((ext_vector_type(4)));
typedef unsigned u32x2 __attribute__((ext_vector_type(2)));

constexpr int DM = 1024, NB = 4, SEQ = 8192, TOK = NB * SEQ;
constexpr int NH = 4, HD = 128, BW = 512;
constexpr int CHUNK = 64, NCH = SEQ / CHUNK;
constexpr int NMEM = 256, DFF = 4096, DIN = 7176, NPROJ = 7168;
constexpr float EPS = 1e-6f;

constexpr size_t MiB = 1u << 20;
constexpr size_t WS_CTL = 0;
constexpr size_t WS_WIN = 1 * MiB;
constexpr size_t WS_WMKV = 15 * MiB;
constexpr size_t WS_WBR = 17 * MiB;
constexpr size_t WS_WO = 20 * MiB;
constexpr size_t WS_WUP = 22 * MiB;
constexpr size_t WS_WDN = 30 * MiB;
constexpr size_t WS_MEMN = 38 * MiB;
constexpr size_t WS_MEMKV = 40 * MiB;
constexpr size_t WS_AB = 42 * MiB;
constexpr size_t WS_SSQ = 43 * MiB;
constexpr size_t WS_GL = 45 * MiB;
constexpr size_t WS_H = 46 * MiB;
constexpr size_t WS_GDNI = 110 * MiB;
constexpr size_t GI_W = 0, GI_QD = 32 * MiB, GI_KDT = 64 * MiB, GI_UT = 96 * MiB, GI_A = 128 * MiB;
constexpr size_t WS_GZ = 254 * MiB;
constexpr size_t WS_GQKV = 286 * MiB;
constexpr size_t WS_OG = 318 * MiB;
constexpr size_t WS_OS = 350 * MiB;
constexpr size_t WS_SQKV = 382 * MiB;
constexpr size_t WS_MQ = 478 * MiB;
constexpr size_t WS_GATES = 110 * MiB;
constexpr size_t WS_MIXF = 382 * MiB;
constexpr size_t WS_MIX = 46 * MiB;
constexpr size_t WS_X1B = 110 * MiB;
constexpr size_t WS_ACT = 174 * MiB;
constexpr size_t WS_END = 510 * MiB;

constexpr int LDS_BYTES = 147456;

typedef __bf16 bf16x2_t __attribute__((ext_vector_type(2)));
__device__ __forceinline__ unsigned cvt_pk_bf16_mfma(float lo, float hi) { f32x2 v = {lo, hi}; bf16x2_t b = __builtin_convertvector(v, bf16x2_t); return __builtin_bit_cast(unsigned, b); }
__device__ __forceinline__ unsigned cvt_pk_bf16(float lo, float hi) { unsigned r; asm volatile("v_cvt_pk_bf16_f32 %0, %1, %2" : "=v"(r) : "v"(lo), "v"(hi)); return r; }
__device__ __forceinline__ float bflo(unsigned u) { return __uint_as_float(u << 16); }
__device__ __forceinline__ float bfhi(unsigned u) { return __uint_as_float(u & 0xffff0000u); }
__device__ __forceinline__ float wave_sum(float v) {
#pragma unroll
    for (int o = 1; o < 64; o <<= 1) v += __shfl_xor(v, o);
    return v;
}
__device__ __forceinline__ float sigmoidf_(float x) { return 1.0f / (1.0f + __expf(-x)); }
__device__ __forceinline__ float softplusf_(float x) { return fmaxf(x, 0.f) + __logf(1.0f + __expf(-fabsf(x))); }
__device__ __forceinline__ u32x2 ld8_agent(const void* p) { const unsigned long long v = __hip_atomic_load((const unsigned long long*)p, __ATOMIC_RELAXED, __HIP_MEMORY_SCOPE_AGENT); u32x2 r; r.x = (unsigned)v; r.y = (unsigned)(v >> 32); return r; }
#define MFMA16(x, y, c) __builtin_amdgcn_mfma_f32_16x16x32_bf16((x), (y), (c), 0, 0, 0)
#define LDS_WAIT() asm volatile("s_waitcnt lgkmcnt(0)" ::: "memory")
#define LDS_BARRIER() do { asm volatile("s_waitcnt lgkmcnt(0)" ::: "memory"); __builtin_amdgcn_s_barrier(); asm volatile("" ::: "memory"); } while (0)

namespace pg8 {
constexpr int BM = 256, BK = 64, HALF = 128, HTB = HALF * BK * 2, STAGE_BYTES = 8 * HTB, NXCD = 8, WGM = 8;
__host__ __device__ __forceinline__ int lds_byte(int r, int c) { const int st = (r >> 4) * 2 + (c >> 5), rr = r & 15, cc = c & 31, ob = rr * 64 + cc * 2; return st * 1024 + (ob ^ (((ob >> 9) & 1) << 5)); }
__host__ __device__ __forceinline__ void stage_rc(int b, int& R, int& C) { const int st = b / 1024, sb = b % 1024, swz = sb ^ (((sb >> 9) & 1) << 5); R = (st >> 1) * 16 + swz / 64; C = (st & 1) * 32 + (swz % 64) / 2; }
__host__ __device__ __forceinline__ int perm32(int rho) { const int n = rho >> 4, i = rho & 15; return 8 * (i >> 2) + 4 * n + (i & 3); }

struct Unit { int pm, pn, kind; const char* A; const char* B; };

__device__ __forceinline__ bool tile_order(int nM, int nN, int G, int c, int i, int& pm, int& pn) {
    const int nwg = nM * nN; const long L = (long)i * G + c; if (L >= nwg) return false;
    int wgid = (int)L; { const int q = nwg / NXCD, r = nwg % NXCD, xcd = wgid % NXCD, off = wgid / NXCD; wgid = (xcd < r ? xcd * (q + 1) : r * (q + 1) + (xcd - r) * q) + off; }
    const int nig = WGM * nN, gid = wgid / nig, fm = gid * WGM, gsz = (nM - fm) < WGM ? (nM - fm) : WGM;
    pm = fm + ((wgid % nig) % gsz); pn = (wgid % nig) / gsz; return true;
}

template <class Epi, class Sched, bool ALIGN_EPI, bool SP2>
__device__ __forceinline__ void gemm_phase(LAS unsigned char* lds, const int K, const Sched& S, const Epi& E) {
    const int tid = threadIdx.x, wid = __builtin_amdgcn_readfirstlane(tid >> 6), lane = tid & 63, wr = wid >> 2, wc = wid & 3, fr = lane & 15, fq = lane >> 4;
    const int nt = K / BK;
    unsigned voffA[2], voffB[2];
#pragma unroll
    for (int i = 0; i < 2; ++i) { int R, C; stage_rc(tid * 16 + i * 8192, R, C); const int Rb = Epi::PERM ? ((R & ~31) + perm32(R & 31)) : R;
        voffA[i] = (unsigned)(R * K + C) * 2u; voffB[i] = (unsigned)(Rb * K + C) * 2u; }
    const size_t kstep = (size_t)(BK * 2);
    const size_t hstep = (size_t)HALF * K * 2;
    const unsigned ldsw = (unsigned)wid * 1024u;
    const int aoff = lds_byte(wr * 64 + fr, fq * 8), boff = lds_byte(wc * 32 + fr, fq * 8);
#define PG8_SA(b, h) (((b) * 2 + (h)) * HTB)
#define PG8_SB(b, h) ((4 + (b) * 2 + (h)) * HTB)
#define PG8_STAGE(bufoff, gbase, voff) do { _Pragma("unroll") for (int _i = 0; _i < 2; ++_i) \
        __builtin_amdgcn_global_load_lds((const unsigned*)((const char*)(gbase) + (voff)[_i]), (LAS unsigned*)(lds + (bufoff) + ldsw + _i * 8192), 16, 0, 0); } while (0)
#define PG8_LDA(dst, b, h) do { _Pragma("unroll") for (int m = 0; m < 4; ++m) _Pragma("unroll") for (int k = 0; k < 2; ++k) dst[m][k] = *(const LAS bf16x8*)(lds + PG8_SA(b, h) + aoff + m * 2048 + k * 1024); } while (0)
#define PG8_LDB(dst, b, h) do { _Pragma("unroll") for (int n = 0; n < 2; ++n) _Pragma("unroll") for (int k = 0; k < 2; ++k) dst[n][k] = *(const LAS bf16x8*)(lds + PG8_SB(b, h) + boff + n * 2048 + k * 1024); } while (0)
#define PG8_MMA(ai, bj, At, Bt) do { __builtin_amdgcn_s_setprio(1); _Pragma("unroll") for (int m = 0; m < 4; ++m) _Pragma("unroll") for (int n = 0; n < 2; ++n) _Pragma("unroll") for (int k = 0; k < 2; ++k) \
        acc[ai][bj][m][n] = __builtin_amdgcn_mfma_f32_16x16x32_bf16(Bt[n][k], At[m][k], acc[ai][bj][m][n], 0, 0, 0); __builtin_amdgcn_s_setprio(0); } while (0)
#define PG8_WAIT_V(n) asm volatile("s_waitcnt vmcnt(" #n ")" ::: "memory")
#define PG8_WAIT_L(n) asm volatile("s_waitcnt lgkmcnt(" #n ")" ::: "memory")
#define PG8_BAR __builtin_amdgcn_s_barrier()
#define PG8_SCHED __builtin_amdgcn_sched_barrier(0)
    Unit cur, nxt; int ui = 0;
    if (!S.next(0, cur)) return;
    f32x4 acc[2][2][4][2];
#pragma unroll
    for (int a = 0; a < 2; ++a)
#pragma unroll
        for (int b = 0; b < 2; ++b)
#pragma unroll
            for (int m = 0; m < 4; ++m)
#pragma unroll
                for (int n = 0; n < 2; ++n) acc[a][b][m][n] = (f32x4){0.f, 0.f, 0.f, 0.f};
    bf16x8 At[4][2], B0[2][2], B1[2][2];
    const char* cA = cur.A; const char* cB = cur.B;
    if constexpr (SP2) {
        PG8_STAGE(PG8_SB(0, 0), cB, voffB); PG8_STAGE(PG8_SB(0, 1), cB + hstep, voffB); PG8_STAGE(PG8_SA(0, 0), cA, voffA); PG8_STAGE(PG8_SA(0, 1), cA + hstep, voffA);
        if (wr == 1) PG8_BAR;
        PG8_WAIT_V(2); PG8_BAR;
        PG8_STAGE(PG8_SB(1, 0), cB + kstep, voffB); PG8_STAGE(PG8_SA(1, 0), cA + kstep, voffA); PG8_STAGE(PG8_SB(1, 1), cB + hstep + kstep, voffB);
        PG8_WAIT_V(6); PG8_BAR;
    } else {
        PG8_STAGE(PG8_SB(0, 0), cB, voffB); PG8_STAGE(PG8_SA(0, 0), cA, voffA); PG8_STAGE(PG8_SB(0, 1), cB + hstep, voffB); PG8_STAGE(PG8_SA(0, 1), cA + hstep, voffA);
        if (wr == 1) PG8_BAR;
        PG8_WAIT_V(4); PG8_BAR;
        PG8_STAGE(PG8_SB(1, 0), cB + kstep, voffB); PG8_STAGE(PG8_SA(1, 0), cA + kstep, voffA); PG8_STAGE(PG8_SB(1, 1), cB + hstep + kstep, voffB);
        PG8_WAIT_V(6); PG8_BAR;
    }
    for (;;) {
        const bool has_next = S.next(ui + 1, nxt);
        const char* nA = has_next ? nxt.A : cA; const char* nB = has_next ? nxt.B : cB;
        for (int t = 0; t < nt; t += 2) {
            const bool last = (t == nt - 2);
            const char* a1 = cA + (size_t)(t + 1) * kstep;
            const char* a2 = last ? nA : cA + (size_t)(t + 2) * kstep; const char* b2 = last ? nB : cB + (size_t)(t + 2) * kstep;
            const char* a3 = a2 + kstep; const char* b3 = b2 + kstep;
            if constexpr (SP2) {
            PG8_LDB(B0, 0, 0); PG8_LDB(B1, 0, 1); PG8_SCHED; PG8_LDA(At, 0, 0); PG8_STAGE(PG8_SA(1, 1), a1 + hstep, voffA);
            PG8_WAIT_V(8); PG8_WAIT_L(0); PG8_BAR; PG8_MMA(0, 0, At, B0); PG8_MMA(0, 1, At, B1); PG8_BAR; PG8_SCHED;
            PG8_LDA(At, 0, 1); PG8_STAGE(PG8_SB(0, 0), b2, voffB); PG8_STAGE(PG8_SB(0, 1), b2 + hstep, voffB); PG8_STAGE(PG8_SA(0, 0), a2, voffA);
            PG8_WAIT_V(8); PG8_WAIT_L(0); PG8_BAR; PG8_MMA(1, 0, At, B0); PG8_MMA(1, 1, At, B1); PG8_BAR; PG8_SCHED;
            PG8_LDB(B0, 1, 0); PG8_LDB(B1, 1, 1); PG8_SCHED; PG8_LDA(At, 1, 0); PG8_STAGE(PG8_SA(0, 1), a2 + hstep, voffA);
            PG8_WAIT_V(8); PG8_WAIT_L(0); PG8_BAR; PG8_MMA(0, 0, At, B0); PG8_MMA(0, 1, At, B1); PG8_BAR; PG8_SCHED;
            PG8_LDA(At, 1, 1); PG8_STAGE(PG8_SB(1, 0), b3, voffB); PG8_STAGE(PG8_SB(1, 1), b3 + hstep, voffB); PG8_STAGE(PG8_SA(1, 0), a3, voffA);
            PG8_WAIT_V(8); PG8_WAIT_L(0); PG8_BAR; PG8_MMA(1, 0, At, B0); PG8_MMA(1, 1, At, B1); PG8_BAR; PG8_SCHED;
            } else {
            PG8_LDB(B0, 0, 0); PG8_SCHED; PG8_LDA(At, 0, 0); PG8_STAGE(PG8_SA(1, 1), a1 + hstep, voffA);
            PG8_WAIT_L(8); PG8_BAR; PG8_WAIT_L(0); PG8_MMA(0, 0, At, B0); PG8_BAR; PG8_SCHED;
            PG8_LDB(B1, 0, 1); PG8_STAGE(PG8_SB(0, 0), b2, voffB);
            PG8_BAR; PG8_WAIT_L(0); PG8_MMA(0, 1, At, B1); PG8_BAR;
            PG8_LDA(At, 0, 1); PG8_STAGE(PG8_SA(0, 0), a2, voffA);
            PG8_BAR; PG8_WAIT_L(0); PG8_MMA(1, 0, At, B0); PG8_BAR; PG8_SCHED;
            PG8_STAGE(PG8_SB(0, 1), b2 + hstep, voffB);
            PG8_WAIT_V(6); PG8_BAR; PG8_MMA(1, 1, At, B1); PG8_BAR;
            PG8_LDB(B0, 1, 0); PG8_SCHED; PG8_LDA(At, 1, 0); PG8_STAGE(PG8_SA(0, 1), a2 + hstep, voffA);
            PG8_WAIT_L(8); PG8_BAR; PG8_WAIT_L(0); PG8_MMA(0, 0, At, B0); PG8_BAR; PG8_SCHED;
            PG8_LDB(B1, 1, 1); PG8_STAGE(PG8_SB(1, 0), b3, voffB);
            PG8_BAR; PG8_WAIT_L(0); PG8_MMA(0, 1, At, B1); PG8_BAR;
            PG8_LDA(At, 1, 1); PG8_STAGE(PG8_SA(1, 0), a3, voffA);
            PG8_BAR; PG8_WAIT_L(0); PG8_MMA(1, 0, At, B0); PG8_BAR; PG8_SCHED;
            PG8_STAGE(PG8_SB(1, 1), b3 + hstep, voffB);
            PG8_WAIT_V(6); PG8_BAR; PG8_MMA(1, 1, At, B1); PG8_BAR;
            }
        }
        if constexpr (ALIGN_EPI) { if (wr == 0) PG8_BAR; }
        E(acc, cur, wr, wc, fr, fq);
        if (!has_next) break;
#pragma unroll
        for (int a = 0; a < 2; ++a)
#pragma unroll
            for (int b = 0; b < 2; ++b)
#pragma unroll
                for (int m = 0; m < 4; ++m)
#pragma unroll
                    for (int n = 0; n < 2; ++n) acc[a][b][m][n] = (f32x4){0.f, 0.f, 0.f, 0.f};
        cur = nxt; cA = nA; cB = nB; ++ui;
        if constexpr (ALIGN_EPI) { if (wr == 1) PG8_BAR; }
    }
    PG8_WAIT_V(0);
    if constexpr (!ALIGN_EPI) { if (wr == 0) PG8_BAR; }
    PG8_BAR;
#undef PG8_SA
#undef PG8_SB
#undef PG8_STAGE
#undef PG8_LDA
#undef PG8_LDB
#undef PG8_MMA
#undef PG8_WAIT_V
#undef PG8_WAIT_L
#undef PG8_BAR
#undef PG8_SCHED
}
}

struct Args {
    const float* in[21];
    float* out; unsigned char* ws;
    int ph_lo, ph_hi;
};
enum { I_X = 0, I_MEM, I_N1G, I_WIN, I_CONVW, I_ALOG, I_DTB, I_GDNG, I_SBQG, I_SBKG, I_MEMNG, I_WMKV, I_MQG, I_MKG, I_WBRG, I_WBRS, I_WBRM, I_WO, I_N2G, I_WUP, I_WDN };

struct SchedGrid {
    const char* A; const char* B; int nM, nN, G, c; size_t tstep;
    __device__ __forceinline__ bool next(int i, pg8::Unit& u) const {
        if (!pg8::tile_order(nM, nN, G, c, i, u.pm, u.pn)) return false;
        u.kind = 0; u.A = A + (size_t)u.pm * tstep; u.B = B + (size_t)u.pn * tstep; return true;
    }
};
struct SchedBranch {
    const char* A0; const char* A1; const char* A2; const char* B; int G, c; size_t tstep;
    __device__ __forceinline__ bool next(int i, pg8::Unit& u) const {
        const int t = i / 3, br = i - 3 * t;
        if (!pg8::tile_order(TOK / 256, DM / 256, G, c, t, u.pm, u.pn)) return false;
        u.kind = br; u.A = (br == 0 ? A0 : (br == 1 ? A1 : A2)) + (size_t)u.pm * tstep; u.B = B + (size_t)br * ((size_t)DM * BW * 2) + (size_t)u.pn * tstep; return true;
    }
};

struct EpiP1 {
    static constexpr bool PERM = true;
    bf16_t* gqkv; bf16_t* gz; bf16_t* sqkv; bf16_t* mq; bf16_t* gates; bf16_t* memkv; int is_mem;
    __device__ __forceinline__ void operator()(const f32x4 (&acc)[2][2][4][2], const pg8::Unit& u, int wr, int wc, int fr, int fq) const {
        bf16_t* base; int ldc, c0; bool sig = false; const int pn = u.pn;
        if (is_mem == 1) { base = memkv; ldc = 1024; c0 = pn * 256; }
        else if (is_mem == 2) { base = gates; ldc = 3072; c0 = pn * 256; sig = true; }
        else if (pn < 6) { base = gqkv; ldc = 1536; c0 = pn * 256; }
        else if (pn < 8) { base = gz; ldc = 512; c0 = (pn - 6) * 256; }
        else if (pn < 14) { base = sqkv; ldc = 1536; c0 = (pn - 8) * 256; }
        else { base = mq; ldc = 512; c0 = (pn - 14) * 256; }
        const int row0 = u.pm * 256 + wr * 64 + fr, col0 = c0 + wc * 32 + 8 * fq;
#pragma unroll
        for (int ai = 0; ai < 2; ++ai)
#pragma unroll
            for (int m = 0; m < 4; ++m) { bf16_t* rowp = base + (size_t)(row0 + ai * 128 + m * 16) * ldc + col0;
#pragma unroll
                for (int bj = 0; bj < 2; ++bj) { f32x4 v0 = acc[ai][bj][m][0], v1 = acc[ai][bj][m][1];
                    if (sig) {
#pragma unroll
                        for (int e = 0; e < 4; ++e) { v0[e] = sigmoidf_(v0[e]); v1[e] = sigmoidf_(v1[e]); } }
                    u32x4 w; w.x = cvt_pk_bf16_mfma(v0[0], v0[1]); w.y = cvt_pk_bf16_mfma(v0[2], v0[3]); w.z = cvt_pk_bf16_mfma(v1[0], v1[1]); w.w = cvt_pk_bf16_mfma(v1[2], v1[3]);
                    *(u32x4*)(rowp + bj * 128) = w; } }
    }
};
struct EpiP3 {
    static constexpr bool PERM = true;
    const bf16_t* gates; float* priv; bf16_t* mix;
    __device__ __forceinline__ void operator()(const f32x4 (&acc)[2][2][4][2], const pg8::Unit& u, int wr, int wc, int fr, int fq) const {
        const int br = u.kind; int opq; asm volatile("v_mov_b32 %0, 0" : "=v"(opq));
        const unsigned row0 = (unsigned)(u.pm * 256 + wr * 64 + fr + opq), col0 = (unsigned)(u.pn * 256 + wc * 32 + 8 * fq);
        const unsigned goff0 = row0 * 3072u + (unsigned)br * 1024u + col0, moff0 = row0 * 1024u + col0;
        u32x4* pv = (u32x4*)priv + threadIdx.x + opq;
        if (br > 0) asm volatile("s_waitcnt vmcnt(0)" ::: "memory");
#pragma unroll
        for (int ai = 0; ai < 2; ++ai)
#pragma unroll
            for (int m = 0; m < 4; ++m) {
#pragma unroll
                for (int bj = 0; bj < 2; ++bj) {
                    const u32x4 g = *(const u32x4*)(gates + (goff0 + (unsigned)((ai * 128 + m * 16) * 3072 + bj * 128)));
                    f32x4 v0 = acc[ai][bj][m][0], v1 = acc[ai][bj][m][1];
                    v0[0] *= bflo(g.x); v0[1] *= bfhi(g.x); v0[2] *= bflo(g.y); v0[3] *= bfhi(g.y);
                    v1[0] *= bflo(g.z); v1[1] *= bfhi(g.z); v1[2] *= bflo(g.w); v1[3] *= bfhi(g.w);
                    const int ri = (ai * 2 + bj) * 4 + m;
                    if (br > 0) { const u32x4 p = pv[ri * 512];
                        v0[0] += bflo(p.x); v0[1] += bfhi(p.x); v0[2] += bflo(p.y); v0[3] += bfhi(p.y);
                        v1[0] += bflo(p.z); v1[1] += bfhi(p.z); v1[2] += bflo(p.w); v1[3] += bfhi(p.w); }
                    u32x4 w; w.x = cvt_pk_bf16(v0[0], v0[1]); w.y = cvt_pk_bf16(v0[2], v0[3]); w.z = cvt_pk_bf16(v1[0], v1[1]); w.w = cvt_pk_bf16(v1[2], v1[3]);
                    if (br < 2) pv[ri * 512] = w;
                    else *(u32x4*)(mix + (moff0 + (unsigned)((ai * 128 + m * 16) * 1024 + bj * 128))) = w; }
                asm volatile("" ::: "memory"); }
    }
};
struct EpiP4 {
    static constexpr bool PERM = true;
    const float* x; float* out; bf16_t* x1b; float* ssq;
    __device__ __forceinline__ void operator()(const f32x4 (&acc)[2][2][4][2], const pg8::Unit& u, int wr, int wc, int fr, int fq) const {
        int opq; asm volatile("v_mov_b32 %0, 0" : "=v"(opq));
        const unsigned row0 = (unsigned)(u.pm * 256 + wr * 64 + fr + opq), col0 = (unsigned)(u.pn * 256 + wc * 32 + 8 * fq);
#pragma unroll
        for (int ai = 0; ai < 2; ++ai)
#pragma unroll
            for (int m = 0; m < 4; ++m) { const unsigned row = row0 + ai * 128 + m * 16; float s = 0.f;
#pragma unroll
                for (int bj = 0; bj < 2; ++bj) { const unsigned off = row * 1024u + col0 + bj * 128;
#ifdef P4_MINIMAL
                    const f32x4 o0 = acc[ai][bj][m][0], o1 = acc[ai][bj][m][1];
#else
                    const f32x4 o0 = *(const f32x4*)(x + off) + acc[ai][bj][m][0], o1 = *(const f32x4*)(x + off + 4) + acc[ai][bj][m][1];
#endif
                    s += (o0[0] * o0[0] + o0[1] * o0[1]) + (o0[2] * o0[2] + o0[3] * o0[3]) + (o1[0] * o1[0] + o1[1] * o1[1]) + (o1[2] * o1[2] + o1[3] * o1[3]);
                    u32x4 w; w.x = cvt_pk_bf16(o0[0], o0[1]); w.y = cvt_pk_bf16(o0[2], o0[3]); w.z = cvt_pk_bf16(o1[0], o1[1]); w.w = cvt_pk_bf16(o1[2], o1[3]);
                    *(u32x4*)(x1b + off) = w; }
#ifndef NO_SSQ
                s += __shfl_xor(s, 16); s += __shfl_xor(s, 32);
                if (fq == 0) ssq[(size_t)u.pn * (TOK * 4) + row * 4 + wc] = s;
#endif
                asm volatile("" ::: "memory"); }
    }
};
struct EpiP6 {
    static constexpr bool PERM = true;
    const float* ssq; bf16_t* act;
    __device__ __forceinline__ void operator()(const f32x4 (&acc)[2][2][4][2], const pg8::Unit& u, int wr, int wc, int fr, int fq) const {
        const int row0 = u.pm * 256 + wr * 64 + fr, col0 = u.pn * 256 + wc * 32 + 8 * fq;
#pragma unroll
        for (int ai = 0; ai < 2; ++ai)
#pragma unroll
            for (int m = 0; m < 4; ++m) { const size_t row = (size_t)(row0 + ai * 128 + m * 16);
                const f32x4 p = *(const f32x4*)(ssq + (size_t)fq * (TOK * 4) + row * 4); float s = (p[0] + p[1]) + (p[2] + p[3]);
                s += __shfl_xor(s, 16); s += __shfl_xor(s, 32);
                const float rstd = rsqrtf(s * (1.0f / DM) + EPS);
#pragma unroll
                for (int bj = 0; bj < 2; ++bj) { f32x4 v0 = acc[ai][bj][m][0] * rstd, v1 = acc[ai][bj][m][1] * rstd;
#pragma unroll
                    for (int e = 0; e < 4; ++e) { const float a = fmaxf(v0[e], 0.f), b = fmaxf(v1[e], 0.f); v0[e] = a * a; v1[e] = b * b; }
                    u32x4 w; w.x = cvt_pk_bf16(v0[0], v0[1]); w.y = cvt_pk_bf16(v0[2], v0[3]); w.z = cvt_pk_bf16(v1[0], v1[1]); w.w = cvt_pk_bf16(v1[2], v1[3]);
                    *(u32x4*)(act + row * 4096 + col0 + bj * 128) = w; } }
    }
};
struct EpiP7 {
    static constexpr bool PERM = false;
    const bf16_t* x1b; float* out;
    __device__ __forceinline__ void operator()(const f32x4 (&acc)[2][2][4][2], const pg8::Unit& u, int wr, int wc, int fr, int fq) const {
        int opq; asm volatile("v_mov_b32 %0, 0" : "=v"(opq));
        const unsigned row0 = (unsigned)(u.pm * 256 + wr * 64 + fr + opq), col0 = (unsigned)(u.pn * 256 + wc * 32 + 4 * fq);
#pragma unroll
        for (int ai = 0; ai < 2; ++ai)
#pragma unroll
            for (int m = 0; m < 4; ++m) { const unsigned row = row0 + ai * 128 + m * 16;
#pragma unroll
                for (int bj = 0; bj < 2; ++bj)
#pragma unroll
                    for (int n = 0; n < 2; ++n) { const unsigned off = row * 1024u + col0 + bj * 128 + n * 16;
                        const u32x2 xb = *(const u32x2*)(x1b + off);
                        f32x4 o = acc[ai][bj][m][n];
#ifndef P7_NOX
                        o[0] += bflo(xb.x); o[1] += bfhi(xb.x); o[2] += bflo(xb.y); o[3] += bfhi(xb.y);
#endif
                        *(f32x4*)(out + off) = o; }
                asm volatile("" ::: "memory"); }
    }
};

__device__ __forceinline__ void p0_transpose_item(const float* W, int K, int ldw, int N, bf16_t* WT, const float* kscale, int skip_at, LAS float* scr, int item, int lane) {
    const int nblk = N / 32, kb = item / nblk, nb = item % nblk, k0 = 64 * kb, n0 = 32 * nb;
    const int src0 = n0 + (n0 >= skip_at ? 8 : 0);
#pragma unroll 8
    for (int i = 0; i < 32; ++i) { const int kk = 2 * i + (lane >> 5); float v = W[(size_t)(k0 + kk) * ldw + src0 + (lane & 31)]; if (kscale) v *= kscale[k0 + kk]; scr[kk * 33 + (lane & 31)] = v; }
    LDS_WAIT(); asm volatile("" ::: "memory");
    const int c = lane & 7;
#pragma unroll
    for (int j = 0; j < 4; ++j) { const int n = (lane >> 3) + 8 * j; const LAS float* s = scr + (8 * c) * 33 + n;
        u32x4 o; o.x = cvt_pk_bf16(s[0 * 33], s[1 * 33]); o.y = cvt_pk_bf16(s[2 * 33], s[3 * 33]); o.z = cvt_pk_bf16(s[4 * 33], s[5 * 33]); o.w = cvt_pk_bf16(s[6 * 33], s[7 * 33]);
        *(u32x4*)(WT + (size_t)(n0 + n) * K + k0 + 8 * c) = o; }
    LDS_WAIT(); asm volatile("" ::: "memory");
}

__device__ __forceinline__ void phase0(const Args& a, LAS unsigned char* lds, int vcu, int G) {
    const int tid = threadIdx.x, lane = tid & 63, wave = __builtin_amdgcn_readfirstlane(tid >> 6);
    unsigned char* ws = a.ws;
    LAS float* wab = (LAS float*)(lds + 8 * 8448);
    for (int e = tid; e < 8192; e += 512) wab[e] = a.in[I_WIN][(size_t)(e >> 3) * DIN + 2048 + (e & 7)];
    LAS float* scr = (LAS float*)(lds + wave * 8448);
    const int gw = vcu * 8 + wave, NGW = G * 8;
    constexpr int I_IN = 16 * 224, I_MKV = 16 * 32, I_BR = 8 * 32, I_O = 16 * 32, I_UP = 16 * 128, I_DN = 64 * 32;
    constexpr int NITEMS = I_IN + I_MKV + 3 * I_BR + I_O + I_UP + I_DN;
    for (int it = gw; it < NITEMS; it += NGW) {
        int r = it;
        if (r < I_IN) { p0_transpose_item(a.in[I_WIN], 1024, DIN, NPROJ, (bf16_t*)(ws + WS_WIN), nullptr, 2048, scr, r, lane); continue; } r -= I_IN;
        if (r < I_MKV) { p0_transpose_item(a.in[I_WMKV], 1024, 1024, 1024, (bf16_t*)(ws + WS_WMKV), nullptr, 1 << 30, scr, r, lane); continue; } r -= I_MKV;
        if (r < I_BR) { p0_transpose_item(a.in[I_WBRG], 512, 1024, 1024, (bf16_t*)(ws + WS_WBR), nullptr, 1 << 30, scr, r, lane); continue; } r -= I_BR;
        if (r < I_BR) { p0_transpose_item(a.in[I_WBRS], 512, 1024, 1024, (bf16_t*)(ws + WS_WBR) + (size_t)DM * BW, nullptr, 1 << 30, scr, r, lane); continue; } r -= I_BR;
        if (r < I_BR) { p0_transpose_item(a.in[I_WBRM], 512, 1024, 1024, (bf16_t*)(ws + WS_WBR) + (size_t)2 * DM * BW, nullptr, 1 << 30, scr, r, lane); continue; } r -= I_BR;
        if (r < I_O) { p0_transpose_item(a.in[I_WO], 1024, 1024, 1024, (bf16_t*)(ws + WS_WO), nullptr, 1 << 30, scr, r, lane); continue; } r -= I_O;
        if (r < I_UP) { p0_transpose_item(a.in[I_WUP], 1024, 4096, 4096, (bf16_t*)(ws + WS_WUP), a.in[I_N2G], 1 << 30, scr, r, lane); continue; } r -= I_UP;
        p0_transpose_item(a.in[I_WDN], 4096, 1024, 1024, (bf16_t*)(ws + WS_WDN), nullptr, 1 << 30, scr, r, lane);
    }
    __syncthreads();
    const float* g1 = a.in[I_N1G]; bf16_t* H = (bf16_t*)(ws + WS_H); float* AB = (float*)(ws + WS_AB);
    f32x4 gv[4];
#pragma unroll
    for (int j = 0; j < 4; ++j) gv[j] = *(const f32x4*)(g1 + 256 * j + 4 * lane);
    for (int m = gw; m < TOK; m += NGW) {
        const f32x4* xr = (const f32x4*)(a.in[I_X] + (size_t)m * DM) + lane;
        f32x4 v[4]; float s = 0.f;
#pragma unroll
        for (int j = 0; j < 4; ++j) { v[j] = xr[64 * j]; s += (v[j].x * v[j].x + v[j].y * v[j].y) + (v[j].z * v[j].z + v[j].w * v[j].w); }
        const float rstd = rsqrtf(wave_sum(s) * (1.f / DM) + EPS);
        float p[8];
#pragma unroll
        for (int c = 0; c < 8; ++c) p[c] = 0.f;
        u32x2* o8 = (u32x2*)(H + (size_t)m * DM) + lane;
#pragma unroll
        for (int j = 0; j < 4; ++j) { v[j] = v[j] * rstd * gv[j];
            u32x2 w; w.x = cvt_pk_bf16(v[j].x, v[j].y); w.y = cvt_pk_bf16(v[j].z, v[j].w); o8[64 * j] = w;
#pragma unroll
            for (int e = 0; e < 4; ++e) { const LAS f32x4* wp = (const LAS f32x4*)(wab + (256 * j + 4 * lane + e) * 8); const f32x4 w0 = wp[0], w1 = wp[1]; const float hv = v[j][e];
                p[0] += hv * w0.x; p[1] += hv * w0.y; p[2] += hv * w0.z; p[3] += hv * w0.w; p[4] += hv * w1.x; p[5] += hv * w1.y; p[6] += hv * w1.z; p[7] += hv * w1.w; } }
#pragma unroll
        for (int c = 0; c < 8; ++c) p[c] = wave_sum(p[c]);
        if (lane == 0) { f32x4* ab = (f32x4*)(AB + (size_t)m * 8); ab[0] = (f32x4){p[0], p[1], p[2], p[3]}; ab[1] = (f32x4){p[4], p[5], p[6], p[7]}; }
    }
    const float* gm = a.in[I_MEMNG]; bf16_t* MN = (bf16_t*)(ws + WS_MEMN);
#pragma unroll
    for (int j = 0; j < 4; ++j) gv[j] = *(const f32x4*)(gm + 256 * j + 4 * lane);
    for (int m = gw; m < NB * NMEM; m += NGW) {
        const f32x4* xr = (const f32x4*)(a.in[I_MEM] + (size_t)m * DM) + lane;
        f32x4 v[4]; float s = 0.f;
#pragma unroll
        for (int j = 0; j < 4; ++j) { v[j] = xr[64 * j]; s += (v[j].x * v[j].x + v[j].y * v[j].y) + (v[j].z * v[j].z + v[j].w * v[j].w); }
        const float rstd = rsqrtf(wave_sum(s) * (1.f / DM) + EPS);
        u32x2* o8 = (u32x2*)(MN + (size_t)m * DM) + lane;
#pragma unroll
        for (int j = 0; j < 4; ++j) { v[j] = v[j] * rstd * gv[j]; u32x2 w; w.x = cvt_pk_bf16(v[j].x, v[j].y); w.y = cvt_pk_bf16(v[j].z, v[j].w); o8[64 * j] = w; }
    }
}

constexpr int PQ_LD = 136;
__device__ __forceinline__ void gdn_prep_unit(const Args& a, LAS unsigned char* lds, int cid) {
    const int tid = threadIdx.x, lane = tid & 63, wave = __builtin_amdgcn_readfirstlane(tid >> 6), fr = lane & 15, fq = lane >> 4;
    unsigned char* ws = a.ws;
    const int n = cid & (NCH - 1), bh = cid >> 7, h = bh & 3, b = bh >> 2;
    const size_t row0 = (size_t)b * SEQ + (size_t)n * CHUNK;
    LAS bf16_t* Qb = (LAS bf16_t*)lds;
    LAS bf16_t* Kb = (LAS bf16_t*)(lds + 17408);
    LAS float* Kf = (LAS float*)(lds + 34816);
    LAS float* Vf = (LAS float*)(lds + 34816 + 32768);
    LAS float* Lm = (LAS float*)(lds + 34816 + 65536);
    LAS float* gcs = (LAS float*)(lds + 34816 + 65536 + 16384);
    LAS float* bet = gcs + 64;
    LAS float* bge = gcs + 128;
    const bf16_t* GQ = (const bf16_t*)a.out;
    if (wave == 0) {
        const float* AB = (const float*)(ws + WS_AB) + (row0 + lane) * 8;
        const float al = AB[h], bl = AB[4 + h];
        float g = -__expf(a.in[I_ALOG][h]) * softplusf_(al + a.in[I_DTB][h]);
#pragma unroll
        for (int o = 1; o < 64; o <<= 1) { const float t = __shfl_up(g, o); if (lane >= o) g += t; }
        const float be = sigmoidf_(bl);
        gcs[lane] = g; bet[lane] = be; bge[lane] = be * __expf(g);
        { const float gle = __expf(__shfl(g, 63)); if (lane < 32) ((float*)(ws + WS_GL))[cid * 32 + lane] = gle; }
    }
    {
        const float* cw = a.in[I_CONVW];
        float wq[4][2], wk[4][2], wv[4][2];
#pragma unroll
        for (int j = 0; j < 4; ++j) { const float* p = cw + j * 1536 + h * 128 + 2 * lane; wq[j][0] = p[0]; wq[j][1] = p[1]; wk[j][0] = p[512]; wk[j][1] = p[513]; wv[j][0] = p[1024]; wv[j][1] = p[1025]; }
        unsigned rq[11], rk[11], rv[11];
#pragma unroll
        for (int i = 0; i < 11; ++i) { const int rr = wave * 8 + i - 3; const bool ok = (n > 0) || (rr >= 0);
            const bf16_t* p = GQ + (row0 + rr) * 1536 + h * 128 + 2 * lane;
            rq[i] = ok ? *(const unsigned*)p : 0u; rk[i] = ok ? *(const unsigned*)(p + 512) : 0u; rv[i] = ok ? *(const unsigned*)(p + 1024) : 0u; }
#pragma unroll
        for (int i = 0; i < 8; ++i) { const int r = wave * 8 + i;
            float q0 = 0.f, q1 = 0.f, k0 = 0.f, k1 = 0.f, v0 = 0.f, v1 = 0.f;
#pragma unroll
            for (int j = 0; j < 4; ++j) { q0 += wq[j][0] * bflo(rq[i + j]); q1 += wq[j][1] * bfhi(rq[i + j]); k0 += wk[j][0] * bflo(rk[i + j]); k1 += wk[j][1] * bfhi(rk[i + j]);
                v0 += wv[j][0] * bflo(rv[i + j]); v1 += wv[j][1] * bfhi(rv[i + j]); }
            q0 *= sigmoidf_(q0); q1 *= sigmoidf_(q1); k0 *= sigmoidf_(k0); k1 *= sigmoidf_(k1); v0 *= sigmoidf_(v0); v1 *= sigmoidf_(v1);
            const float qn = rsqrtf(wave_sum(q0 * q0 + q1 * q1) + EPS) * 0.08838834764831845f, kn = rsqrtf(wave_sum(k0 * k0 + k1 * k1) + EPS);
            q0 *= qn; q1 *= qn; k0 *= kn; k1 *= kn;
            *(LAS unsigned*)(Qb + r * PQ_LD + 2 * lane) = cvt_pk_bf16(q0, q1);
            *(LAS unsigned*)(Kb + r * PQ_LD + 2 * lane) = cvt_pk_bf16(k0, k1);
            *(LAS f32x2*)(Kf + r * 128 + 2 * lane) = (f32x2){k0, k1};
            *(LAS f32x2*)(Vf + r * 128 + 2 * lane) = (f32x2){v0, v1}; }
    }
    __syncthreads();
    {
        const int mat = wave >> 2, ct = wave & 3;
        const LAS bf16_t* Xb = mat ? Qb : Kb;
        bf16x8 xf[4];
#pragma unroll
        for (int ks = 0; ks < 4; ++ks) xf[ks] = *(const LAS bf16x8*)(Xb + (ct * 16 + fr) * PQ_LD + ks * 32 + 8 * fq);
        bf16_t* Ag = (bf16_t*)(ws + WS_GDNI + GI_A) + (size_t)cid * 4096;
#pragma unroll
        for (int st = 0; st < 4; ++st) {
            f32x4 d = (f32x4){0.f, 0.f, 0.f, 0.f};
#pragma unroll
            for (int ks = 0; ks < 4; ++ks) { const bf16x8 yf = *(const LAS bf16x8*)(Kb + (st * 16 + fr) * PQ_LD + ks * 32 + 8 * fq); d = MFMA16(xf[ks], yf, d); }
            const int s = st * 16 + fr; const float gs = gcs[s];
#pragma unroll
            for (int i = 0; i < 4; ++i) { const int c = ct * 16 + 4 * fq + i; const float dec = __expf(fminf(gcs[c] - gs, 0.f));
                if (mat == 0) Lm[c * 64 + s] = (c > s) ? bet[c] * d[i] * dec : 0.f;
                else Ag[c * 64 + s] = (bf16_t)(cvt_pk_bf16((c >= s) ? d[i] * dec : 0.f, 0.f) & 0xffffu); }
        }
    }
    __syncthreads();
    const size_t gbase = (size_t)cid * 8192;
    if (wave < 4) {
        const int col = (wave & 1) * 64 + lane; const bool isw = wave >= 2;
        const LAS float* src = isw ? Kf : Vf; const LAS float* scl = isw ? bge : bet;
        float xv[64]; int opq; asm volatile("v_mov_b32 %0, 0" : "=v"(opq));
        const LAS float* Lmv = Lm + opq;
#pragma unroll
        for (int i = 0; i < 64; ++i) xv[i] = 0.f;
#pragma unroll
        for (int i = 0; i < 64; ++i) {
            float r0 = src[i * 128 + col] * scl[i], r1 = 0.f, r2 = 0.f, r3 = 0.f;
#pragma unroll
            for (int j4 = 0; j4 < (i + 3) / 4; ++j4) { const f32x4 lv = *(const LAS f32x4*)(Lmv + i * 64 + 4 * j4);
                r0 -= lv.x * xv[4 * j4]; r1 -= lv.y * xv[4 * j4 + 1]; r2 -= lv.z * xv[4 * j4 + 2]; r3 -= lv.w * xv[4 * j4 + 3]; }
            xv[i] = (r0 + r1) + (r2 + r3);
        }
        if (!isw) {
            u32x4* up = (u32x4*)((bf16_t*)(ws + WS_GDNI + GI_UT) + gbase + (size_t)col * 64);
#pragma unroll
            for (int j = 0; j < 8; ++j) { u32x4 w; w.x = cvt_pk_bf16(xv[8 * j], xv[8 * j + 1]); w.y = cvt_pk_bf16(xv[8 * j + 2], xv[8 * j + 3]); w.z = cvt_pk_bf16(xv[8 * j + 4], xv[8 * j + 5]); w.w = cvt_pk_bf16(xv[8 * j + 6], xv[8 * j + 7]); up[j] = w; }
        } else {
            bf16_t* wp = (bf16_t*)(ws + WS_GDNI + GI_W) + gbase + col;
#pragma unroll
            for (int i = 0; i < 64; ++i) wp[i * 128] = (bf16_t)(cvt_pk_bf16(xv[i], 0.f) & 0xffffu);
        }
    } else {
        const int t = tid - 256; const float gl = gcs[63];
        bf16_t* qd = (bf16_t*)(ws + WS_GDNI + GI_QD) + gbase; bf16_t* kdt = (bf16_t*)(ws + WS_GDNI + GI_KDT) + gbase;
#pragma unroll
        for (int j = 0; j < 4; ++j) { const int task = t + 256 * j, c = task >> 4, seg = task & 15; const float e = __expf(gcs[c]);
            const u32x4 qv = *(const LAS u32x4*)(Qb + c * PQ_LD + seg * 8);
            u32x4 w; w.x = cvt_pk_bf16(bflo(qv.x) * e, bfhi(qv.x) * e); w.y = cvt_pk_bf16(bflo(qv.y) * e, bfhi(qv.y) * e); w.z = cvt_pk_bf16(bflo(qv.z) * e, bfhi(qv.z) * e); w.w = cvt_pk_bf16(bflo(qv.w) * e, bfhi(qv.w) * e);
            *(u32x4*)(qd + c * 128 + seg * 8) = w; }
#pragma unroll
        for (int j = 0; j < 4; ++j) { const int task = t + 256 * j, dk = task & 127, c8 = task >> 7; float v[8];
#pragma unroll
            for (int e = 0; e < 8; ++e) { const int c = c8 * 8 + e; v[e] = Kf[c * 128 + dk] * __expf(gl - gcs[c]); }
            u32x4 w; w.x = cvt_pk_bf16(v[0], v[1]); w.y = cvt_pk_bf16(v[2], v[3]); w.z = cvt_pk_bf16(v[4], v[5]); w.w = cvt_pk_bf16(v[6], v[7]);
            *(u32x4*)(kdt + dk * 64 + c8 * 8) = w; }
    }
    asm volatile("s_waitcnt vmcnt(0)" ::: "memory"); __syncthreads();
}

constexpr int ST_LD = 136, VN_LD = 72;
__device__ __forceinline__ void gdn_scan_unit(const Args& a, LAS unsigned char* lds, int unit) {
    const int tid = threadIdx.x, lane = tid & 63, wave = __builtin_amdgcn_readfirstlane(tid >> 6), fr = lane & 15, fq = lane >> 4;
    unsigned char* ws = a.ws;
    const int bh = unit >> 2, sl = unit & 3, h = bh & 3, b = bh >> 2;
    LAS bf16_t* St = (LAS bf16_t*)lds;
    LAS bf16_t* VNt = (LAS bf16_t*)(lds + 2 * 32 * ST_LD * 2);
    LAS float* red = (LAS float*)(lds + 2 * 32 * ST_LD * 2 + 32 * VN_LD * 2);
    for (int e = tid; e < 32 * ST_LD / 2; e += 512) ((LAS unsigned*)St)[e] = 0u;
    f32x4 sacc[2];
    sacc[0] = (f32x4){0.f, 0.f, 0.f, 0.f}; sacc[1] = sacc[0];
    const int ct = wave >> 1, tt = wave & 1;
    const int dvg = sl * 32 + tt * 16;
    const bf16_t* Wg = (const bf16_t*)(ws + WS_GDNI + GI_W); const bf16_t* QDg = (const bf16_t*)(ws + WS_GDNI + GI_QD);
    const bf16_t* KDTg = (const bf16_t*)(ws + WS_GDNI + GI_KDT); const bf16_t* UTg = (const bf16_t*)(ws + WS_GDNI + GI_UT); const bf16_t* Ag = (const bf16_t*)(ws + WS_GDNI + GI_A);
    const bf16_t* GZ = (const bf16_t*)(ws + WS_GZ); bf16_t* OG = (bf16_t*)(ws + WS_OG); float* PART = (float*)(ws + WS_SSQ);
    const f32x4 gnj = *(const f32x4*)(a.in[I_GDNG] + dvg + 4 * fq);
    __syncthreads();
#define SCAN_LOAD(nn, WF, UV, AL, QF, AF, KF, ZV) do { const int cid_ = bh * NCH + (nn); const size_t gb_ = (size_t)cid_ * 8192; \
        _Pragma("unroll") for (int ks = 0; ks < 4; ++ks) { WF[ks] = *(const bf16x8*)(Wg + gb_ + (ct * 16 + fr) * 128 + ks * 32 + 8 * fq); QF[ks] = *(const bf16x8*)(QDg + gb_ + (ct * 16 + fr) * 128 + ks * 32 + 8 * fq); } \
        _Pragma("unroll") for (int ks = 0; ks < 2; ++ks) { AF[ks] = *(const bf16x8*)(Ag + (size_t)cid_ * 4096 + (ct * 16 + fr) * 64 + ks * 32 + 8 * fq); KF[ks] = *(const bf16x8*)(KDTg + gb_ + (wave * 16 + fr) * 64 + ks * 32 + 8 * fq); } \
        UV = *(const u32x2*)(UTg + gb_ + (dvg + fr) * 64 + ct * 16 + 4 * fq); \
        ZV = *(const u32x2*)(GZ + ((size_t)b * SEQ + (size_t)(nn) * CHUNK + ct * 16 + fr) * 512 + h * 128 + dvg + 4 * fq); \
        AL = ((const float*)(ws + WS_GL))[cid_ * 32]; } while (0)
#define SCAN_STEP(n, WF, UV, AL, QF, AF, KF, zv) do { \
        const LAS bf16_t* Sc = St + ((n) & 1) * 32 * ST_LD; LAS bf16_t* Sn = St + (((n) + 1) & 1) * 32 * ST_LD; \
        const size_t trow = (size_t)b * SEQ + (size_t)(n) * CHUNK + ct * 16 + fr; \
        const float gl = AL; \
          \
        { bf16x8 yb[4]; \
          _Pragma("unroll") for (int ks = 0; ks < 4; ++ks) yb[ks] = *(const LAS bf16x8*)(Sc + (tt * 16 + fr) * ST_LD + ks * 32 + 8 * fq); \
          __builtin_amdgcn_sched_barrier(0); \
          f32x4 d = (f32x4){0.f, 0.f, 0.f, 0.f}; \
          _Pragma("unroll") for (int ks = 0; ks < 4; ++ks) d = MFMA16(WF[ks], yb[ks], d); \
          __builtin_amdgcn_sched_barrier(0); \
          const float v0 = bflo(UV.x) - d[0], v1 = bfhi(UV.x) - d[1], v2 = bflo(UV.y) - d[2], v3 = bfhi(UV.y) - d[3]; \
          u32x2 w; w.x = cvt_pk_bf16(v0, v1); w.y = cvt_pk_bf16(v2, v3); \
          *(LAS u32x2*)(VNt + (tt * 16 + fr) * VN_LD + ct * 16 + 4 * fq) = w; } \
        LDS_BARRIER(); \
          \
        f32x4 od; float ss; \
        { bf16x8 xb[4], vb[2], yb3[2][2]; \
          _Pragma("unroll") for (int ks = 0; ks < 4; ++ks) xb[ks] = *(const LAS bf16x8*)(Sc + (tt * 16 + fr) * ST_LD + ks * 32 + 8 * fq); \
          _Pragma("unroll") for (int ks = 0; ks < 2; ++ks) vb[ks] = *(const LAS bf16x8*)(VNt + (tt * 16 + fr) * VN_LD + ks * 32 + 8 * fq); \
          _Pragma("unroll") for (int t = 0; t < 2; ++t) _Pragma("unroll") for (int ks = 0; ks < 2; ++ks) yb3[t][ks] = *(const LAS bf16x8*)(VNt + (t * 16 + fr) * VN_LD + ks * 32 + 8 * fq); \
          f32x4 dd[2]; dd[0] = sacc[0] * gl; dd[1] = sacc[1] * gl; \
          __builtin_amdgcn_sched_barrier(0); \
          f32x4 d = (f32x4){0.f, 0.f, 0.f, 0.f}; \
            \
          _Pragma("unroll") for (int ks = 0; ks < 4; ++ks) { d = MFMA16(xb[ks], QF[ks], d); if (ks < 2) { dd[0] = MFMA16(KF[ks], yb3[0][ks], dd[0]); dd[1] = MFMA16(KF[ks], yb3[1][ks], dd[1]); } } \
          _Pragma("unroll") for (int ks = 0; ks < 2; ++ks) d = MFMA16(vb[ks], AF[ks], d); \
          __builtin_amdgcn_sched_barrier(0); \
          od = d; ss = (d[0] * d[0] + d[1] * d[1]) + (d[2] * d[2] + d[3] * d[3]); \
          _Pragma("unroll") for (int t = 0; t < 2; ++t) { sacc[t] = dd[t]; \
              u32x2 w; w.x = cvt_pk_bf16_mfma(dd[t][0], dd[t][1]); w.y = cvt_pk_bf16_mfma(dd[t][2], dd[t][3]); \
              *(LAS u32x2*)(Sn + (t * 16 + fr) * ST_LD + wave * 16 + 4 * fq) = w; } } \
        ss += __shfl_xor(ss, 16); ss += __shfl_xor(ss, 32); \
        if (fq == 0) red[(ct * 2 + tt) * 16 + fr] = ss; \
        LDS_BARRIER(); \
          \
        if (tt == 0 && fq == 0) PART[(trow * 4 + h) * 4 + sl] = red[(ct * 2) * 16 + fr] + red[(ct * 2 + 1) * 16 + fr]; \
        { const float z0 = bflo(zv.x), z1 = bfhi(zv.x), z2 = bflo(zv.y), z3 = bfhi(zv.y); \
          const float o0 = od[0] * gnj[0] * (z0 * sigmoidf_(z0)), o1 = od[1] * gnj[1] * (z1 * sigmoidf_(z1)); \
          const float o2 = od[2] * gnj[2] * (z2 * sigmoidf_(z2)), o3 = od[3] * gnj[3] * (z3 * sigmoidf_(z3)); \
          u32x2 w; w.x = cvt_pk_bf16(o0, o1); w.y = cvt_pk_bf16(o2, o3); \
          *(u32x2*)(OG + trow * 512 + h * 128 + dvg + 4 * fq) = w; } } while (0)
#define SCAN_WAIT(nn) do { if (((nn) & 7) == 0) { const unsigned* fp_ = flags + bh * NCH + (nn) + (lane & 7); \
        while (!__all(__hip_atomic_load(fp_, __ATOMIC_RELAXED, __HIP_MEMORY_SCOPE_AGENT) != 0u)) __builtin_amdgcn_s_sleep(2); \
        __builtin_amdgcn_fence(__ATOMIC_ACQUIRE, "agent"); asm volatile("s_waitcnt vmcnt(0)" ::: "memory"); } } while (0)
    const unsigned* flags = (const unsigned*)(ws + WS_CTL) + 1024;
    bf16x8 wfA[4], wfB[4], qfA[4], afA[2], qfB[4], afB[2], kfA[2], kfB[2]; u32x2 uvA, uvB, zvA, zvB; float alA, alB;
    SCAN_WAIT(0);
    SCAN_LOAD(0, wfA, uvA, alA, qfA, afA, kfA, zvA);
    for (int n = 0; n < NCH; n += 2) {
        SCAN_LOAD(n + 1, wfB, uvB, alB, qfB, afB, kfB, zvB);
        SCAN_STEP(n, wfA, uvA, alA, qfA, afA, kfA, zvA);
        const int n2 = (n + 2 < NCH) ? n + 2 : NCH - 1;
        SCAN_WAIT(n2); SCAN_LOAD(n2, wfA, uvA, alA, qfA, afA, kfA, zvA);
        SCAN_STEP(n + 1, wfB, uvB, alB, qfB, afB, kfB, zvB);
    }
#undef SCAN_LOAD
#undef SCAN_STEP
#undef SCAN_WAIT
    __syncthreads();
}
__device__ __forceinline__ void gdn_norm_pass(const Args& a, int bx, int G) {
    bf16_t* OG = (bf16_t*)(a.ws + WS_OG); const float* PART = (const float*)(a.ws + WS_SSQ);
    for (size_t g = (size_t)bx * 512 + threadIdx.x; g < (size_t)TOK * 4 * 16; g += (size_t)G * 512) {
        const size_t pair = g >> 4; const int seg = (int)(g & 15);
        const f32x4 p = *(const f32x4*)(PART + pair * 4);
        const float rstd = rsqrtf(((p[0] + p[1]) + (p[2] + p[3])) * (1.f / HD) + EPS);
        u32x4* ptr = (u32x4*)(OG + pair * 128 + seg * 8); const u32x4 v = *ptr; u32x4 w;
#pragma unroll
        for (int e = 0; e < 4; ++e) w[e] = cvt_pk_bf16(bflo(v[e]) * rstd, bfhi(v[e]) * rstd);
        *ptr = w;
    }
}

constexpr int KS_LD = 136, VT_LD = 72;
__device__ __forceinline__ void sb_unit(const Args& a, LAS unsigned char* lds, int uid) {
    const int tid = threadIdx.x, lane = tid & 63, wave = __builtin_amdgcn_readfirstlane(tid >> 6), fr = lane & 15, fq = lane >> 4;
    const int qb = uid & 63, bh = uid >> 6, h = bh & 3, b = bh >> 2;
    const bf16_t* SQ = (const bf16_t*)(a.ws + WS_SQKV); bf16_t* OS = (bf16_t*)(a.ws + WS_OS);
    LAS bf16_t* Ks = (LAS bf16_t*)lds;
    LAS bf16_t* Vt = (LAS bf16_t*)(lds + 64 * KS_LD * 2);
    LAS int* flags = (LAS int*)(lds + 64 * KS_LD * 2 + 128 * VT_LD * 2);
    const int q0 = qb * 128, tq = q0 + wave * 16 + fr;
    const size_t brow = (size_t)b * SEQ;
    bf16x8 qf[4];
    {
        u32x4 raw[4]; float s = 0.f;
#pragma unroll
        for (int ks = 0; ks < 4; ++ks) { raw[ks] = *(const u32x4*)(SQ + (brow + tq) * 1536 + h * 128 + ks * 32 + 8 * fq);
#pragma unroll
            for (int e = 0; e < 4; ++e) { const float lo = bflo(raw[ks][e]), hi = bfhi(raw[ks][e]); s += lo * lo + hi * hi; } }
        s += __shfl_xor(s, 16); s += __shfl_xor(s, 32);
        const float rs = rsqrtf(s * (1.f / HD) + EPS) * 0.08838834764831845f;
#pragma unroll
        for (int ks = 0; ks < 4; ++ks) { const float* gp = a.in[I_SBQG] + ks * 32 + 8 * fq; u32x4 w;
#pragma unroll
            for (int e = 0; e < 4; ++e) w[e] = cvt_pk_bf16(bflo(raw[ks][e]) * rs * gp[2 * e], bfhi(raw[ks][e]) * rs * gp[2 * e + 1]);
            qf[ks] = __builtin_bit_cast(bf16x8, w); }
    }
    f32x4 oacc[8];
#pragma unroll
    for (int j = 0; j < 8; ++j) oacc[j] = (f32x4){0.f, 0.f, 0.f, 0.f};
    float carry = 0.f;
    for (int kt = qb * 2 + 1; kt >= 0; --kt) {
#pragma unroll
        for (int j = 0; j < 2; ++j) { const int task = tid + 512 * j, r = task >> 4, seg = task & 15;
            const bf16_t* kp = SQ + (brow + kt * 64 + r) * 1536 + 512 + h * 128 + seg * 8;
            const u32x4 kr = *(const u32x4*)kp;
            float s = 0.f;
#pragma unroll
            for (int e = 0; e < 4; ++e) { const float lo = bflo(kr[e]), hi = bfhi(kr[e]); s += lo * lo + hi * hi; }
            s += __shfl_xor(s, 1); s += __shfl_xor(s, 2); s += __shfl_xor(s, 4); s += __shfl_xor(s, 8);
            const float rs = rsqrtf(s * (1.f / HD) + EPS); const float* gp = a.in[I_SBKG] + seg * 8; u32x4 w;
#pragma unroll
            for (int e = 0; e < 4; ++e) w[e] = cvt_pk_bf16(bflo(kr[e]) * rs * gp[2 * e], bfhi(kr[e]) * rs * gp[2 * e + 1]);
            *(LAS u32x4*)(Ks + r * KS_LD + seg * 8) = w; }
#pragma unroll
        for (int j = 0; j < 2; ++j) { const int task = tid + 512 * j, r = task & 63, seg = task >> 6;
            const u32x4 vr = *(const u32x4*)(SQ + (brow + kt * 64 + r) * 1536 + 1024 + h * 128 + seg * 8);
            const int xt = r >> 4, kfq = (r & 15) >> 2, ii = r & 3, slot = (xt >> 1) * 32 + kfq * 8 + (xt & 1) * 4 + ii;
#pragma unroll
            for (int e = 0; e < 4; ++e) { Vt[(seg * 8 + 2 * e) * VT_LD + slot] = (bf16_t)(vr[e] & 0xffffu); Vt[(seg * 8 + 2 * e + 1) * VT_LD + slot] = (bf16_t)(vr[e] >> 16); } }
        __syncthreads();
        f32x4 z[4];
#pragma unroll
        for (int xt = 0; xt < 4; ++xt) { f32x4 d = (f32x4){0.f, 0.f, 0.f, 0.f};
#pragma unroll
            for (int ks = 0; ks < 4; ++ks) { const bf16x8 xf = *(const LAS bf16x8*)(Ks + (xt * 16 + fr) * KS_LD + ks * 32 + 8 * fq); d = MFMA16(xf, qf[ks], d); }
            z[xt] = d; }
        float s4[4], lsg[4][4]; bool val[4][4];
#pragma unroll
        for (int xt = 0; xt < 4; ++xt) { s4[xt] = 0.f;
#pragma unroll
            for (int i = 0; i < 4; ++i) { const int key = kt * 64 + xt * 16 + 4 * fq + i; val[xt][i] = key < tq;
                const float sp = softplusf_(z[xt][i]); const float l = val[xt][i] ? -sp : 0.f; lsg[xt][i] = z[xt][i] - sp; z[xt][i] = l; s4[xt] += l; } }
        float R[4], Hh[4];
#pragma unroll
        for (int xt = 0; xt < 4; ++xt) { const float v1 = __shfl_xor(s4[xt], 16), v2 = __shfl_xor(s4[xt], 32), v3 = __shfl_xor(s4[xt], 48);
            R[xt] = s4[xt] + v1 + v2 + v3;
            Hh[xt] = (((fq ^ 1) > fq) ? v1 : 0.f) + (((fq ^ 2) > fq) ? v2 : 0.f) + (((fq ^ 3) > fq) ? v3 : 0.f); }
        float above = carry;
        u32x4 pw[2];
#pragma unroll
        for (int xt = 3; xt >= 0; --xt) { const float base = above + Hh[xt];
            const float b3 = base, b2 = b3 + z[xt][3], b1 = b2 + z[xt][2], b0 = b1 + z[xt][1];
            const float p0 = val[xt][0] ? __expf(lsg[xt][0] + b0) : 0.f, p1 = val[xt][1] ? __expf(lsg[xt][1] + b1) : 0.f;
            const float p2 = val[xt][2] ? __expf(lsg[xt][2] + b2) : 0.f, p3 = val[xt][3] ? __expf(lsg[xt][3] + b3) : 0.f;
            pw[xt >> 1][(xt & 1) * 2] = cvt_pk_bf16(p0, p1); pw[xt >> 1][(xt & 1) * 2 + 1] = cvt_pk_bf16(p2, p3);
            above += R[xt]; }
        carry = above;
#pragma unroll
        for (int ks = 0; ks < 2; ++ks) { const bf16x8 pf = __builtin_bit_cast(bf16x8, pw[ks]);
#pragma unroll
            for (int dt = 0; dt < 8; ++dt) { const bf16x8 xf = *(const LAS bf16x8*)(Vt + (dt * 16 + fr) * VT_LD + ks * 32 + 8 * fq); oacc[dt] = MFMA16(xf, pf, oacc[dt]); } }
        const bool done = __all(carry < -110.0f);
        if (lane == 0) flags[wave] = done ? 1 : 0;
        __syncthreads();
        int alld = 1;
#pragma unroll
        for (int w = 0; w < 8; ++w) alld &= flags[w];
        if (alld) break;
        __syncthreads();
    }
#pragma unroll
    for (int dt = 0; dt < 8; ++dt) { u32x2 w; w.x = cvt_pk_bf16_mfma(oacc[dt][0], oacc[dt][1]); w.y = cvt_pk_bf16_mfma(oacc[dt][2], oacc[dt][3]);
        *(u32x2*)(OS + (brow + tq) * 512 + h * 128 + dt * 16 + 4 * fq) = w; }
    __syncthreads();
}

constexpr int MK_LD = 136, MV_LD = 264;
__device__ __forceinline__ void mem_unit(const Args& a, LAS unsigned char* lds, int uid) {
    const int tid = threadIdx.x, lane = tid & 63, wave = __builtin_amdgcn_readfirstlane(tid >> 6), fr = lane & 15, fq = lane >> 4;
    const int qb = uid & 31, bh = uid >> 5, h = bh & 3, b = bh >> 2;
    bf16_t* MQ = (bf16_t*)(a.ws + WS_MQ); const bf16_t* KV = (const bf16_t*)(a.ws + WS_MEMKV);
    {
        const unsigned* cnt = (const unsigned*)(a.ws + WS_CTL) + 128;
        while (__hip_atomic_load(cnt, __ATOMIC_RELAXED, __HIP_MEMORY_SCOPE_AGENT) < 16u) __builtin_amdgcn_s_sleep(8);
        __builtin_amdgcn_fence(__ATOMIC_ACQUIRE, "agent"); asm volatile("s_waitcnt vmcnt(0)" ::: "memory");
    }
    LAS bf16_t* Km = (LAS bf16_t*)lds;
    LAS bf16_t* Vt = (LAS bf16_t*)(lds + 256 * MK_LD * 2);
#pragma unroll
    for (int j = 0; j < 8; ++j) { const int task = tid + 512 * j, r = task >> 4, seg = task & 15;
        const bf16_t* kp = KV + (size_t)(b * NMEM + r) * 1024 + h * 128 + seg * 8;
        const u32x4 kr = *(const u32x4*)kp; const u32x4 vr = *(const u32x4*)(kp + 512);
        float s = 0.f;
#pragma unroll
        for (int e = 0; e < 4; ++e) { const float lo = bflo(kr[e]), hi = bfhi(kr[e]); s += lo * lo + hi * hi; }
        s += __shfl_xor(s, 1); s += __shfl_xor(s, 2); s += __shfl_xor(s, 4); s += __shfl_xor(s, 8);
        const float rs = rsqrtf(s * (1.f / HD) + EPS); const float* gp = a.in[I_MKG] + seg * 8; u32x4 w;
#pragma unroll
        for (int e = 0; e < 4; ++e) w[e] = cvt_pk_bf16(bflo(kr[e]) * rs * gp[2 * e], bfhi(kr[e]) * rs * gp[2 * e + 1]);
        *(LAS u32x4*)(Km + r * MK_LD + seg * 8) = w;
        const int xt = r >> 4, kfq = (r & 15) >> 2, ii = r & 3, slot = (xt >> 1) * 32 + kfq * 8 + (xt & 1) * 4 + ii;
#pragma unroll
        for (int e = 0; e < 4; ++e) { Vt[(seg * 8 + 2 * e) * MV_LD + slot] = (bf16_t)(vr[e] & 0xffffu); Vt[(seg * 8 + 2 * e + 1) * MV_LD + slot] = (bf16_t)(vr[e] >> 16); } }
    __syncthreads();
    for (int pass = 0; pass < 2; ++pass) {
        const size_t trow = (size_t)b * SEQ + qb * 256 + pass * 128 + wave * 16 + fr;
        bf16x8 qf[4];
        {
            u32x4 raw[4]; float s = 0.f;
#pragma unroll
            for (int ks = 0; ks < 4; ++ks) { raw[ks] = *(const u32x4*)(MQ + trow * 512 + h * 128 + ks * 32 + 8 * fq);
#pragma unroll
                for (int e = 0; e < 4; ++e) { const float lo = bflo(raw[ks][e]), hi = bfhi(raw[ks][e]); s += lo * lo + hi * hi; } }
            s += __shfl_xor(s, 16); s += __shfl_xor(s, 32);
            const float rs = rsqrtf(s * (1.f / HD) + EPS) * 0.08838834764831845f;
#pragma unroll
            for (int ks = 0; ks < 4; ++ks) { const float* gp = a.in[I_MQG] + ks * 32 + 8 * fq; u32x4 w;
#pragma unroll
                for (int e = 0; e < 4; ++e) w[e] = cvt_pk_bf16(bflo(raw[ks][e]) * rs * gp[2 * e], bfhi(raw[ks][e]) * rs * gp[2 * e + 1]);
                qf[ks] = __builtin_bit_cast(bf16x8, w); }
        }
        f32x4 z[16]; float mx = -3.0e38f;
#pragma unroll
        for (int xt = 0; xt < 16; ++xt) { f32x4 d = (f32x4){0.f, 0.f, 0.f, 0.f};
#pragma unroll
            for (int ks = 0; ks < 4; ++ks) { const bf16x8 xf = *(const LAS bf16x8*)(Km + (xt * 16 + fr) * MK_LD + ks * 32 + 8 * fq); d = MFMA16(xf, qf[ks], d); }
            z[xt] = d; mx = fmaxf(mx, fmaxf(fmaxf(d[0], d[1]), fmaxf(d[2], d[3]))); }
        mx = fmaxf(mx, __shfl_xor(mx, 16)); mx = fmaxf(mx, __shfl_xor(mx, 32));
        float sum = 0.f;
#pragma unroll
        for (int xt = 0; xt < 16; ++xt) {
#pragma unroll
            for (int i = 0; i < 4; ++i) { const float p = __expf(z[xt][i] - mx); z[xt][i] = p; sum += p; } }
        sum += __shfl_xor(sum, 16); sum += __shfl_xor(sum, 32);
        const float inv = 1.0f / sum;
        f32x4 oacc[8];
#pragma unroll
        for (int j = 0; j < 8; ++j) oacc[j] = (f32x4){0.f, 0.f, 0.f, 0.f};
#pragma unroll
        for (int ks = 0; ks < 8; ++ks) { u32x4 pw; pw.x = cvt_pk_bf16(z[2 * ks][0], z[2 * ks][1]); pw.y = cvt_pk_bf16(z[2 * ks][2], z[2 * ks][3]); pw.z = cvt_pk_bf16(z[2 * ks + 1][0], z[2 * ks + 1][1]); pw.w = cvt_pk_bf16(z[2 * ks + 1][2], z[2 * ks + 1][3]);
            const bf16x8 pf = __builtin_bit_cast(bf16x8, pw);
#pragma unroll
            for (int dt = 0; dt < 8; ++dt) { const bf16x8 xf = *(const LAS bf16x8*)(Vt + (dt * 16 + fr) * MV_LD + ks * 32 + 8 * fq); oacc[dt] = MFMA16(xf, pf, oacc[dt]); } }
#pragma unroll
        for (int dt = 0; dt < 8; ++dt) { u32x2 w; w.x = cvt_pk_bf16(oacc[dt][0] * inv, oacc[dt][1] * inv); w.y = cvt_pk_bf16(oacc[dt][2] * inv, oacc[dt][3] * inv);
            *(u32x2*)(MQ + trow * 512 + h * 128 + dt * 16 + 4 * fq) = w; }
    }
    __syncthreads();
}

__device__ __forceinline__ void l2_flush(const float* x, int bx, int tid, float* sink) {
    const f32x4* p = (const f32x4*)x + (size_t)bx * 32768 + tid;
    f32x4 a = (f32x4){0.f, 0.f, 0.f, 0.f};
#pragma unroll 8
    for (int i = 0; i < 64; ++i) a += p[(size_t)i * 512];
    if (a[0] + a[1] + a[2] + a[3] == 1.2345e38f) *sink = a[0];
}

#define XB_TMO      128
#define XB_XCNT(j)  (256  + 64 * (j))
#define XB_XSUB(j)  (1280 + 64 * (j))
#define XB_XGEN(j)  (2304 + 64 * (j))
#define XB_TOP      3328
#define XB_TOPGEN   3392
#define XCD_BAR_WORDS 3456
#define XB_SPIN_CAP (1u << 22)
__device__ __forceinline__ unsigned xb_ld(unsigned* p)              { return __hip_atomic_load(p, __ATOMIC_RELAXED, __HIP_MEMORY_SCOPE_AGENT); }
__device__ __forceinline__ unsigned xb_add(unsigned* p, unsigned v) { return __hip_atomic_fetch_add(p, v, __ATOMIC_RELAXED, __HIP_MEMORY_SCOPE_AGENT); }
__device__ __forceinline__ unsigned xb_xcc_id() { return (unsigned)__builtin_amdgcn_s_getreg((3 << 11) | 20) & 0xFu; }
#define XB_SPIN(cond, bar) do { unsigned _sp = 0; while (cond) { __builtin_amdgcn_s_sleep(1); \
    if ((++_sp & 255u) == 0u) { if (xb_ld(&(bar)[XB_TMO])) break; if (_sp > XB_SPIN_CAP) { atomicAdd(&(bar)[XB_TMO], 1u); break; } } } } while (0)
struct XcdBarrier { unsigned* bar; unsigned x; volatile LAS unsigned* st; };
__device__ __forceinline__ XcdBarrier xcd_barrier_post(unsigned* bar, volatile LAS unsigned* st) {
    XcdBarrier b; b.bar = bar; b.x = xb_xcc_id(); b.st = st;
    if (threadIdx.x == 0) (void)xb_add(&bar[XB_XCNT(b.x)], 1u);
    return b;
}
__device__ __forceinline__ void xcd_barrier_complete(unsigned* bar, unsigned x, unsigned& nloc, unsigned& nx) {
    const unsigned G = gridDim.x * gridDim.y * gridDim.z;
    unsigned sum, cnt, mine, sp = 0u;
    for (;;) {
        sum = 0u; cnt = 0u; mine = 0u;
#pragma unroll
        for (unsigned j = 0; j < 16; ++j) { const unsigned c = xb_ld(&bar[XB_XCNT(j)]); sum += c; cnt += (c > 0u) ? 1u : 0u; mine = (j == x) ? c : mine; }
        if (sum == G) break;
        __builtin_amdgcn_s_sleep(1);
        if ((++sp & 255u) == 0u) { if (xb_ld(&bar[XB_TMO])) break; if (sp > XB_SPIN_CAP) { atomicAdd(&bar[XB_TMO], 1u); break; } }
    }
    nloc = mine > 0u ? mine : 1u; nx = cnt > 0u ? cnt : 1u;
}
__device__ __forceinline__ void xcd_barrier(const XcdBarrier& b) {
    asm volatile("s_waitcnt vmcnt(0)" ::: "memory");
    __syncthreads();
    if (threadIdx.x == 0) {
        unsigned* bar = b.bar;
        __builtin_amdgcn_s_waitcnt(0);
        unsigned nloc = b.st[0], nx = b.st[1];
        if (nloc == 0u) { xcd_barrier_complete(bar, b.x, nloc, nx); b.st[0] = nloc; b.st[1] = nx; }
        const unsigned old = xb_add(&bar[XB_XSUB(b.x)], 1u);
        const unsigned gen = old / nloc;
        if (old + 1u == (gen + 1u) * nloc) {
            __builtin_amdgcn_fence(__ATOMIC_RELEASE, "agent");
            asm volatile("s_waitcnt vmcnt(0)" ::: "memory");
            const unsigned og = xb_add(&bar[XB_TOP], 1u);
            const unsigned tg = og / nx;
            if (og + 1u == (tg + 1u) * nx) xb_add(&bar[XB_TOPGEN], 1u);
            else XB_SPIN(xb_ld(&bar[XB_TOPGEN]) == tg, bar);
            __builtin_amdgcn_fence(__ATOMIC_ACQUIRE, "agent");
            xb_add(&bar[XB_XGEN(b.x)], 1u);
            asm volatile("s_waitcnt vmcnt(0)" ::: "memory");
        } else {
            XB_SPIN(xb_ld(&bar[XB_XGEN(b.x)]) == gen, bar);
            __builtin_amdgcn_fence(__ATOMIC_ACQUIRE, "agent");
            asm volatile("s_waitcnt vmcnt(0)" ::: "memory");
        }
    }
    __syncthreads();
}

__global__ void __launch_bounds__(512) fwd_megakernel(Args args) {
    extern __shared__ __attribute__((aligned(16))) unsigned char lds_raw[];
    LAS unsigned char* lds = (LAS unsigned char*)lds_raw;
    cg::grid_group grid = cg::this_grid();
    const int G = gridDim.x, bx = blockIdx.x, tid = threadIdx.x;
    const int vcu = (G % 8 == 0) ? (bx % 8) * (G / 8) + bx / 8 : bx;
    unsigned char* ws = args.ws;
    unsigned* ctl = (unsigned*)(ws + WS_CTL);
    LAS int* qslot = (LAS int*)(lds + LDS_BYTES - 64);
    volatile LAS unsigned* xbst = (volatile LAS unsigned*)(lds + LDS_BYTES - 32);
    if (tid < 2) xbst[tid] = 0u;
    __syncthreads();
    const XcdBarrier xbar = xcd_barrier_post(ctl + 4096, xbst);
    const int lo = args.ph_lo, hi = args.ph_hi;
#ifndef PH_MASK
#define PH_MASK 0x1ff
#endif
#ifdef TIME_MASK
    unsigned long long t_ph0 = 0;
#define PH_T0(k) do { if ((TIME_MASK >> (k)) & 1) t_ph0 = __builtin_amdgcn_s_memrealtime(); } while (0)
#define PH_T1(k) do { if ((TIME_MASK >> (k)) & 1) { const unsigned long long t1_ = __builtin_amdgcn_s_memrealtime(); const unsigned long long d_ = t1_ - t_ph0; while (__builtin_amdgcn_s_memrealtime() - t1_ < d_) __builtin_amdgcn_s_sleep(8); } } while (0)
#else
#define PH_T0(k) do { } while (0)
#define PH_T1(k) do { } while (0)
#endif
#define INR(k) (lo <= (k) && (k) < hi)
#define IN(k) (((PH_MASK >> (k)) & 1) && INR(k))
#define SEAM(k) do { if (INR(k) && INR((k) + 1)) xcd_barrier(xbar); } while (0)
    if (lo < 0) {
        asm volatile("s_waitcnt vmcnt(0)" ::: "memory"); grid.sync(); __builtin_amdgcn_fence(__ATOMIC_ACQUIRE, "agent"); asm volatile("s_waitcnt vmcnt(0)" ::: "memory"); }

    PH_T0(0); if (IN(0)) phase0(args, lds, vcu, G);
    SEAM(0); PH_T1(0);
#ifdef TEST_GEMM
    if (IN(1)) {
        EpiP7 E{(const bf16_t*)(ws + WS_H), args.out};
        SchedGrid S{(const char*)(ws + WS_H), (const char*)(ws + WS_WO), TOK / 256, DM / 256, G, bx, (size_t)256 * 1024 * 2};
        pg8::gemm_phase<EpiP7, SchedGrid, true, true>(lds, 1024, S, E);
    }
#endif
#ifdef TEST_GEMM
    if (false) {
#else
    PH_T0(1); if (IN(1)) {
#endif
        EpiP1 E{(bf16_t*)args.out, (bf16_t*)(ws + WS_GZ), (bf16_t*)(ws + WS_SQKV), (bf16_t*)(ws + WS_MQ), (bf16_t*)(ws + WS_GATES), (bf16_t*)(ws + WS_MEMKV), 0};
        SchedGrid S{(const char*)(ws + WS_H), (const char*)(ws + WS_WIN), TOK / 256, 16, G, bx, (size_t)256 * 1024 * 2};
        pg8::gemm_phase<EpiP1, SchedGrid, true, true>(lds, 1024, S, E);
    }
    SEAM(1); PH_T1(1);
    PH_T0(3); if (IN(3)) {
#ifdef TIME_SCAN
        if (bx < NB * NH * 4) { const unsigned long long t0_ = __builtin_amdgcn_s_memrealtime(); gdn_scan_unit(args, lds, bx); const unsigned long long t1_ = __builtin_amdgcn_s_memrealtime(); while (__builtin_amdgcn_s_memrealtime() - t1_ < (t1_ - t0_)) __builtin_amdgcn_s_sleep(8); }
#else
        if (bx < NB * NH * 4) gdn_scan_unit(args, lds, bx);
        else { const int nprep = G - NB * NH * 4;
            int pend = -1;
            for (int u = bx - NB * NH * 4; u < NB * NH * NCH; u += nprep) { const int cid = (u & 15) * NCH + (u >> 4);
                gdn_prep_unit(args, lds, cid);
                const bool flush = (pend >= 0) || (u + nprep >= NB * NH * NCH) || (u < 2 * nprep);
                if (flush) { if (tid == 0) { __builtin_amdgcn_fence(__ATOMIC_RELEASE, "agent"); asm volatile("s_waitcnt vmcnt(0)" ::: "memory");
                        if (pend >= 0) __hip_atomic_store(ctl + 1024 + pend, 1u, __ATOMIC_RELAXED, __HIP_MEMORY_SCOPE_AGENT);
                        __hip_atomic_store(ctl + 1024 + cid, 1u, __ATOMIC_RELAXED, __HIP_MEMORY_SCOPE_AGENT); } pend = -1; }
                else pend = cid; }
            if (bx - NB * NH * 4 < 16) {
                EpiP1 E2{(bf16_t*)args.out, (bf16_t*)(ws + WS_GZ), (bf16_t*)(ws + WS_SQKV), (bf16_t*)(ws + WS_MQ), (bf16_t*)(ws + WS_GATES), (bf16_t*)(ws + WS_MEMKV), 1};
                SchedGrid S2{(const char*)(ws + WS_MEMN), (const char*)(ws + WS_WMKV), 4, 4, G, bx - NB * NH * 4, (size_t)256 * 1024 * 2};
                pg8::gemm_phase<EpiP1, SchedGrid, true, true>(lds, 1024, S2, E2);
                asm volatile("s_waitcnt vmcnt(0)" ::: "memory"); __syncthreads();
                if (tid == 0) { __builtin_amdgcn_fence(__ATOMIC_RELEASE, "agent"); asm volatile("s_waitcnt vmcnt(0)" ::: "memory");
                    __hip_atomic_fetch_add(ctl + 128, 1u, __ATOMIC_RELAXED, __HIP_MEMORY_SCOPE_AGENT); }
            }
        }
#endif
        for (;;) {
            if (tid == 0) *qslot = (int)atomicAdd(ctl + 64, 1u);
            __syncthreads();
            const int it = *qslot;
            __syncthreads();
            if (it >= 1024 + 512) break;
            if (it < 1024) sb_unit(args, lds, it); else mem_unit(args, lds, it - 1024);
        }
    }
    SEAM(3); PH_T1(3);
    PH_T0(4); if (IN(4)) {
        gdn_norm_pass(args, bx, G);
        EpiP1 E{(bf16_t*)args.out, (bf16_t*)(ws + WS_GZ), (bf16_t*)(ws + WS_SQKV), (bf16_t*)(ws + WS_MQ), (bf16_t*)(ws + WS_GATES), (bf16_t*)(ws + WS_MEMKV), 2};
        SchedGrid S{(const char*)(ws + WS_H), (const char*)(ws + WS_WIN) + (size_t)4096 * 1024 * 2, TOK / 256, 12, G, bx, (size_t)256 * 1024 * 2};
        pg8::gemm_phase<EpiP1, SchedGrid, true, true>(lds, 1024, S, E);
    }
    SEAM(4); PH_T1(4);
    PH_T0(5); if (IN(5)) {
        EpiP3 E{(const bf16_t*)(ws + WS_GATES), (float*)(ws + WS_MIXF + (size_t)bx * 262144), (bf16_t*)(ws + WS_MIX)};
        SchedBranch S{(const char*)(ws + WS_OG), (const char*)(ws + WS_OS), (const char*)(ws + WS_MQ), (const char*)(ws + WS_WBR), G, bx, (size_t)256 * 512 * 2};
        pg8::gemm_phase<EpiP3, SchedBranch, true, true>(lds, 512, S, E);
    }
    SEAM(5); PH_T1(5);
    PH_T0(6); if (IN(6)) {
        EpiP4 E{args.in[I_X], args.out, (bf16_t*)(ws + WS_X1B), (float*)(ws + WS_SSQ)};
        SchedGrid S{(const char*)(ws + WS_MIX), (const char*)(ws + WS_WO), TOK / 256, DM / 256, G, bx, (size_t)256 * 1024 * 2};
        pg8::gemm_phase<EpiP4, SchedGrid, true, true>(lds, 1024, S, E);
    }
    SEAM(6); PH_T1(6);
    PH_T0(7); if (IN(7)) {
        EpiP6 E{(const float*)(ws + WS_SSQ), (bf16_t*)(ws + WS_ACT)};
        SchedGrid S{(const char*)(ws + WS_X1B), (const char*)(ws + WS_WUP), TOK / 256, DFF / 256, G, bx, (size_t)256 * 1024 * 2};
        pg8::gemm_phase<EpiP6, SchedGrid, true, true>(lds, 1024, S, E);
    }
    SEAM(7); PH_T1(7);
    PH_T0(8); if (IN(8)) {
#ifdef P7_VIA_WS
        EpiP7 E{(const bf16_t*)(ws + WS_X1B), (float*)(ws + 46 * MiB)};
#else
        EpiP7 E{(const bf16_t*)(ws + WS_X1B), args.out};
#endif
#ifdef TEST_P7
        E.x1b = (const bf16_t*)(ws + TEST_A);
        SchedGrid S{(const char*)(ws + TEST_A), (const char*)(ws + WS_WO), TOK / 256, DM / 256, G, bx, (size_t)256 * 1024 * 2};
        pg8::gemm_phase<EpiP7, SchedGrid, true, true>(lds, 1024, S, E);
#else
        SchedGrid S{(const char*)(ws + WS_ACT), (const char*)(ws + WS_WDN), TOK / 256, DM / 256, G, bx, (size_t)256 * 4096 * 2};
        pg8::gemm_phase<EpiP7, SchedGrid, true, true>(lds, 4096, S, E);
#endif
    }
#ifdef P7_VIA_WS
    { asm volatile("s_waitcnt vmcnt(0)" ::: "memory"); grid.sync(); __builtin_amdgcn_fence(__ATOMIC_ACQUIRE, "agent"); asm volatile("s_waitcnt vmcnt(0)" ::: "memory");
      const f32x4* src = (const f32x4*)(ws + 46 * MiB); f32x4* dst = (f32x4*)args.out;
      for (size_t i = (size_t)bx * 512 + tid; i < (size_t)TOK * DM / 4; i += (size_t)G * 512) dst[i] = src[i]; }
#endif
    asm volatile("s_waitcnt vmcnt(0)" ::: "memory"); __syncthreads();
    if (tid == 0) { __builtin_amdgcn_fence(__ATOMIC_RELEASE, "agent"); asm volatile("s_waitcnt vmcnt(0)" ::: "memory"); }
#ifdef DUMP_OFF
    if (lo == 0) { asm volatile("s_waitcnt vmcnt(0)" ::: "memory"); grid.sync(); __builtin_amdgcn_fence(__ATOMIC_ACQUIRE, "agent"); asm volatile("s_waitcnt vmcnt(0)" ::: "memory"); }
    if (lo == 100 || lo == 0) {
        const unsigned* src = (const unsigned*)(ws + (size_t)DUMP_OFF);
        { const int xcd = bx & 7, k = bx >> 3, pmt = xcd * 16 + (k >> 1), half = k & 1;
          const size_t base = ((size_t)pmt * 256 + (size_t)half * 128) * 512;
          for (int j = tid; j < 128 * 512; j += 512) { const size_t i = base + j; const unsigned u = src[i]; args.out[2 * i] = bflo(u); args.out[2 * i + 1] = bfhi(u); } }
    }
    asm volatile("s_waitcnt vmcnt(0)" ::: "memory"); __syncthreads();
    if (tid == 0) { __builtin_amdgcn_fence(__ATOMIC_RELEASE, "agent"); asm volatile("s_waitcnt vmcnt(0)" ::: "memory"); }
#endif
#undef IN
#undef SEAM
}

#ifndef MK_N_LAUNCHES
#define MK_N_LAUNCHES 1
#endif
extern "C" void kernel_launch(void* const* d_in, const int* in_sizes, int n_in, void* d_out, int out_size, void* d_ws, size_t ws_size, hipStream_t stream) {
    static int grid = 0;
    if (grid == 0) {
        if (n_in != 21 || out_size != TOK * DM || ws_size < WS_END) { fprintf(stderr, "kernel_launch: unexpected shapes (n_in %d, out %d, ws %zu)\n", n_in, out_size, ws_size); grid = -1; return; }
        int dev = 0, cus = 0, per_cu = 0;
        hipGetDevice(&dev); hipDeviceGetAttribute(&cus, hipDeviceAttributeMultiprocessorCount, dev);
        hipFuncSetAttribute((const void*)fwd_megakernel, hipFuncAttributeMaxDynamicSharedMemorySize, LDS_BYTES);
        hipOccupancyMaxActiveBlocksPerMultiprocessor(&per_cu, (const void*)fwd_megakernel, 512, LDS_BYTES);
        (void)hipGetLastError();
        if (per_cu < 1) { fprintf(stderr, "kernel_launch: occupancy query says %d workgroups per CU\n", per_cu); per_cu = 1; }
        grid = cus;
    }
    if (grid < 0) return;
    hipMemsetAsync((char*)d_ws + WS_CTL, 0, 32768, stream);
    Args a{};
    for (int i = 0; i < 21; ++i) a.in[i] = (const float*)d_in[i];
    a.out = (float*)d_out; a.ws = (unsigned char*)d_ws;
#if MK_N_LAUNCHES == 1
#ifdef DUMP_OFF
    a.ph_lo = 0; a.ph_hi = DUMP_AFTER + 1;
#elif defined(TEST_GEMM)
    a.ph_lo = 0; a.ph_hi = 2;
#else
    a.ph_lo = 0; a.ph_hi = 9;
#endif
    void* kargs[] = {&a};
    hipError_t e = hipLaunchCooperativeKernel((const void*)fwd_megakernel, dim3(grid), dim3(512), kargs, LDS_BYTES, stream);
    if (e != hipSuccess) fprintf(stderr, "cooperative launch failed: %s (grid %d)\n", hipGetErrorString(e), grid);
#else
#ifdef DUMP_OFF
    for (int p = 0; p <= DUMP_AFTER; ++p) { a.ph_lo = p; a.ph_hi = p + 1; hipLaunchKernelGGL(fwd_megakernel, dim3(grid), dim3(512), LDS_BYTES, stream, a); }
    a.ph_lo = 100; a.ph_hi = 101; hipLaunchKernelGGL(fwd_megakernel, dim3(grid), dim3(512), LDS_BYTES, stream, a);
#else
    for (int p = 0; p < 9; ++p) { a.ph_lo = p; a.ph_hi = p + 1; hipLaunchKernelGGL(fwd_megakernel, dim3(grid), dim3(512), LDS_BYTES, stream, a); }
#endif
#endif
}
```
